# Optimizing an MI355X kernel written in HIP

```python
import jax, jax.numpy as jnp
from jax import lax
import numpy as np

D_MODEL = 2048
BATCH = 2
SEQ = 4096
DEPTH = 2
DEC_BATCH = 16
DEC_SEQ = 64
PAST_LEN = 2048

CHUNK = 64
QBLOCK = 128
EPS = 1e-6
D_FF = 5632
MLA_HEADS = 8
Q_LORA = 512
KV_LORA = 512
NOPE_DIM = 128
ROPE_DIM = 64
V_DIM = 128
ROPE_THETA = 10000.0
MLA_WIDTH = MLA_HEADS * V_DIM
CONV_DIM = 512
CONV_W = 3
SB_HEADS = 4
SB_DIM = 128
SB_WIDTH = SB_HEADS * SB_DIM
D_MIX = MLA_WIDTH + CONV_DIM + SB_WIDTH
D_IN = Q_LORA + KV_LORA + ROPE_DIM + 3 * CONV_DIM + 3 * SB_WIDTH
MLA_SCALE = (NOPE_DIM + ROPE_DIM) ** -0.5
SB_SCALE = SB_DIM ** -0.5
NEG_INF = -1e30

kernel_name = 'hybrid_mla_conv_stickbreak_stream_step'


def rms_norm(x, g):
    xf = x.astype(jnp.float32)
    y = xf * lax.rsqrt(jnp.mean(xf * xf, axis=-1, keepdims=True) + EPS)
    return (y * g.astype(jnp.float32)).astype(x.dtype)


def swiglu(x, w_gate, w_up, w_down):
    return (jax.nn.silu(x @ w_gate) * (x @ w_up)) @ w_down


def rope_tables(pos):
    half = ROPE_DIM // 2
    inv_freq = ROPE_THETA ** (-jnp.arange(half, dtype=jnp.float32) / half)
    ang = pos.astype(jnp.float32)[:, None] * inv_freq[None, :]
    return jnp.cos(ang), jnp.sin(ang)


def apply_rope(x, cos, sin):
    half = ROPE_DIM // 2
    xf = x.astype(jnp.float32)
    x1, x2 = xf[..., :half], xf[..., half:]
    return jnp.concatenate([x1 * cos - x2 * sin, x2 * cos + x1 * sin], axis=-1).astype(x.dtype)


def with_past(past, new):
    return new if past is None else jnp.concatenate([past.astype(new.dtype), new], axis=1)


def sweep_query_blocks(block_fn, q_inputs, q_pos):
    sq = q_pos.shape[0]
    if sq <= QBLOCK:
        return block_fn(q_inputs, q_pos)
    nb = sq // QBLOCK

    def split(a):
        return jnp.swapaxes(a.reshape(a.shape[0], nb, QBLOCK, *a.shape[2:]), 0, 1)

    blocks = tuple(split(a) for a in q_inputs)
    out = lax.map(lambda xs: block_fn(xs[0], xs[1]), (blocks, q_pos.reshape(nb, QBLOCK)))
    out = jnp.swapaxes(out, 0, 1)
    return out.reshape(out.shape[0], sq, *out.shape[3:])


def token_mixing(u, pos, past, lw):
    bsz, s, _ = u.shape
    offs = np.cumsum([Q_LORA, KV_LORA, ROPE_DIM, CONV_DIM, CONV_DIM, CONV_DIM, SB_WIDTH, SB_WIDTH]).tolist()
    z = u @ lw['w_in']
    c_q, c_kv, k_rope, gate_b, gate_c, x_conv, q_sb, k_sb, v_sb = jnp.split(z, offs, axis=-1)

    if past is None:
        past_ckv = past_kr = past_k = past_v = None
        conv_hist = jnp.zeros((bsz, CONV_W - 1, CONV_DIM), u.dtype)
        kpos = pos
    else:
        past_ckv, past_kr, past_k, past_v, conv_hist = past
        kpos = jnp.concatenate([jnp.arange(past_ckv.shape[1], dtype=jnp.int32), pos])

    c_q = rms_norm(c_q, lw['mla_q_norm_g'])
    c_kv = rms_norm(c_kv, lw['mla_kv_norm_g'])
    q = (c_q @ lw['mla_w_uq']).reshape(bsz, s, MLA_HEADS, NOPE_DIM + ROPE_DIM)
    cos, sin = rope_tables(pos)
    q_rope = apply_rope(q[..., NOPE_DIM:], cos[:, None, :], sin[:, None, :])
    k_rope = apply_rope(k_rope, cos, sin)
    q_lat = jnp.einsum('bshn,lhn->bshl', q[..., :NOPE_DIM], lw['mla_w_uk'])
    keys_ckv = with_past(past_ckv, c_kv)
    keys_kr = with_past(past_kr, k_rope)

    def mla_block(qb, qpos):
        ql, qr = qb
        scores = (jnp.einsum('bqhl,bkl->bhqk', ql, keys_ckv)
                  + jnp.einsum('bqhr,bkr->bhqk', qr, keys_kr)).astype(jnp.float32) * MLA_SCALE
        visible = (kpos[None, :] // CHUNK) <= (qpos[:, None] // CHUNK)
        p = jax.nn.softmax(jnp.where(visible, scores, NEG_INF), axis=-1).astype(keys_ckv.dtype)
        return jnp.einsum('bhqk,bkl->bqhl', p, keys_ckv)

    o_lat = sweep_query_blocks(mla_block, (q_lat, q_rope), pos)
    y_mla = jnp.einsum('bshl,lhd->bshd', o_lat, lw['mla_w_uv']).reshape(bsz, s, MLA_WIDTH)

    u_conv = gate_c * x_conv
    ext = jnp.concatenate([conv_hist.astype(u_conv.dtype), u_conv], axis=1)
    w = lw['conv_w']
    conv = w[0] * ext[:, 0:s]
    for k in range(1, CONV_W):
        conv = conv + w[k] * ext[:, k:k + s]
    y_conv = gate_b * conv
    new_conv = ext[:, -(CONV_W - 1):]

    q_sb = q_sb.reshape(bsz, s, SB_HEADS, SB_DIM)
    k_sb = k_sb.reshape(bsz, s, SB_HEADS, SB_DIM)
    v_sb = v_sb.reshape(bsz, s, SB_HEADS, SB_DIM)
    keys_k = with_past(past_k, k_sb)
    keys_v = with_past(past_v, v_sb)

    def sb_block(qb, qpos):
        (qq,) = qb
        logits = jnp.einsum('bqhd,bkhd->bhqk', qq, keys_k).astype(jnp.float32) * SB_SCALE
        earlier = kpos[None, :] < qpos[:, None]
        log_keep = jnp.where(earlier, jax.nn.log_sigmoid(-logits), 0.0)
        log_between = lax.cumsum(log_keep, axis=3, reverse=True) - log_keep
        weights = jnp.where(earlier, jnp.exp(jax.nn.log_sigmoid(logits) + log_between), 0.0)
        return jnp.einsum('bhqk,bkhd->bqhd', weights.astype(keys_v.dtype), keys_v)

    y_sb = sweep_query_blocks(sb_block, (q_sb,), pos).reshape(bsz, s, SB_WIDTH)

    merged = jnp.concatenate([rms_norm(y_mla, lw['out_norm_mla_g']),
                              rms_norm(y_conv, lw['out_norm_conv_g']),
                              rms_norm(y_sb, lw['out_norm_sb_g'])], axis=-1)
    y = merged @ lw['w_o']
    return y, (c_kv, k_rope, k_sb, v_sb, new_conv)


def trunk_layer(x, pos, past, lw):
    f1 = swiglu(rms_norm(x, lw['ffn1_pre_g']), lw['ffn1_w_gate'], lw['ffn1_w_up'], lw['ffn1_w_down'])
    h = x + 0.5 * rms_norm(f1, lw['ffn1_post_g'])
    m, new_state = token_mixing(rms_norm(h, lw['mix_pre_g']), pos, past, lw)
    h = h + rms_norm(m, lw['mix_post_g'])
    f2 = swiglu(rms_norm(h, lw['ffn2_pre_g']), lw['ffn2_w_gate'], lw['ffn2_w_up'], lw['ffn2_w_down'])
    h = h + 0.5 * rms_norm(f2, lw['ffn2_post_g'])
    return h, new_state


def setup_inputs(seed: int = 0) -> dict:
    key = jax.random.key(seed)
    ks = iter(jax.random.split(key, 40))

    def nrm(shape, scale):
        return scale * jax.random.normal(next(ks), shape, jnp.float32)

    def gain(shape):
        return 1.0 + 0.02 * jax.random.normal(next(ks), shape, jnp.float32)

    L = DEPTH
    return {
        'x_prompt': nrm((BATCH, SEQ, D_MODEL), 1.0),
        'x_sample': nrm((DEC_BATCH, DEC_SEQ, D_MODEL), 1.0),
        'cache_mla_ckv': nrm((L, DEC_BATCH, PAST_LEN, KV_LORA), 1.0),
        'cache_mla_krope': nrm((L, DEC_BATCH, PAST_LEN, ROPE_DIM), 1.0),
        'cache_sb_k': nrm((L, DEC_BATCH, PAST_LEN, SB_HEADS, SB_DIM), 1.0),
        'cache_sb_v': nrm((L, DEC_BATCH, PAST_LEN, SB_HEADS, SB_DIM), 1.0),
        'state_conv': nrm((L, DEC_BATCH, CONV_W - 1, CONV_DIM), 1.0),
        'ffn1_pre_g': gain((L, D_MODEL)),
        'ffn1_w_gate': nrm((L, D_MODEL, D_FF), D_MODEL ** -0.5),
        'ffn1_w_up': nrm((L, D_MODEL, D_FF), D_MODEL ** -0.5),
        'ffn1_w_down': nrm((L, D_FF, D_MODEL), D_FF ** -0.5),
        'ffn1_post_g': gain((L, D_MODEL)),
        'mix_pre_g': gain((L, D_MODEL)),
        'w_in': nrm((L, D_MODEL, D_IN), D_MODEL ** -0.5),
        'mla_q_norm_g': gain((L, Q_LORA)),
        'mla_kv_norm_g': gain((L, KV_LORA)),
        'mla_w_uq': nrm((L, Q_LORA, MLA_HEADS * (NOPE_DIM + ROPE_DIM)), Q_LORA ** -0.5),
        'mla_w_uk': nrm((L, KV_LORA, MLA_HEADS, NOPE_DIM), KV_LORA ** -0.5),
        'mla_w_uv': nrm((L, KV_LORA, MLA_HEADS, V_DIM), KV_LORA ** -0.5),
        'conv_w': nrm((L, CONV_W, CONV_DIM), CONV_W ** -0.5),
        'out_norm_mla_g': gain((L, MLA_WIDTH)),
        'out_norm_conv_g': gain((L, CONV_DIM)),
        'out_norm_sb_g': gain((L, SB_WIDTH)),
        'w_o': nrm((L, D_MIX, D_MODEL), D_MIX ** -0.5),
        'mix_post_g': gain((L, D_MODEL)),
        'ffn2_pre_g': gain((L, D_MODEL)),
        'ffn2_w_gate': nrm((L, D_MODEL, D_FF), D_MODEL ** -0.5),
        'ffn2_w_up': nrm((L, D_MODEL, D_FF), D_MODEL ** -0.5),
        'ffn2_w_down': nrm((L, D_FF, D_MODEL), D_FF ** -0.5),
        'ffn2_post_g': gain((L, D_MODEL)),
    }


def reference(x_prompt, x_sample, cache_mla_ckv, cache_mla_krope, cache_sb_k, cache_sb_v, state_conv,
              ffn1_pre_g, ffn1_w_gate, ffn1_w_up, ffn1_w_down, ffn1_post_g,
              mix_pre_g, w_in, mla_q_norm_g, mla_kv_norm_g, mla_w_uq, mla_w_uk, mla_w_uv, conv_w,
              out_norm_mla_g, out_norm_conv_g, out_norm_sb_g, w_o, mix_post_g,
              ffn2_pre_g, ffn2_w_gate, ffn2_w_up, ffn2_w_down, ffn2_post_g):
    past_len = cache_mla_ckv.shape[2]
    pos_p = jnp.arange(x_prompt.shape[1], dtype=jnp.int32)
    pos_s = past_len + jnp.arange(x_sample.shape[1], dtype=jnp.int32)

    h_p, h_s = x_prompt, x_sample
    new_p, new_s = [], []
    for l in range(DEPTH):
        lw = {
            'ffn1_pre_g': ffn1_pre_g[l], 'ffn1_w_gate': ffn1_w_gate[l], 'ffn1_w_up': ffn1_w_up[l],
            'ffn1_w_down': ffn1_w_down[l], 'ffn1_post_g': ffn1_post_g[l],
            'mix_pre_g': mix_pre_g[l], 'w_in': w_in[l],
            'mla_q_norm_g': mla_q_norm_g[l], 'mla_kv_norm_g': mla_kv_norm_g[l],
            'mla_w_uq': mla_w_uq[l], 'mla_w_uk': mla_w_uk[l], 'mla_w_uv': mla_w_uv[l],
            'conv_w': conv_w[l],
            'out_norm_mla_g': out_norm_mla_g[l], 'out_norm_conv_g': out_norm_conv_g[l],
            'out_norm_sb_g': out_norm_sb_g[l], 'w_o': w_o[l], 'mix_post_g': mix_post_g[l],
            'ffn2_pre_g': ffn2_pre_g[l], 'ffn2_w_gate': ffn2_w_gate[l], 'ffn2_w_up': ffn2_w_up[l],
            'ffn2_w_down': ffn2_w_down[l], 'ffn2_post_g': ffn2_post_g[l],
        }
        h_p, st_p = trunk_layer(h_p, pos_p, None, lw)
        past = (cache_mla_ckv[l], cache_mla_krope[l], cache_sb_k[l], cache_sb_v[l], state_conv[l])
        h_s, st_s = trunk_layer(h_s, pos_s, past, lw)
        new_p.append(st_p)
        new_s.append(st_s)

    def stacked(states, i):
        return jnp.stack([st[i] for st in states], axis=0)

    return (h_p, h_s,
            stacked(new_p, 0), stacked(new_p, 1), stacked(new_p, 2), stacked(new_p, 3), stacked(new_p, 4),
            stacked(new_s, 0), stacked(new_s, 1), stacked(new_s, 2), stacked(new_s, 3), stacked(new_s, 4))
```

```cpp
#include <hip/hip_runtime.h>
#include <cstdio>
#include <cstdint>
namespace pg8 {
#define PG8_LAS __attribute__((address_space(3)))
typedef unsigned short bf16_t;
typedef short bf16x8 __attribute__((ext_vector_type(8)));
typedef float f32x4 __attribute__((ext_vector_type(4)));
typedef unsigned u32x4 __attribute__((ext_vector_type(4)));
constexpr int BM = 256, BK = 64, HALF = 128, HTB = HALF * BK * 2  , STAGE_BYTES = 8 * HTB, NXCD = 8, WGM = 8;

__host__ __device__ __forceinline__ int lds_byte(int r, int c) { const int st = (r >> 4) * 2 + (c >> 5), rr = r & 15, cc = c & 31, ob = rr * 64 + cc * 2; return st * 1024 + (ob ^ (((ob >> 9) & 1) << 5)); }
__host__ __device__ __forceinline__ void stage_rc(int b, int& R, int& C) { const int st = b / 1024, sb = b % 1024, swz = sb ^ (((sb >> 9) & 1) << 5); R = (st >> 1) * 16 + swz / 64; C = (st & 1) * 32 + (swz % 64) / 2; }
__host__ __device__ __forceinline__ int perm32(int rho) { const int n = rho >> 4, i = rho & 15; return 8 * (i >> 2) + 4 * n + (i & 3); }

struct Unit { int pm, pn; };
struct Gemm { const bf16_t* A; const bf16_t* Bt; int M, N, K; };

struct StaticOrder {
    int nM, nN, nwg, G, c;
    __host__ __device__ void init(int M, int N, int G_, int c_) { nM = M / BM; nN = N / BM; nwg = nM * nN; G = G_; c = c_; }
    __host__ __device__ bool next(int i, Unit& u) const {
        const long L = (long)i * G + c; if (L >= nwg) return false;
        int wgid = (int)L; { const int q = nwg / NXCD, r = nwg % NXCD, xcd = wgid % NXCD, off = wgid / NXCD; wgid = (xcd < r ? xcd * (q + 1) : r * (q + 1) + (xcd - r) * q) + off; }
        const int nig = WGM * nN, gid = wgid / nig, fm = gid * WGM, gsz = (nM - fm) < WGM ? (nM - fm) : WGM;
        u.pm = fm + ((wgid % nig) % gsz); u.pn = (wgid % nig) / gsz; return true;
    }
    __device__ __forceinline__ void a_ready(const Unit&) const {}
    __device__ __forceinline__ void done(const Unit&) const {}
};

__device__ __forceinline__ unsigned cvt_pk_bf16(float lo, float hi) { unsigned r; asm volatile("v_cvt_pk_bf16_f32 %0, %1, %2" : "=v"(r) : "v"(lo), "v"(hi)); return r; }
typedef unsigned u32x2 __attribute__((ext_vector_type(2)));

struct EpiF32 {
    static constexpr bool PERM = false, AFTER_DRAIN = false;
    float* C; int ldc;
    __device__ __forceinline__ void operator()(const f32x4 (&acc)[2][2][4][2], const Unit& u, int wr, int wc, int fr, int fq) const {
        const int row0 = u.pm * BM + wr * 64 + fr, col0 = u.pn * BM + wc * 32 + 4 * fq;
#pragma unroll
        for (int ai = 0; ai < 2; ++ai)
#pragma unroll
            for (int m = 0; m < 4; ++m) { float* rowp = C + (size_t)(row0 + ai * HALF + m * 16) * ldc + col0;
#pragma unroll
                for (int bj = 0; bj < 2; ++bj)
#pragma unroll
                    for (int n = 0; n < 2; ++n) *(f32x4*)(rowp + bj * HALF + n * 16) = acc[ai][bj][m][n]; }
    }
};
struct EpiBf16 {
    static constexpr bool PERM = true, AFTER_DRAIN = false;
    bf16_t* O; int ldc;
    __device__ __forceinline__ void operator()(const f32x4 (&acc)[2][2][4][2], const Unit& u, int wr, int wc, int fr, int fq) const {
        const int row0 = u.pm * BM + wr * 64 + fr, col0 = u.pn * BM + wc * 32 + 8 * fq;
#pragma unroll
        for (int ai = 0; ai < 2; ++ai)
#pragma unroll
            for (int m = 0; m < 4; ++m) { bf16_t* rowp = O + (size_t)(row0 + ai * HALF + m * 16) * ldc + col0;
#pragma unroll
                for (int bj = 0; bj < 2; ++bj) { const f32x4 v0 = acc[ai][bj][m][0], v1 = acc[ai][bj][m][1];
                    u32x4 w; w.x = cvt_pk_bf16(v0[0], v0[1]); w.y = cvt_pk_bf16(v0[2], v0[3]); w.z = cvt_pk_bf16(v1[0], v1[1]); w.w = cvt_pk_bf16(v1[2], v1[3]);
                    *(u32x4*)(rowp + bj * HALF) = w; } }
    }
};
struct EpiSwiGLU {
    static constexpr bool PERM = true, AFTER_DRAIN = false;
    bf16_t* O; int ldc;
    __device__ __forceinline__ static float silu_mul(float g, float u) { const float e = __builtin_amdgcn_exp2f(-g * 1.4426950408889634f); return g * u * __builtin_amdgcn_rcpf(1.0f + e); }
    __device__ __forceinline__ void operator()(const f32x4 (&acc)[2][2][4][2], const Unit& u, int wr, int wc, int fr, int fq) const {
        const int row0 = u.pm * BM + wr * 64 + fr, col0 = u.pn * HALF + wc * 32 + 8 * fq;
#pragma unroll
        for (int ai = 0; ai < 2; ++ai)
#pragma unroll
            for (int m = 0; m < 4; ++m) { bf16_t* rowp = O + (size_t)(row0 + ai * HALF + m * 16) * ldc + col0;
                const f32x4 g0 = acc[ai][0][m][0], g1 = acc[ai][0][m][1], u0 = acc[ai][1][m][0], u1 = acc[ai][1][m][1];
                u32x4 w; w.x = cvt_pk_bf16(silu_mul(g0[0], u0[0]), silu_mul(g0[1], u0[1])); w.y = cvt_pk_bf16(silu_mul(g0[2], u0[2]), silu_mul(g0[3], u0[3]));
                w.z = cvt_pk_bf16(silu_mul(g1[0], u1[0]), silu_mul(g1[1], u1[1])); w.w = cvt_pk_bf16(silu_mul(g1[2], u1[2]), silu_mul(g1[3], u1[3]));
                *(u32x4*)rowp = w; }
    }
};
template <int NH> struct EpiKBlk {
    static constexpr bool PERM = true, AFTER_DRAIN = false;
    unsigned char* O;
    __device__ __forceinline__ void operator()(const f32x4 (&acc)[2][2][4][2], const Unit& u, int wr, int wc, int fr, int fq) const {
        unsigned char* base = O + ((size_t)((4 * u.pm + wr) * NH + 2 * u.pn)) * 16384 + (4 * wc + fq) * 1024 + fr * 16;
#pragma unroll
        for (int ai = 0; ai < 2; ++ai)
#pragma unroll
            for (int m = 0; m < 4; ++m)
#pragma unroll
                for (int bj = 0; bj < 2; ++bj) { const f32x4 v0 = acc[ai][bj][m][0], v1 = acc[ai][bj][m][1];
                    u32x4 w; w.x = cvt_pk_bf16(v0[0], v0[1]); w.y = cvt_pk_bf16(v0[2], v0[3]); w.z = cvt_pk_bf16(v1[0], v1[1]); w.w = cvt_pk_bf16(v1[2], v1[3]);
                    *(u32x4*)(base + ai * (2 * NH * 16384) + bj * 16384 + m * 256) = w; }
    }
};
template <bool TOK, int NH> struct EpiVtBlk {
    static constexpr bool PERM = false, AFTER_DRAIN = false;
    unsigned char* O;
    __device__ __forceinline__ void operator()(const f32x4 (&acc)[2][2][4][2], const Unit& u, int wr, int wc, int fr, int fq) const {
        const bool smp = TOK && u.pn >= 32;
        const int tile0 = smp ? 160 + 33 * (4 * (u.pn - 32) + (wc >> 1)) : 4 * u.pn + (wc >> 1);
        const unsigned bjs = smp ? 66u * NH * 16384u : 2u * NH * 16384u;
        unsigned char* base = O + ((size_t)(tile0 * NH + 2 * u.pm)) * 16384 + (4 * (wc & 1) + (fq & 1)) * 2048 + (wr * 64 + fr) * 16 + 8 * (fq >> 1);
#pragma unroll
        for (int bj = 0; bj < 2; ++bj) { unsigned char* bb = base + (size_t)bj * bjs;
#pragma unroll
            for (int ai = 0; ai < 2; ++ai)
#pragma unroll
                for (int m = 0; m < 4; ++m)
#pragma unroll
                    for (int n = 0; n < 2; ++n) { const f32x4 v = acc[ai][bj][m][n];
                        u32x2 w; w.x = cvt_pk_bf16(v[0], v[1]); w.y = cvt_pk_bf16(v[2], v[3]);
                        *(u32x2*)(bb + ai * 16384 + m * 256 + n * 4096) = w; } }
    }
};

template <class Epi, class Sched, bool ALIGN_EPI = false, bool SP2 = false>
__device__ __forceinline__ void gemm_phase(PG8_LAS unsigned char* lds, const Gemm g, const Sched& S, const Epi& E) {
    int tid_ = threadIdx.x; asm volatile("" : "+v"(tid_));
    const int tid = tid_, wid = __builtin_amdgcn_readfirstlane(tid >> 6), lane = tid & 63, wr = wid >> 2, wc = wid & 3, fr = lane & 15, fq = lane >> 4;
    const int K = g.K, nt = K / BK;
    unsigned voffA[2], voffB[2];
#pragma unroll
    for (int i = 0; i < 2; ++i) { int R, C; stage_rc(tid * 16 + i * 8192, R, C); const int Rb = Epi::PERM ? ((R & ~31) + perm32(R & 31)) : R;
        voffA[i] = (unsigned)(R * K + C) * 2u; voffB[i] = (unsigned)(Rb * K + C) * 2u; }
    const size_t kstep = (size_t)(BK * 2);
    const size_t hstep = (size_t)HALF * K * 2;
    const size_t tstep = 2 * hstep;
    const unsigned ldsw = (unsigned)wid * 1024u;
    const int aoff = lds_byte(wr * 64 + fr, fq * 8), boff = lds_byte(wc * 32 + fr, fq * 8);
#define PG8_SA(b, h) (((b) * 2 + (h)) * HTB)
#define PG8_SB(b, h) ((4 + (b) * 2 + (h)) * HTB)
#define PG8_STAGE(bufoff, gbase, voff) do { _Pragma("unroll") for (int _i = 0; _i < 2; ++_i) \
        __builtin_amdgcn_global_load_lds((const unsigned*)((const char*)(gbase) + (voff)[_i]), (PG8_LAS unsigned*)(lds + (bufoff) + ldsw + _i * 8192), 16, 0, 0); } while (0)
#define PG8_LDA(dst, b, h) do { _Pragma("unroll") for (int m = 0; m < 4; ++m) _Pragma("unroll") for (int k = 0; k < 2; ++k) dst[m][k] = *(const PG8_LAS bf16x8*)(lds + PG8_SA(b, h) + aoff + m * 2048 + k * 1024); } while (0)
#define PG8_LDB(dst, b, h) do { _Pragma("unroll") for (int n = 0; n < 2; ++n) _Pragma("unroll") for (int k = 0; k < 2; ++k) dst[n][k] = *(const PG8_LAS bf16x8*)(lds + PG8_SB(b, h) + boff + n * 2048 + k * 1024); } while (0)
#define PG8_MMA(ai, bj, At, Bt) do { __builtin_amdgcn_s_setprio(1); _Pragma("unroll") for (int m = 0; m < 4; ++m) _Pragma("unroll") for (int n = 0; n < 2; ++n) _Pragma("unroll") for (int k = 0; k < 2; ++k) \
        acc[ai][bj][m][n] = __builtin_amdgcn_mfma_f32_16x16x32_bf16(Bt[n][k], At[m][k], acc[ai][bj][m][n], 0, 0, 0); __builtin_amdgcn_s_setprio(0); } while (0)
#define PG8_WAIT_V(n) asm volatile("s_waitcnt vmcnt(" #n ")" ::: "memory")
#define PG8_WAIT_L(n) asm volatile("s_waitcnt lgkmcnt(" #n ")" ::: "memory")
#define PG8_BAR __builtin_amdgcn_s_barrier()
#define PG8_SCHED __builtin_amdgcn_sched_barrier(0)
    Unit cur, nxt; int ui = 0;
    if (!S.next(0, cur)) return;
    f32x4 acc[2][2][4][2];
#pragma unroll
    for (int a = 0; a < 2; ++a)
#pragma unroll
        for (int b = 0; b < 2; ++b)
#pragma unroll
            for (int m = 0; m < 4; ++m)
#pragma unroll
                for (int n = 0; n < 2; ++n) acc[a][b][m][n] = (f32x4){0.f, 0.f, 0.f, 0.f};
    bf16x8 At[4][2], B0[2][2], B1[2][2];
    const char* cA = (const char*)g.A + (size_t)cur.pm * tstep; const char* cB = (const char*)g.Bt + (size_t)cur.pn * tstep;
    S.a_ready(cur);
    if constexpr (SP2) {
        PG8_STAGE(PG8_SB(0, 0), cB, voffB); PG8_STAGE(PG8_SB(0, 1), cB + hstep, voffB); PG8_STAGE(PG8_SA(0, 0), cA, voffA); PG8_STAGE(PG8_SA(0, 1), cA + hstep, voffA);
        if (wr == 1) PG8_BAR;
        PG8_WAIT_V(2); PG8_BAR;
        PG8_STAGE(PG8_SB(1, 0), cB + kstep, voffB); PG8_STAGE(PG8_SA(1, 0), cA + kstep, voffA); PG8_STAGE(PG8_SB(1, 1), cB + hstep + kstep, voffB);
        PG8_WAIT_V(6); PG8_BAR;
    } else {
        PG8_STAGE(PG8_SB(0, 0), cB, voffB); PG8_STAGE(PG8_SA(0, 0), cA, voffA); PG8_STAGE(PG8_SB(0, 1), cB + hstep, voffB); PG8_STAGE(PG8_SA(0, 1), cA + hstep, voffA);
        if (wr == 1) PG8_BAR;
        PG8_WAIT_V(4); PG8_BAR;
        PG8_STAGE(PG8_SB(1, 0), cB + kstep, voffB); PG8_STAGE(PG8_SA(1, 0), cA + kstep, voffA); PG8_STAGE(PG8_SB(1, 1), cB + hstep + kstep, voffB);
        PG8_WAIT_V(6); PG8_BAR;
    }
    for (;;) {
        const bool has_next = S.next(ui + 1, nxt);
        const char* nA = has_next ? (const char*)g.A + (size_t)nxt.pm * tstep : cA; const char* nB = has_next ? (const char*)g.Bt + (size_t)nxt.pn * tstep : cB;
        for (int t = 0; t < nt; t += 2) {
            const bool last = (t == nt - 2);
            const char* a1 = cA + (size_t)(t + 1) * kstep;
            const char* a2 = last ? nA : cA + (size_t)(t + 2) * kstep; const char* b2 = last ? nB : cB + (size_t)(t + 2) * kstep;
            const char* a3 = a2 + kstep; const char* b3 = b2 + kstep;
            if (last && has_next) S.a_ready(nxt);
            if constexpr (SP2) {
            PG8_LDB(B0, 0, 0); PG8_LDB(B1, 0, 1); PG8_SCHED; PG8_LDA(At, 0, 0); PG8_STAGE(PG8_SA(1, 1), a1 + hstep, voffA);
            PG8_WAIT_V(8); PG8_WAIT_L(0); PG8_BAR; PG8_MMA(0, 0, At, B0); PG8_MMA(0, 1, At, B1); PG8_BAR; PG8_SCHED;
            PG8_LDA(At, 0, 1); PG8_STAGE(PG8_SB(0, 0), b2, voffB); PG8_STAGE(PG8_SB(0, 1), b2 + hstep, voffB); PG8_STAGE(PG8_SA(0, 0), a2, voffA);
            PG8_WAIT_V(8); PG8_WAIT_L(0); PG8_BAR; PG8_MMA(1, 0, At, B0); PG8_MMA(1, 1, At, B1); PG8_BAR; PG8_SCHED;
            PG8_LDB(B0, 1, 0); PG8_LDB(B1, 1, 1); PG8_SCHED; PG8_LDA(At, 1, 0); PG8_STAGE(PG8_SA(0, 1), a2 + hstep, voffA);
            PG8_WAIT_V(8); PG8_WAIT_L(0); PG8_BAR; PG8_MMA(0, 0, At, B0); PG8_MMA(0, 1, At, B1); PG8_BAR; PG8_SCHED;
            PG8_LDA(At, 1, 1); PG8_STAGE(PG8_SB(1, 0), b3, voffB); PG8_STAGE(PG8_SB(1, 1), b3 + hstep, voffB); PG8_STAGE(PG8_SA(1, 0), a3, voffA);
            PG8_WAIT_V(8); PG8_WAIT_L(0); PG8_BAR; PG8_MMA(1, 0, At, B0); PG8_MMA(1, 1, At, B1); PG8_BAR; PG8_SCHED;
            } else {
            PG8_LDB(B0, 0, 0); PG8_SCHED; PG8_LDA(At, 0, 0); PG8_STAGE(PG8_SA(1, 1), a1 + hstep, voffA);
            PG8_WAIT_L(8); PG8_BAR; PG8_WAIT_L(0); PG8_MMA(0, 0, At, B0); PG8_BAR; PG8_SCHED;
            PG8_LDB(B1, 0, 1); PG8_STAGE(PG8_SB(0, 0), b2, voffB);
            PG8_BAR; PG8_WAIT_L(0); PG8_MMA(0, 1, At, B1); PG8_BAR;
            PG8_LDA(At, 0, 1); PG8_STAGE(PG8_SA(0, 0), a2, voffA);
            PG8_BAR; PG8_WAIT_L(0); PG8_MMA(1, 0, At, B0); PG8_BAR; PG8_SCHED;
            PG8_STAGE(PG8_SB(0, 1), b2 + hstep, voffB);
            PG8_WAIT_V(6); PG8_BAR; PG8_MMA(1, 1, At, B1); PG8_BAR;
            PG8_LDB(B0, 1, 0); PG8_SCHED; PG8_LDA(At, 1, 0); PG8_STAGE(PG8_SA(0, 1), a2 + hstep, voffA);
            PG8_WAIT_L(8); PG8_BAR; PG8_WAIT_L(0); PG8_MMA(0, 0, At, B0); PG8_BAR; PG8_SCHED;
            PG8_LDB(B1, 1, 1); PG8_STAGE(PG8_SB(1, 0), b3, voffB);
            PG8_BAR; PG8_WAIT_L(0); PG8_MMA(0, 1, At, B1); PG8_BAR;
            PG8_LDA(At, 1, 1); PG8_STAGE(PG8_SA(1, 0), a3, voffA);
            PG8_BAR; PG8_WAIT_L(0); PG8_MMA(1, 0, At, B0); PG8_BAR; PG8_SCHED;
            PG8_STAGE(PG8_SB(1, 1), b3 + hstep, voffB);
            PG8_WAIT_V(6); PG8_BAR; PG8_MMA(1, 1, At, B1); PG8_BAR;
            }
        }
        if constexpr (ALIGN_EPI) { if (wr == 0) PG8_BAR; }
        if constexpr (!Epi::AFTER_DRAIN) { E(acc, cur, wr, wc, fr, fq); S.done(cur); }
        if (!has_next) break;
#pragma unroll
        for (int a = 0; a < 2; ++a)
#pragma unroll
            for (int b = 0; b < 2; ++b)
#pragma unroll
                for (int m = 0; m < 4; ++m)
#pragma unroll
                    for (int n = 0; n < 2; ++n) acc[a][b][m][n] = (f32x4){0.f, 0.f, 0.f, 0.f};
        cur = nxt; cA = nA; cB = nB; ++ui;
        if constexpr (ALIGN_EPI) { if (wr == 1) PG8_BAR; }
    }
    PG8_WAIT_V(0);
    if constexpr (!ALIGN_EPI) { if (wr == 0) PG8_BAR; }
    PG8_BAR;
    if constexpr (Epi::AFTER_DRAIN) { E.fused(acc, cur, wr, wc, fr, fq, lds, wid, lane); S.done(cur); }
#undef PG8_SA
#undef PG8_SB
#undef PG8_STAGE
#undef PG8_LDA
#undef PG8_LDB
#undef PG8_MMA
#undef PG8_WAIT_V
#undef PG8_WAIT_L
#undef PG8_BAR
#undef PG8_SCHED
}
}

constexpr int NWAVES = 8;
constexpr int DM = 2048, TP = 8192, TS = 1024, MT = TP + TS, DFF = 5632, DEPTH = 2;
constexpr int DIN = 4160, DINP = 4352;
constexpr int ZC_CQ = 0, ZC_CKV = 512, ZC_KR = 1024, ZC_GB = 1088, ZC_GC = 1600, ZC_XC = 2112, ZC_QSB = 2624, ZC_KSB = 3136, ZC_VSB = 3648;
constexpr int NKEY = 41984, NTILE = 656;
constexpr int QW = 1536;
constexpr int YW = 1536;
constexpr float EPS = 1e-6f;
constexpr float LOG2E = 1.4426950408889634f, LN2 = 0.6931471805599453f;
constexpr float MLA_QSCALE = 0.07216878364870322f * LOG2E;
constexpr float SB_QSCALE = 0.08838834764831845f;
constexpr float SB_EXIT = -104.0f;

constexpr size_t O_Y = 0;
constexpr size_t O_CKV_P = 18874368, O_KR_P = 27262976, O_SBK_P = 28311552, O_SBV_P = 36700160, O_CONV_P = 45088768;
constexpr size_t O_CKV_S = 45092864, O_KR_S = 46141440, O_SBK_S = 46272512, O_SBV_S = 47321088, O_CONV_S = 48369664, O_END = 48402432;

constexpr size_t WS_CTL = 0, CTL_ZERO_BYTES = 1u << 20;
constexpr size_t WS_ROPE = 1u << 20;
constexpr size_t WS_W = 2u << 20;
constexpr size_t W_GU1 = 0, SZ_GU = (size_t)2 * DFF * DM * 2, W_D1 = W_GU1 + SZ_GU, SZ_D = (size_t)DM * DFF * 2, W_GU2 = W_D1 + SZ_D, W_D2 = W_GU2 + SZ_GU;
constexpr size_t W_IN = W_D2 + SZ_D, SZ_IN = (size_t)DINP * DM * 2, W_UQ = W_IN + SZ_IN, SZ_UQ = (size_t)1536 * 512 * 2, W_UKV = W_UQ + SZ_UQ, SZ_UKV = (size_t)2048 * 512 * 2;
constexpr size_t W_O = W_UKV + SZ_UKV, SZ_O = (size_t)DM * DM * 2, W_LAYER = W_O + SZ_O;
constexpr size_t WS_C = WS_W + DEPTH * W_LAYER;
constexpr size_t C_CKV = 0, SZ_CKV = (size_t)NKEY * 512 * 2, C_KR = C_CKV + SZ_CKV, SZ_KR = (size_t)NTILE * 8192, C_KSB = C_KR + SZ_KR, SZ_KSB = (size_t)NTILE * 4 * 16384;
constexpr size_t C_VTSB = C_KSB + SZ_KSB, C_LAYER = C_VTSB + SZ_KSB;
constexpr size_t WS_XN = WS_C + DEPTH * C_LAYER, SZ_XN = (size_t)MT * DM * 2;
constexpr size_t WS_F = WS_XN + SZ_XN, SZ_F = (size_t)MT * DM * 4;
constexpr size_t WS_MIX = WS_F + SZ_F;
constexpr size_t WS_HID = WS_MIX, SZ_HID = (size_t)MT * DFF * 2;
constexpr size_t WS_Z = WS_MIX, SZ_Z = (size_t)MT * DINP * 2, WS_CQN = WS_Z + SZ_Z, SZ_CQN = (size_t)MT * 512 * 2, WS_Q = WS_CQN + SZ_CQN, SZ_Q = (size_t)MT * QW * 2;
constexpr size_t WS_KN = WS_Q + SZ_Q, SZ_KN = (size_t)NTILE * 8 * 16384, WS_VT = WS_KN + SZ_KN, WS_YATT = WS_VT + SZ_KN, SZ_YATT = (size_t)MT * YW * 2;
constexpr size_t WS_END = WS_YATT + SZ_YATT;
static_assert(WS_HID + SZ_HID <= WS_END, "hidden overlay");
static_assert(WS_END <= 1160000000ull, "workspace");
constexpr int CW_TMO = 0, CW_CODE = 1;
constexpr int CW_BAR = 4096;
constexpr int CW_QUEUE = 16384;

constexpr int RING_BYTES = 131072;
constexpr int LDS_BYTES = 147456;
constexpr int MISC_OFF = LDS_BYTES - 256;

#define GAS __attribute__((address_space(1)))
#define LAS __attribute__((address_space(3)))
typedef unsigned short bf16;
typedef unsigned v4u __attribute__((ext_vector_type(4)));
typedef float f32x4 __attribute__((ext_vector_type(4)));
typedef short bf16x8 __attribute__((ext_vector_type(8)));
typedef GAS unsigned gu32;
typedef GAS unsigned long long gu64;
#define RLX_AGENT __ATOMIC_RELAXED, __HIP_MEMORY_SCOPE_AGENT
#define LDS_WAIT() asm volatile("s_waitcnt lgkmcnt(0)" ::: "memory")
#define VM_WAIT() asm volatile("s_waitcnt vmcnt(0)" ::: "memory")
__device__ __forceinline__ unsigned long long rt() { return __builtin_amdgcn_s_memrealtime(); }
__device__ __forceinline__ unsigned f2bf(float f) { unsigned u = __builtin_bit_cast(unsigned, f); return (u + 0x7fffu + ((u >> 16) & 1u)) >> 16; }
__device__ __forceinline__ unsigned pk2(float lo, float hi) { return f2bf(lo) | (f2bf(hi) << 16); }

#define XB_TMO      128
#define XB_XCNT(j)  (256  + 64 * (j))
#define XB_XSUB(j)  (1280 + 64 * (j))
#define XB_XGEN(j)  (2304 + 64 * (j))
#define XB_TOP      3328
#define XB_TOPGEN   3392
#define XCD_BAR_WORDS 3456
#define XB_SPIN_CAP (1u << 18)

__device__ __forceinline__ unsigned xb_ld(unsigned* p)              { return __hip_atomic_load(p, __ATOMIC_RELAXED, __HIP_MEMORY_SCOPE_AGENT); }
__device__ __forceinline__ unsigned xb_add(unsigned* p, unsigned v) { return __hip_atomic_fetch_add(p, v, __ATOMIC_RELAXED, __HIP_MEMORY_SCOPE_AGENT); }
__device__ __forceinline__ unsigned xb_xcc_id() { return (unsigned)__builtin_amdgcn_s_getreg((3 << 11) | 20) & 0xFu; }
#define XB_SPIN(cond, bar) do { unsigned _sp = 0; while (cond) { __builtin_amdgcn_s_sleep(1); \
    if ((++_sp & 255u) == 0u) { if (xb_ld(&(bar)[XB_TMO])) break; if (_sp > XB_SPIN_CAP) { atomicAdd(&(bar)[XB_TMO], 1u); break; } } } } while (0)

struct XcdBarrier {
    unsigned* bar; unsigned x;
    volatile LAS unsigned* st;
};

__device__ __forceinline__ XcdBarrier xcd_barrier_post(unsigned* bar, volatile LAS unsigned* st) {
    XcdBarrier b; b.bar = bar; b.x = xb_xcc_id(); b.st = st;
    if (threadIdx.x == 0) (void)xb_add(&bar[XB_XCNT(b.x)], 1u);
    return b;
}
__device__ __forceinline__ void xcd_barrier_complete(unsigned* bar, unsigned x, unsigned& nloc, unsigned& nx) {
    const unsigned G = gridDim.x * gridDim.y * gridDim.z;
    unsigned sum, cnt, mine, sp = 0u;
    for (;;) {
        sum = 0u; cnt = 0u; mine = 0u;
#pragma unroll 1
        for (unsigned j = 0; j < 16; ++j) { const unsigned c = xb_ld(&bar[XB_XCNT(j)]); sum += c; cnt += (c > 0u) ? 1u : 0u; mine = (j == x) ? c : mine; }
        if (sum == G) break;
        __builtin_amdgcn_s_sleep(1);
        if ((++sp & 255u) == 0u) { if (xb_ld(&bar[XB_TMO])) break; if (sp > XB_SPIN_CAP) { atomicAdd(&bar[XB_TMO], 1u); break; } }
    }
    nloc = mine > 0u ? mine : 1u; nx = cnt > 0u ? cnt : 1u;
}

__device__ __forceinline__ void xcd_barrier(const XcdBarrier& b) {
    asm volatile("s_waitcnt vmcnt(0)" ::: "memory");
    __syncthreads();
    if (threadIdx.x == 0) {
        unsigned* bar = b.bar;
        __builtin_amdgcn_s_waitcnt(0);
        unsigned nloc = b.st[0], nx = b.st[1];
        if (nloc == 0u) { xcd_barrier_complete(bar, b.x, nloc, nx); b.st[0] = nloc; b.st[1] = nx; }
        const unsigned old = xb_add(&bar[XB_XSUB(b.x)], 1u);
        const unsigned gen = old / nloc;
        if (old + 1u == (gen + 1u) * nloc) {
            __builtin_amdgcn_fence(__ATOMIC_RELEASE, "agent");
            asm volatile("s_waitcnt vmcnt(0)" ::: "memory");
            const unsigned og = xb_add(&bar[XB_TOP], 1u);
            const unsigned tg = og / nx;
            if (og + 1u == (tg + 1u) * nx) xb_add(&bar[XB_TOPGEN], 1u);
            else XB_SPIN(xb_ld(&bar[XB_TOPGEN]) == tg, bar);
            __builtin_amdgcn_fence(__ATOMIC_ACQUIRE, "agent");
            xb_add(&bar[XB_XGEN(b.x)], 1u);
            asm volatile("s_waitcnt vmcnt(0)" ::: "memory");
        } else {
            XB_SPIN(xb_ld(&bar[XB_XGEN(b.x)]) == gen, bar);
            __builtin_amdgcn_fence(__ATOMIC_ACQUIRE, "agent");
            asm volatile("s_waitcnt vmcnt(0)" ::: "memory");
        }
    }
    __syncthreads();
}

typedef unsigned u32x2v __attribute__((ext_vector_type(2)));
typedef float f32x16 __attribute__((ext_vector_type(16)));
struct Args { const float* in[30]; float* out; unsigned char* ws; int ph_lo, ph_hi; };
struct Frame {
    LAS unsigned char* lds;
    volatile LAS unsigned* MISC;
    gu32* ctl;
    int tid, lane, wave;
    int gw, ngw;
};
constexpr int PARAM_OFF = MISC_OFF - 512;
__device__ __forceinline__ unsigned long long ldparam(LAS unsigned char* lds, int k) {
    volatile LAS unsigned* p = (volatile LAS unsigned*)(lds + PARAM_OFF) + 2 * k;
    const unsigned lo = __builtin_amdgcn_readfirstlane(p[0]), hi = __builtin_amdgcn_readfirstlane(p[1]);
    return ((unsigned long long)hi << 32) | lo;
}
#define PIN(k) ((const float*)(const GAS float*)ldparam(F.lds, (k)))
#define POUT() ((float*)(GAS float*)ldparam(F.lds, 30))
#define PWS() ((unsigned char*)(GAS unsigned char*)ldparam(F.lds, 31))
__device__ __forceinline__ float wave_sum(float v) {
#pragma unroll
    for (int o = 1; o < 64; o <<= 1) v += __shfl_xor(v, o);
    return v;
}
__device__ __forceinline__ unsigned pkbf(float lo, float hi) { return pg8::cvt_pk_bf16(lo, hi); }
__device__ __forceinline__ float bflo(unsigned w) { return __uint_as_float(w << 16); }
__device__ __forceinline__ float bfhi(unsigned w) { return __uint_as_float(w & 0xffff0000u); }
__device__ __forceinline__ void unpack8(const v4u w, float (&f)[8]) { f[0] = bflo(w.x); f[1] = bfhi(w.x); f[2] = bflo(w.y); f[3] = bfhi(w.y); f[4] = bflo(w.z); f[5] = bfhi(w.z); f[6] = bflo(w.w); f[7] = bfhi(w.w); }
__device__ __forceinline__ v4u pack8(const float (&f)[8]) { v4u w; w.x = pkbf(f[0], f[1]); w.y = pkbf(f[2], f[3]); w.z = pkbf(f[4], f[5]); w.w = pkbf(f[6], f[7]); return w; }
__device__ __forceinline__ void ld8f(const float* p, float (&f)[8]) { const f32x4 a = *(const f32x4*)p, b = *(const f32x4*)(p + 4); f[0] = a.x; f[1] = a.y; f[2] = a.z; f[3] = a.w; f[4] = b.x; f[5] = b.y; f[6] = b.z; f[7] = b.w; }
__device__ __forceinline__ void st8f(float* p, const float (&f)[8]) { *(f32x4*)p = (f32x4){f[0], f[1], f[2], f[3]}; *(f32x4*)(p + 4) = (f32x4){f[4], f[5], f[6], f[7]}; }

__device__ __forceinline__ void transpose_item(const float* W, int K, int N, bf16* WT, int k0, int n0, int drow, float scale, LAS float* scr, int lane) {
    const int kr = lane >> 4, nc = (lane & 15) * 4;
#pragma unroll 4
    for (int i = 0; i < 16; ++i) { const int kk = 4 * i + kr; const f32x4 v = *(const f32x4*)(W + (size_t)(k0 + kk) * N + n0 + nc);
        LAS float* s = scr + kk * 65 + nc; s[0] = v.x * scale; s[1] = v.y * scale; s[2] = v.z * scale; s[3] = v.w * scale; }
    LDS_WAIT(); asm volatile("" ::: "memory");
    const int c = lane & 7;
#pragma unroll
    for (int j = 0; j < 8; ++j) { const int n = (lane >> 3) + 8 * j; const LAS float* s = scr + (8 * c) * 65 + n;
        v4u o; o.x = pkbf(s[0 * 65], s[1 * 65]); o.y = pkbf(s[2 * 65], s[3 * 65]); o.z = pkbf(s[4 * 65], s[5 * 65]); o.w = pkbf(s[6 * 65], s[7 * 65]);
        *(v4u*)(WT + (size_t)(drow + n) * K + k0 + 8 * c) = o; }
    LDS_WAIT(); asm volatile("" ::: "memory");
}
template <class RowMap>
__device__ __forceinline__ void transpose_matrix(Frame& F, const float* W, int K, int N, bf16* WT, float scale_lo, int sc_n0, int sc_n1, float scale_in, RowMap rm, int& base) {
    LAS float* scr = (LAS float*)(F.lds + F.wave * 16640);
    const int nkb = K / 64, nnb = N / 64, nit = nkb * nnb;
    int it = (F.gw - base % F.ngw + F.ngw) % F.ngw;
    for (; it < nit; it += F.ngw) { const int kb = it / nnb, nb = it % nnb, n0 = nb * 64;
        const float sc = (n0 >= sc_n0 && n0 < sc_n1) ? scale_in : scale_lo;
        transpose_item(W, K, N, WT, kb * 64, n0, rm(n0), sc, scr, F.lane); }
    base += nit;
}
struct RmIdent { __device__ __forceinline__ int operator()(int n0) const { return n0; } };
struct RmOff { int off; __device__ __forceinline__ int operator()(int n0) const { return n0 + off; } };
struct RmGU { int up; __device__ __forceinline__ int operator()(int n0) const { return 256 * (n0 >> 7) + (n0 & 127) + 128 * up; } };

__device__ __forceinline__ void rms_row_to_bf16(Frame& F, const float* xrow, const float* g, bf16* orow) {
    f32x4 v[8]; float s = 0.f;
#pragma unroll
    for (int j = 0; j < 8; ++j) { v[j] = *((const f32x4*)xrow + F.lane + 64 * j); s += (v[j].x * v[j].x + v[j].y * v[j].y) + (v[j].z * v[j].z + v[j].w * v[j].w); }
    const float rstd = 1.0f / sqrtf(wave_sum(s) * (1.0f / DM) + EPS);
#pragma unroll
    for (int j = 0; j < 8; ++j) { const f32x4 gg = *((const f32x4*)g + F.lane + 64 * j); u32x2v w; w.x = pkbf(v[j].x * rstd * gg.x, v[j].y * rstd * gg.y); w.y = pkbf(v[j].z * rstd * gg.z, v[j].w * rstd * gg.w);
        *((u32x2v*)orow + F.lane + 64 * j) = w; }
}

__device__ __forceinline__ void p0_prologue(Frame& F) {
    unsigned char* ws = PWS();
    int base = 0;
    for (int l = 0; l < DEPTH; ++l) {
        unsigned char* wl = ws + WS_W + (size_t)l * W_LAYER;
        transpose_matrix(F, PIN(8) + (size_t)l * DM * DFF, DM, DFF, (bf16*)(wl + W_GU1), 1.f, 0, 0, 1.f, RmGU{0}, base);
        transpose_matrix(F, PIN(9) + (size_t)l * DM * DFF, DM, DFF, (bf16*)(wl + W_GU1), 1.f, 0, 0, 1.f, RmGU{1}, base);
        transpose_matrix(F, PIN(10) + (size_t)l * DFF * DM, DFF, DM, (bf16*)(wl + W_D1), 1.f, 0, 0, 1.f, RmIdent{}, base);
        transpose_matrix(F, PIN(26) + (size_t)l * DM * DFF, DM, DFF, (bf16*)(wl + W_GU2), 1.f, 0, 0, 1.f, RmGU{0}, base);
        transpose_matrix(F, PIN(27) + (size_t)l * DM * DFF, DM, DFF, (bf16*)(wl + W_GU2), 1.f, 0, 0, 1.f, RmGU{1}, base);
        transpose_matrix(F, PIN(28) + (size_t)l * DFF * DM, DFF, DM, (bf16*)(wl + W_D2), 1.f, 0, 0, 1.f, RmIdent{}, base);
        transpose_matrix(F, PIN(13) + (size_t)l * DM * DIN, DM, DIN, (bf16*)(wl + W_IN), 1.f, ZC_QSB, ZC_KSB, SB_QSCALE, RmIdent{}, base);
        transpose_matrix(F, PIN(16) + (size_t)l * 512 * 1536, 512, 1536, (bf16*)(wl + W_UQ), MLA_QSCALE, 0, 0, 1.f, RmIdent{}, base);
        transpose_matrix(F, PIN(17) + (size_t)l * 512 * 1024, 512, 1024, (bf16*)(wl + W_UKV), 1.f, 0, 0, 1.f, RmIdent{}, base);
        transpose_matrix(F, PIN(18) + (size_t)l * 512 * 1024, 512, 1024, (bf16*)(wl + W_UKV), 1.f, 0, 0, 1.f, RmOff{1024}, base);
        transpose_matrix(F, PIN(23) + (size_t)l * DM * DM, DM, DM, (bf16*)(wl + W_O), 1.f, 0, 0, 1.f, RmIdent{}, base);
        { v4u* p = (v4u*)(wl + W_IN + (size_t)DIN * DM * 2); const int n16 = (DINP - DIN) * DM * 2 / 16;
          for (int i = F.gw * 64 + F.lane; i < n16; i += F.ngw * 64) p[i] = (v4u){0u, 0u, 0u, 0u}; }
    }
    { float* ct = (float*)(ws + WS_ROPE); float* st = ct + 4096 * 32;
      for (int i = F.gw * 64 + F.lane; i < 4096 * 32; i += F.ngw * 64) { const int pos = i >> 5, k = i & 31;
          const float inv = powf(10000.0f, -(float)k * (1.0f / 32.0f)); const float ang = (float)pos * inv; ct[i] = cosf(ang); st[i] = sinf(ang); } }
    for (int l = 0; l < DEPTH; ++l) {
        unsigned char* cl = ws + WS_C + (size_t)l * C_LAYER;
        { const float* src = PIN(2) + (size_t)l * 16 * 2048 * 512; bf16* dst = (bf16*)(cl + C_CKV);
          for (int r = F.gw; r < 16 * 2048; r += F.ngw) { const int s = r >> 11, p = r & 2047; float f[8]; ld8f(src + (size_t)r * 512 + 8 * F.lane, f);
              *(v4u*)(dst + (size_t)(8192 + s * 2112 + p) * 512 + 8 * F.lane) = pack8(f); } }
        { const float* src = PIN(3) + (size_t)l * 16 * 2048 * 64; unsigned char* dst = cl + C_KR;
          for (int it = F.gw; it < 16 * 32; it += F.ngw) { const int s = it >> 5, t = it & 31, tile = 128 + 33 * s + t; const float* rp = src + ((size_t)s * 2048 + t * 64 + F.lane) * 64;
#pragma unroll
              for (int c = 0; c < 8; ++c) { float f[8]; ld8f(rp + 8 * c, f); *(v4u*)(dst + ((size_t)(tile * 8 + c) * 64 + F.lane) * 16) = pack8(f); } } }
        { const float* src = PIN(4) + (size_t)l * 16 * 2048 * 512; unsigned char* dst = cl + C_KSB;
          for (int it = F.gw; it < 16 * 32 * 4; it += F.ngw) { const int h = it & 3, t = (it >> 2) & 31, s = it >> 7, tile = 128 + 33 * s + t; const int ks = F.lane >> 4, c = F.lane & 15;
#pragma unroll 4
              for (int i = 0; i < 16; ++i) { const int key = 4 * i + ks; float f[8]; ld8f(src + ((size_t)s * 2048 + t * 64 + key) * 512 + h * 128 + 8 * c, f);
                  *(v4u*)(dst + ((size_t)((tile * 4 + h) * 16 + c) * 64 + key) * 16) = pack8(f); } } }
        { const float* src = PIN(5) + (size_t)l * 16 * 2048 * 512; unsigned char* dst = cl + C_VTSB;
          for (int it = F.gw; it < 16 * 32 * 4 * 2; it += F.ngw) { const int dh = it & 1, h = (it >> 1) & 3, t = (it >> 3) & 31, s = it >> 8, tile = 128 + 33 * s + t; const int d = dh * 64 + F.lane;
              const float* cp = src + ((size_t)s * 2048 + t * 64) * 512 + h * 128 + d;
#pragma unroll
              for (int P = 0; P < 8; ++P) { float f[8];
#pragma unroll
                  for (int j = 0; j < 8; ++j) { const int key = 16 * (P >> 1) + 4 * (P & 1) + (j < 4 ? j : j + 4); f[j] = cp[(size_t)key * 512]; }
                  *(v4u*)(dst + ((size_t)((tile * 4 + h) * 8 + P) * 128 + d) * 16) = pack8(f); } } }
    }
    { bf16* xn = (bf16*)(ws + WS_XN);
      for (int m = F.gw; m < MT; m += F.ngw) { const float* xr = m < TP ? PIN(0) + (size_t)m * DM : PIN(1) + (size_t)(m - TP) * DM; rms_row_to_bf16(F, xr, PIN(7), xn + (size_t)m * DM); } }
}

__device__ __forceinline__ void norm_phase(Frame& F, const float* f, const float* hin_p, const float* hin_s, float coef, const float* g1, const float* g2, float* hout, bf16* xn) {
    for (int m = F.gw; m < MT; m += F.ngw) {
        const float* fr = f + (size_t)m * DM; const float* hr = m < TP ? hin_p + (size_t)m * DM : hin_s + (size_t)(m - TP) * DM;
        f32x4 v[8], hv[8]; float s = 0.f;
#pragma unroll
        for (int j = 0; j < 8; ++j) { v[j] = *((const f32x4*)fr + F.lane + 64 * j); hv[j] = *((const f32x4*)hr + F.lane + 64 * j); s += (v[j].x * v[j].x + v[j].y * v[j].y) + (v[j].z * v[j].z + v[j].w * v[j].w); }
        const float rstd = coef / sqrtf(wave_sum(s) * (1.0f / DM) + EPS); float s2 = 0.f;
#pragma unroll
        for (int j = 0; j < 8; ++j) { const f32x4 gg = *((const f32x4*)g1 + F.lane + 64 * j); hv[j] = hv[j] + v[j] * gg * rstd; *((f32x4*)(hout + (size_t)m * DM) + F.lane + 64 * j) = hv[j];
            s2 += (hv[j].x * hv[j].x + hv[j].y * hv[j].y) + (hv[j].z * hv[j].z + hv[j].w * hv[j].w); }
        if (g2) { const float r2 = 1.0f / sqrtf(wave_sum(s2) * (1.0f / DM) + EPS);
#pragma unroll
            for (int j = 0; j < 8; ++j) { const f32x4 gg = *((const f32x4*)g2 + F.lane + 64 * j); u32x2v w; w.x = pkbf(hv[j].x * r2 * gg.x, hv[j].y * r2 * gg.y); w.y = pkbf(hv[j].z * r2 * gg.z, hv[j].w * r2 * gg.w);
                *((u32x2v*)(xn + (size_t)m * DM) + F.lane + 64 * j) = w; } }
    }
}

__device__ __forceinline__ void postz_phase(Frame& F, int l) {
    unsigned char* ws = PWS(); const bf16* Z = (const bf16*)(ws + WS_Z); bf16* CQN = (bf16*)(ws + WS_CQN); bf16* MRG = (bf16*)(ws + WS_XN);
    unsigned char* cl = ws + WS_C + (size_t)l * C_LAYER; bf16* CKV = (bf16*)(cl + C_CKV);
    const float* ctab = (const float*)(ws + WS_ROPE); const float* stab = ctab + 4096 * 32;
    const float* gq = PIN(14) + l * 512; const float* gkv = PIN(15) + l * 512; const float* cw = PIN(19) + l * 3 * 512; const float* gcv = PIN(21) + l * 512;
    float* out = POUT(); const int L8 = 8 * F.lane;
    for (int r = F.gw; r < MT; r += F.ngw) {
        const bool smp = r >= TP; const int b = smp ? (r - TP) >> 6 : r >> 12, t = smp ? (r - TP) & 63 : r & 4095, pos = smp ? 2048 + t : t;
        const int g = smp ? 8192 + b * 2112 + 2048 + t : r, tile = g >> 6, kap = g & 63;
        const bf16* zr = Z + (size_t)r * DINP;
        { float f[8]; unpack8(*(const v4u*)(zr + ZC_CQ + L8), f); float s = 0.f;
#pragma unroll
          for (int i = 0; i < 8; ++i) s += f[i] * f[i];
          const float rs = 1.0f / sqrtf(wave_sum(s) * (1.0f / 512) + EPS); float gg[8]; ld8f(gq + L8, gg);
#pragma unroll
          for (int i = 0; i < 8; ++i) f[i] = f[i] * rs * gg[i];
          *(v4u*)(CQN + (size_t)r * 512 + L8) = pack8(f); }
        { float f[8]; unpack8(*(const v4u*)(zr + ZC_CKV + L8), f); float s = 0.f;
#pragma unroll
          for (int i = 0; i < 8; ++i) s += f[i] * f[i];
          const float rs = 1.0f / sqrtf(wave_sum(s) * (1.0f / 512) + EPS); float gg[8]; ld8f(gkv + L8, gg);
#pragma unroll
          for (int i = 0; i < 8; ++i) f[i] = f[i] * rs * gg[i];
          float* op = smp ? out + O_CKV_S + ((size_t)(l * 16 + b) * 64 + t) * 512 : out + O_CKV_P + ((size_t)(l * 2 + b) * 4096 + t) * 512;
          st8f(op + L8, f); *(v4u*)(CKV + (size_t)g * 512 + L8) = pack8(f); }
        { float f[8], p[8]; const int lz = F.lane & 7; unpack8(*(const v4u*)(zr + ZC_KR + 8 * lz), f);
#pragma unroll
          for (int i = 0; i < 8; ++i) p[i] = __shfl_xor(f[i], 4);
          float c[8], s[8]; ld8f(ctab + pos * 32 + 8 * (lz & 3), c); ld8f(stab + pos * 32 + 8 * (lz & 3), s);
#pragma unroll
          for (int i = 0; i < 8; ++i) f[i] = (lz < 4) ? f[i] * c[i] - p[i] * s[i] : f[i] * c[i] + p[i] * s[i];
          if (F.lane < 8) { float* op = smp ? out + O_KR_S + ((size_t)(l * 16 + b) * 64 + t) * 64 : out + O_KR_P + ((size_t)(l * 2 + b) * 4096 + t) * 64;
              st8f(op + 8 * F.lane, f); *(v4u*)(cl + C_KR + ((size_t)(tile * 8 + F.lane) * 64 + kap) * 16) = pack8(f); } }
        { float uc0[8], uc1[8], uc2[8];
          { float a[8], x[8]; unpack8(*(const v4u*)(zr + ZC_GC + L8), a); unpack8(*(const v4u*)(zr + ZC_XC + L8), x);
#pragma unroll
            for (int i = 0; i < 8; ++i) uc2[i] = a[i] * x[i]; }
          if (t >= 1) { float a[8], x[8]; unpack8(*(const v4u*)(zr - DINP + ZC_GC + L8), a); unpack8(*(const v4u*)(zr - DINP + ZC_XC + L8), x);
#pragma unroll
            for (int i = 0; i < 8; ++i) uc1[i] = a[i] * x[i]; }
          else if (smp) ld8f(PIN(6) + ((size_t)(l * 16 + b) * 2 + 1) * 512 + L8, uc1);
          else {
#pragma unroll
            for (int i = 0; i < 8; ++i) uc1[i] = 0.f; }
          if (t >= 2) { float a[8], x[8]; unpack8(*(const v4u*)(zr - 2 * DINP + ZC_GC + L8), a); unpack8(*(const v4u*)(zr - 2 * DINP + ZC_XC + L8), x);
#pragma unroll
            for (int i = 0; i < 8; ++i) uc0[i] = a[i] * x[i]; }
          else if (smp) ld8f(PIN(6) + ((size_t)(l * 16 + b) * 2 + t) * 512 + L8, uc0);
          else {
#pragma unroll
            for (int i = 0; i < 8; ++i) uc0[i] = 0.f; }
          float w0[8], w1[8], w2[8], gb[8], y[8]; ld8f(cw + L8, w0); ld8f(cw + 512 + L8, w1); ld8f(cw + 1024 + L8, w2); unpack8(*(const v4u*)(zr + ZC_GB + L8), gb); float s = 0.f;
#pragma unroll
          for (int i = 0; i < 8; ++i) { y[i] = gb[i] * ((w0[i] * uc0[i] + w1[i] * uc1[i]) + w2[i] * uc2[i]); s += y[i] * y[i]; }
          const float rs = 1.0f / sqrtf(wave_sum(s) * (1.0f / 512) + EPS); float gg[8]; ld8f(gcv + L8, gg);
#pragma unroll
          for (int i = 0; i < 8; ++i) y[i] = y[i] * rs * gg[i];
          *(v4u*)(MRG + (size_t)r * DM + 1024 + L8) = pack8(y);
          const int S = smp ? 64 : 4096;
          if (t >= S - 2) { float* op = smp ? out + O_CONV_S + ((size_t)(l * 16 + b) * 2 + (t - (S - 2))) * 512 : out + O_CONV_P + ((size_t)(l * 2 + b) * 2 + (t - (S - 2))) * 512; st8f(op + L8, uc2); } }
        { float f[8]; const v4u kw = *(const v4u*)(zr + ZC_KSB + L8); unpack8(kw, f);
          float* op = smp ? out + O_SBK_S + ((size_t)(l * 16 + b) * 64 + t) * 512 : out + O_SBK_P + ((size_t)(l * 2 + b) * 4096 + t) * 512; st8f(op + L8, f);
          *(v4u*)(cl + C_KSB + ((size_t)((tile * 4 + (F.lane >> 4)) * 16 + (F.lane & 15)) * 64 + kap) * 16) = kw;
          unpack8(*(const v4u*)(zr + ZC_VSB + L8), f);
          op = smp ? out + O_SBV_S + ((size_t)(l * 16 + b) * 64 + t) * 512 : out + O_SBV_P + ((size_t)(l * 2 + b) * 4096 + t) * 512; st8f(op + L8, f); }
    }
}

__device__ __forceinline__ void postattn_phase(Frame& F, int l) {
    const bf16* Y = (const bf16*)(PWS() + WS_YATT); bf16* MRG = (bf16*)(PWS() + WS_XN);
    const float* gm = PIN(20) + l * 1024; const float* gs = PIN(22) + l * 512; const int L8 = 8 * F.lane;
    for (int r = F.gw; r < MT; r += F.ngw) {
        const bf16* yr = Y + (size_t)r * YW; float a[8], b[8], c[8];
        unpack8(*(const v4u*)(yr + L8), a); unpack8(*(const v4u*)(yr + 512 + L8), b); unpack8(*(const v4u*)(yr + 1024 + L8), c);
        float s1 = 0.f, s2 = 0.f;
#pragma unroll
        for (int i = 0; i < 8; ++i) { s1 += a[i] * a[i] + b[i] * b[i]; s2 += c[i] * c[i]; }
        const float r1 = 1.0f / sqrtf(wave_sum(s1) * (1.0f / 1024) + EPS), r2 = 1.0f / sqrtf(wave_sum(s2) * (1.0f / 512) + EPS);
        float g0[8], g1[8], g2[8]; ld8f(gm + L8, g0); ld8f(gm + 512 + L8, g1); ld8f(gs + L8, g2);
#pragma unroll
        for (int i = 0; i < 8; ++i) { a[i] = a[i] * r1 * g0[i]; b[i] = b[i] * r1 * g1[i]; c[i] = c[i] * r2 * g2[i]; }
        bf16* mr = MRG + (size_t)r * DM; *(v4u*)(mr + L8) = pack8(a); *(v4u*)(mr + 512 + L8) = pack8(b); *(v4u*)(mr + 1536 + L8) = pack8(c);
    }
}

struct AttnJob {
    const bf16* q; int qpitch; int nrows; int pos0;
    const unsigned char* kA; int kA_ts; const unsigned char* kB; int kB_ts; const unsigned char* vt; int vt_ts;
    int ntiles; bf16* out; int opitch;
};
constexpr int ATT_BUF = 40960, ATT_K = 0, ATT_KB = 16384, ATT_V = 24576, ATT_FLAGS = 2 * ATT_BUF, ATT_QWORD = ATT_FLAGS + 64;
#define ATT_GLDS(gp, loff) __builtin_amdgcn_global_load_lds((const unsigned*)(gp), (LAS unsigned*)(lds + (loff)), 16, 0, 0)
#define ATT_MFMA(a, b, c) __builtin_amdgcn_mfma_f32_32x32x16_bf16((a), (b), (c), 0, 0, 0)

template <bool SB>
__device__ __forceinline__ void attn_issue(LAS unsigned char* lds, const AttnJob& J, int t, int buf, int wid, int lane) {
    const int lb = buf * ATT_BUF;
    const unsigned char* ka = J.kA + (size_t)t * J.kA_ts + wid * 2048 + lane * 16;
    ATT_GLDS(ka, lb + ATT_K + wid * 2048); ATT_GLDS(ka + 1024, lb + ATT_K + wid * 2048 + 1024);
    if (!SB) { const unsigned char* kb = J.kB + (size_t)t * J.kB_ts + wid * 1024 + lane * 16; ATT_GLDS(kb, lb + ATT_KB + wid * 1024); }
    const unsigned char* vp = J.vt + (size_t)t * J.vt_ts + wid * 2048 + lane * 16;
    ATT_GLDS(vp, lb + ATT_V + wid * 2048); ATT_GLDS(vp + 1024, lb + ATT_V + wid * 2048 + 1024);
}

template <bool SB>
__device__ __forceinline__ void attn_unit(LAS unsigned char* lds, const AttnJob& J, const float* ctab, const float* stab, int wid, int lane) {
    constexpr int NQ = SB ? 8 : 12;
    const int r32 = lane & 31, hi = lane >> 5, r0 = wid * 32;
    const bool active = r0 < J.nrows;
    const int nt = J.ntiles;
    attn_issue<SB>(lds, J, SB ? nt - 1 : 0, 0, wid, lane);
    bf16x8 qf[NQ];
    const int qpos = J.pos0 + r0 + r32;
    if (active) {
        const bf16* qp = J.q + (size_t)(r0 + r32) * J.qpitch + 8 * hi;
#pragma unroll
        for (int d0 = 0; d0 < NQ; ++d0) qf[d0] = *(const bf16x8*)(qp + 16 * d0);
        if (!SB) {
#pragma unroll
            for (int fi = 0; fi < 2; ++fi) {
                float x1[8], x2[8], c[8], s[8]; unpack8(__builtin_bit_cast(v4u, qf[8 + fi]), x1); unpack8(__builtin_bit_cast(v4u, qf[10 + fi]), x2);
                ld8f(ctab + qpos * 32 + 16 * fi + 8 * hi, c); ld8f(stab + qpos * 32 + 16 * fi + 8 * hi, s);
                float o1[8], o2[8];
#pragma unroll
                for (int j = 0; j < 8; ++j) { o1[j] = x1[j] * c[j] - x2[j] * s[j]; o2[j] = x2[j] * c[j] + x1[j] * s[j]; }
                qf[8 + fi] = __builtin_bit_cast(bf16x8, pack8(o1)); qf[10 + fi] = __builtin_bit_cast(bf16x8, pack8(o2));
            }
        }
    } else {
#pragma unroll
        for (int d0 = 0; d0 < NQ; ++d0) qf[d0] = (bf16x8){0, 0, 0, 0, 0, 0, 0, 0};
    }
    f32x16 o[4];
#pragma unroll
    for (int db = 0; db < 4; ++db)
#pragma unroll
        for (int r = 0; r < 16; ++r) o[db][r] = 0.f;
    float m_run = -INFINITY, l_run = 0.f, R = 0.f;
    const int wave_lim = SB ? 0 : ((J.pos0 + r0) >> 6);
    const int max_qp = J.pos0 + r0 + 31;
    for (int i = 0; i < nt; ++i) {
        const int t = SB ? nt - 1 - i : i;
        if (i + 1 < nt) { attn_issue<SB>(lds, J, SB ? t - 1 : t + 1, (i + 1) & 1, wid, lane);
            if (SB) asm volatile("s_waitcnt vmcnt(4)" ::: "memory"); else asm volatile("s_waitcnt vmcnt(5)" ::: "memory"); }
        else asm volatile("s_waitcnt vmcnt(0)" ::: "memory");
        __builtin_amdgcn_s_barrier(); asm volatile("" ::: "memory");
        const bool work = active && (SB ? (64 * t < max_qp) : (t <= wave_lim));
        if (work) {
            LAS unsigned char* kbuf = lds + (i & 1) * ATT_BUF + hi * 1024 + r32 * 16;
            LAS unsigned char* vbuf = lds + (i & 1) * ATT_BUF + ATT_V + hi * 2048 + r32 * 16;
            f32x16 s0, s1;
#pragma unroll
            for (int r = 0; r < 16; ++r) { s0[r] = 0.f; s1[r] = 0.f; }
#pragma unroll
            for (int d0 = 0; d0 < NQ; ++d0) {
                const bf16x8 a0 = *(const LAS bf16x8*)(kbuf + d0 * 2048), a1 = *(const LAS bf16x8*)(kbuf + d0 * 2048 + 512);
                s0 = ATT_MFMA(a0, qf[d0], s0); s1 = ATT_MFMA(a1, qf[d0], s1);
            }
            if (!SB) {
                float mx = s0[0];
#pragma unroll
                for (int r = 1; r < 16; ++r) mx = fmaxf(mx, s0[r]);
#pragma unroll
                for (int r = 0; r < 16; ++r) mx = fmaxf(mx, s1[r]);
                mx = fmaxf(mx, __shfl_xor(mx, 32));
                const float mn = fmaxf(m_run, mx), alpha = __builtin_amdgcn_exp2f(m_run - mn); m_run = mn;
                float ls = 0.f;
#pragma unroll
                for (int r = 0; r < 16; ++r) { s0[r] = __builtin_amdgcn_exp2f(s0[r] - mn); s1[r] = __builtin_amdgcn_exp2f(s1[r] - mn); ls += s0[r] + s1[r]; }
                l_run = l_run * alpha + ls;
#pragma unroll
                for (int db = 0; db < 4; ++db)
#pragma unroll
                    for (int r = 0; r < 16; ++r) o[db][r] *= alpha;
            } else {
                const int kbase = 64 * t + 4 * hi;
                float gs[8], L0[16], L1[16];
#pragma unroll
                for (int kb = 0; kb < 2; ++kb)
#pragma unroll
                    for (int gq = 0; gq < 4; ++gq) { float acc = 0.f;
#pragma unroll
                        for (int e = 0; e < 4; ++e) { const int r = 4 * gq + e; const float x = kb ? s1[r] : s0[r];
                            const float sp = fmaxf(x, 0.f) + LN2 * __builtin_amdgcn_logf(1.0f + __builtin_amdgcn_exp2f(-fabsf(x) * LOG2E));
                            const bool earlier = (kbase + 32 * kb + e + 8 * gq) < qpos;
                            const float lk = earlier ? -sp : 0.f; acc += lk;
                            if (kb) { L1[r] = lk; s1[r] = x - sp; } else { L0[r] = lk; s0[r] = x - sp; } }
                        gs[4 * kb + gq] = acc; }
                float pgs[8];
#pragma unroll
                for (int j = 0; j < 8; ++j) pgs[j] = __shfl_xor(gs[j], 32);
                float T = 0.f;
#pragma unroll
                for (int j = 7; j >= 0; --j) { const int kb = j >> 2, gq = j & 3;
                    float W = T + (hi == 0 ? pgs[j] : 0.f) + R;
#pragma unroll
                    for (int e = 3; e >= 0; --e) { const int r = 4 * gq + e; const float lb = kb ? s1[r] : s0[r];
                        const bool earlier = (kbase + 32 * kb + e + 8 * gq) < qpos;
                        const float w = earlier ? __builtin_amdgcn_exp2f((lb + W) * LOG2E) : 0.f;
                        W += kb ? L1[r] : L0[r];
                        if (kb) s1[r] = w; else s0[r] = w; }
                    T += gs[j] + pgs[j]; }
                R += T;
            }
            bf16x8 pb[4];
            { v4u w;
              w.x = pkbf(s0[0], s0[1]); w.y = pkbf(s0[2], s0[3]); w.z = pkbf(s0[4], s0[5]); w.w = pkbf(s0[6], s0[7]); pb[0] = __builtin_bit_cast(bf16x8, w);
              w.x = pkbf(s0[8], s0[9]); w.y = pkbf(s0[10], s0[11]); w.z = pkbf(s0[12], s0[13]); w.w = pkbf(s0[14], s0[15]); pb[1] = __builtin_bit_cast(bf16x8, w);
              w.x = pkbf(s1[0], s1[1]); w.y = pkbf(s1[2], s1[3]); w.z = pkbf(s1[4], s1[5]); w.w = pkbf(s1[6], s1[7]); pb[2] = __builtin_bit_cast(bf16x8, w);
              w.x = pkbf(s1[8], s1[9]); w.y = pkbf(s1[10], s1[11]); w.z = pkbf(s1[12], s1[13]); w.w = pkbf(s1[14], s1[15]); pb[3] = __builtin_bit_cast(bf16x8, w); }
#pragma unroll
            for (int db = 0; db < 4; ++db)
#pragma unroll
                for (int g = 0; g < 4; ++g) { const bf16x8 a = *(const LAS bf16x8*)(vbuf + g * 4096 + db * 512); o[db] = ATT_MFMA(a, pb[g], o[db]); }
        }
        if (SB) { const bool done = !active || __all(R < SB_EXIT); if (lane == 0) *(volatile LAS unsigned*)(lds + ATT_FLAGS + (i & 1) * 32 + wid * 4) = done ? 1u : 0u; }
        asm volatile("s_waitcnt lgkmcnt(0)" ::: "memory"); __builtin_amdgcn_s_barrier(); asm volatile("" ::: "memory");
        if (SB) { const volatile LAS unsigned* fl = (const volatile LAS unsigned*)(lds + ATT_FLAGS + (i & 1) * 32);
            unsigned all = fl[0] & fl[1] & fl[2] & fl[3] & fl[4] & fl[5] & fl[6] & fl[7];
            if (__builtin_amdgcn_readfirstlane(all)) break; }
    }
    asm volatile("s_waitcnt vmcnt(0)" ::: "memory");
    if (active) {
        float inv = 1.f;
        if (!SB) { const float lt = l_run + __shfl_xor(l_run, 32); inv = 1.0f / lt; }
        bf16* op = J.out + (size_t)(r0 + r32) * J.opitch + 4 * hi;
#pragma unroll
        for (int db = 0; db < 4; ++db)
#pragma unroll
            for (int gq = 0; gq < 4; ++gq) { u32x2v w; w.x = pkbf(o[db][4 * gq] * inv, o[db][4 * gq + 1] * inv); w.y = pkbf(o[db][4 * gq + 2] * inv, o[db][4 * gq + 3] * inv);
                *(u32x2v*)(op + 32 * db + 8 * gq) = w; }
    }
    __builtin_amdgcn_s_barrier();
}

__device__ __forceinline__ int queue_next(Frame& F, gu32* head) {
    volatile LAS unsigned* w = (volatile LAS unsigned*)(F.lds + ATT_QWORD);
    if (F.tid == 0) *w = __hip_atomic_fetch_add(head, 1u, RLX_AGENT);
    LDS_WAIT(); __syncthreads();
    const int v = (int)*w;
    LDS_WAIT(); __syncthreads();
    return v;
}

__device__ __forceinline__ void attention_phase(Frame& F, int l) {
    unsigned char* ws = PWS(); unsigned char* cl = ws + WS_C + (size_t)l * C_LAYER;
    const float* ctab = (const float*)(ws + WS_ROPE); const float* stab = ctab + 4096 * 32;
    const bf16* Q = (const bf16*)(ws + WS_Q); const bf16* Z = (const bf16*)(ws + WS_Z); bf16* Y = (bf16*)(ws + WS_YATT);
    const unsigned char* KN = ws + WS_KN; const unsigned char* VT = ws + WS_VT; const unsigned char* KR = cl + C_KR; const unsigned char* KSB = cl + C_KSB; const unsigned char* VTSB = cl + C_VTSB;
    { gu32* head = F.ctl + CW_QUEUE + 64 * (2 * l);
      for (;;) { const int id = queue_next(F, head); if (id >= 384) break;
          AttnJob J; int row0, tile0, h;
          if (id < 256) { const int qb = 15 - (id >> 4), b = (id >> 3) & 1; h = id & 7; row0 = b * 4096 + 256 * qb; tile0 = b * 64; J.nrows = 256; J.pos0 = 256 * qb; J.ntiles = 4 * qb + 4; }
          else { const int u = id - 256, s = u >> 3; h = u & 7; row0 = TP + 64 * s; tile0 = 128 + 33 * s; J.nrows = 64; J.pos0 = 2048; J.ntiles = 33; }
          J.q = Q + (size_t)row0 * QW + h * 192; J.qpitch = QW;
          J.kA = KN + ((size_t)tile0 * 8 + h) * 16384; J.kA_ts = 8 * 16384; J.kB = KR + (size_t)tile0 * 8192; J.kB_ts = 8192; J.vt = VT + ((size_t)tile0 * 8 + h) * 16384; J.vt_ts = 8 * 16384;
          J.out = Y + (size_t)row0 * YW + h * 128; J.opitch = YW;
          attn_unit<false>(F.lds, J, ctab, stab, F.wave, F.lane); } }
    { gu32* head = F.ctl + CW_QUEUE + 64 * (2 * l + 1);
      for (;;) { const int id = queue_next(F, head); if (id >= 192) break;
          AttnJob J; int row0, tile0, h;
          if (id < 128) { const int qb = 15 - (id >> 3), b = (id >> 2) & 1; h = id & 3; row0 = b * 4096 + 256 * qb; tile0 = b * 64; J.nrows = 256; J.pos0 = 256 * qb; J.ntiles = 4 * qb + 4; }
          else { const int u = id - 128, s = u >> 2; h = u & 3; row0 = TP + 64 * s; tile0 = 128 + 33 * s; J.nrows = 64; J.pos0 = 2048; J.ntiles = 33; }
          J.q = Z + (size_t)row0 * DINP + ZC_QSB + h * 128; J.qpitch = DINP;
          J.kA = KSB + ((size_t)tile0 * 4 + h) * 16384; J.kA_ts = 4 * 16384; J.kB = nullptr; J.kB_ts = 0; J.vt = VTSB + ((size_t)tile0 * 4 + h) * 16384; J.vt_ts = 4 * 16384;
          J.out = Y + (size_t)row0 * YW + 1024 + h * 128; J.opitch = YW;
          attn_unit<true>(F.lds, J, ctab, stab, F.wave, F.lane); } }
}

#ifndef MK_SPLIT
#define MK_SPLIT 0
#endif
constexpr int NPH = 1 + 13 * DEPTH;
using EVtSb = pg8::EpiVtBlk<true, 4>; using EVtMla = pg8::EpiVtBlk<false, 8>; using EKnMla = pg8::EpiKBlk<8>;
__global__ void __launch_bounds__(NWAVES * 64, 2) fwd_kernel(Args args) {
    extern __shared__ __attribute__((aligned(16))) unsigned char lds_raw[];
    Frame F;
    F.lds = (LAS unsigned char*)lds_raw;
    F.MISC = (volatile LAS unsigned*)(F.lds + MISC_OFF);
    F.tid = threadIdx.x; F.lane = F.tid & 63; F.wave = __builtin_amdgcn_readfirstlane(F.tid >> 6);
    const int G = gridDim.x; const int vcu = (G % 8 == 0) ? ((int)blockIdx.x % 8) * (G / 8) + (int)blockIdx.x / 8 : (int)blockIdx.x;
    F.gw = vcu * NWAVES + F.wave; F.ngw = G * NWAVES;
    F.ctl = (gu32*)(args.ws + WS_CTL);
    { LAS unsigned long long* pp = (LAS unsigned long long*)(F.lds + PARAM_OFF);
      if (F.tid == 0) {
#pragma unroll
          for (int k = 0; k < 30; ++k) pp[k] = (unsigned long long)args.in[k];
          pp[30] = (unsigned long long)args.out; pp[31] = (unsigned long long)args.ws; } }
    for (int u = F.tid; u < 64; u += NWAVES * 64) ((LAS unsigned*)(F.lds + MISC_OFF))[u] = 0u;
    __syncthreads();
    XcdBarrier bar; bar.bar = (unsigned*)(F.ctl + CW_BAR); bar.x = 0; bar.st = nullptr;
    if (!MK_SPLIT) bar = xcd_barrier_post((unsigned*)(F.ctl + CW_BAR), F.MISC + 8);
    const int lo = args.ph_lo, hi = args.ph_hi;
#ifndef PHM
#define PHM 0xFFFFFFFFu
#endif
#define EN(j) ((PHM >> (j)) & 1u)
#define IN(k) (lo <= (k) && (k) < hi)
#define SEAM(k) do { if (IN((k) + 1)) xcd_barrier(bar); } while (0)
#define LAUNDER() asm volatile("" : "+v"(F.tid), "+v"(F.lane), "+s"(F.wave), "+s"(F.gw))
#define WL() (PWS() + WS_W + (size_t)l * W_LAYER)
#define CL() (PWS() + WS_C + (size_t)l * C_LAYER)
#define GEMM_CALL(EPI, AP, BP, MM, NN, KK, EOBJ) do { int bid_ = (int)blockIdx.x; asm volatile("" : "+s"(bid_)); pg8::Gemm g{(const bf16*)(AP), (const bf16*)(BP), (MM), (NN), (KK)}; pg8::StaticOrder S; S.init((MM), (NN), (int)gridDim.x, bid_); \
        pg8::gemm_phase<EPI, pg8::StaticOrder, true, true>(F.lds, g, S, (EOBJ)); } while (0)
    if (EN(13) && IN(0)) { LAUNDER(); p0_prologue(F); SEAM(0); }
    for (int l = 0; l < DEPTH; ++l) {
        const int pb = 1 + 13 * l;
        if (EN(0) && IN(pb + 0)) { LAUNDER(); unsigned char* ws = PWS(); pg8::EpiSwiGLU E{(bf16*)(ws + WS_HID), DFF}; GEMM_CALL(pg8::EpiSwiGLU, ws + WS_XN, WL() + W_GU1, MT, 2 * DFF, DM, E); SEAM(pb + 0); }
        if (EN(1) && IN(pb + 1)) { LAUNDER(); unsigned char* ws = PWS(); pg8::EpiF32 E{(float*)(ws + WS_F), DM}; GEMM_CALL(pg8::EpiF32, ws + WS_HID, WL() + W_D1, MT, DM, DFF, E); SEAM(pb + 1); }
        if (EN(2) && IN(pb + 2)) { LAUNDER(); unsigned char* ws = PWS(); float* H = POUT();
            norm_phase(F, (const float*)(ws + WS_F), l == 0 ? PIN(0) : H, l == 0 ? PIN(1) : H + (size_t)TP * DM, 0.5f, PIN(11) + l * DM, PIN(12) + l * DM, H, (bf16*)(ws + WS_XN)); SEAM(pb + 2); }
        if (EN(3) && IN(pb + 3)) { LAUNDER();
            { unsigned char* ws = PWS(); pg8::EpiBf16 E{(bf16*)(ws + WS_Z), DINP}; GEMM_CALL(pg8::EpiBf16, ws + WS_XN, WL() + W_IN, MT, DINP, DM, E); }
            { unsigned char* ws = PWS(); EVtSb E{CL() + C_VTSB}; GEMM_CALL(EVtSb, WL() + W_IN + (size_t)ZC_VSB * DM * 2, ws + WS_XN, 512, MT, DM, E); }
            SEAM(pb + 3); }
        if (EN(4) && IN(pb + 4)) { LAUNDER(); postz_phase(F, l); SEAM(pb + 4); }
        if (EN(5) && IN(pb + 5)) { LAUNDER();
            { unsigned char* ws = PWS(); pg8::EpiBf16 E{(bf16*)(ws + WS_Q), QW}; GEMM_CALL(pg8::EpiBf16, ws + WS_CQN, WL() + W_UQ, MT, QW, 512, E); }
            { unsigned char* ws = PWS(); EKnMla E{ws + WS_KN}; GEMM_CALL(EKnMla, CL() + C_CKV, WL() + W_UKV, NKEY, 1024, 512, E); }
            { unsigned char* ws = PWS(); EVtMla E{ws + WS_VT}; GEMM_CALL(EVtMla, WL() + W_UKV + (size_t)1024 * 512 * 2, CL() + C_CKV, 1024, NKEY, 512, E); }
            SEAM(pb + 5); }
        if (EN(6) && IN(pb + 6)) { LAUNDER(); attention_phase(F, l); SEAM(pb + 6); }
        if (EN(7) && IN(pb + 7)) { LAUNDER(); postattn_phase(F, l); SEAM(pb + 7); }
        if (EN(8) && IN(pb + 8)) { LAUNDER(); unsigned char* ws = PWS(); pg8::EpiF32 E{(float*)(ws + WS_F), DM}; GEMM_CALL(pg8::EpiF32, ws + WS_XN, WL() + W_O, MT, DM, DM, E); SEAM(pb + 8); }
        if (EN(9) && IN(pb + 9)) { LAUNDER(); unsigned char* ws = PWS(); float* H = POUT();
            norm_phase(F, (const float*)(ws + WS_F), H, H + (size_t)TP * DM, 1.0f, PIN(24) + l * DM, PIN(25) + l * DM, H, (bf16*)(ws + WS_XN)); SEAM(pb + 9); }
        if (EN(10) && IN(pb + 10)) { LAUNDER(); unsigned char* ws = PWS(); pg8::EpiSwiGLU E{(bf16*)(ws + WS_HID), DFF}; GEMM_CALL(pg8::EpiSwiGLU, ws + WS_XN, WL() + W_GU2, MT, 2 * DFF, DM, E); SEAM(pb + 10); }
        if (EN(11) && IN(pb + 11)) { LAUNDER(); unsigned char* ws = PWS(); pg8::EpiF32 E{(float*)(ws + WS_F), DM}; GEMM_CALL(pg8::EpiF32, ws + WS_HID, WL() + W_D2, MT, DM, DFF, E); SEAM(pb + 11); }
        if (EN(12) && IN(pb + 12)) { LAUNDER(); unsigned char* ws = PWS(); float* H = POUT();
            norm_phase(F, (const float*)(ws + WS_F), H, H + (size_t)TP * DM, 0.5f, PIN(29) + l * DM, l + 1 < DEPTH ? PIN(7) + (l + 1) * DM : nullptr, H, (bf16*)(ws + WS_XN)); SEAM(pb + 12); }
    }
#undef IN
#undef SEAM
}

extern "C" void kernel_launch(void* const* d_in, const int* in_sizes, int n_in, void* d_out, int out_size, void* d_ws, size_t ws_size, hipStream_t stream) {
    static int grid = 0;
    if (grid == 0) {
        if (n_in != 30 || out_size != (int)O_END || ws_size < WS_END) { fprintf(stderr, "kernel_launch: unexpected shapes: n_in %d out %d ws %zu (need %zu)\n", n_in, out_size, ws_size, (size_t)WS_END); grid = -1; return; }
        int dev = 0, cus = 0, per_cu = 0;
        if (hipGetDevice(&dev) != hipSuccess || hipDeviceGetAttribute(&cus, hipDeviceAttributeMultiprocessorCount, dev) != hipSuccess) { grid = -1; return; }
        if (hipFuncSetAttribute((const void*)fwd_kernel, hipFuncAttributeMaxDynamicSharedMemorySize, LDS_BYTES) != hipSuccess) { fprintf(stderr, "kernel_launch: hipFuncSetAttribute failed\n"); grid = -1; return; }
        if (hipOccupancyMaxActiveBlocksPerMultiprocessor(&per_cu, (const void*)fwd_kernel, NWAVES * 64, LDS_BYTES) != hipSuccess || per_cu < 1) { fprintf(stderr, "kernel_launch: occupancy query says %d\n", per_cu); (void)hipGetLastError(); grid = -1; return; }
        grid = cus;
    }
    if (grid < 0) return;
    (void)hipMemsetAsync((char*)d_ws + WS_CTL, 0, CTL_ZERO_BYTES, stream);
    Args a{};
    for (int i = 0; i < 30; ++i) a.in[i] = (const float*)d_in[i];
    a.out = (float*)d_out; a.ws = (unsigned char*)d_ws;
#if MK_SPLIT
    for (int p = 0; p < NPH; ++p) { a.ph_lo = p; a.ph_hi = p + 1; hipLaunchKernelGGL(fwd_kernel, dim3(grid), dim3(NWAVES * 64), LDS_BYTES, stream, a); }
#else
    a.ph_lo = 0; a.ph_hi = NPH;
    hipLaunchKernelGGL(fwd_kernel, dim3(grid), dim3(NWAVES * 64), LDS_BYTES, stream, a);
#endif
}
```

```cpp
#include <hip/hip_runtime.h>
#include <cstdio>
#include <cstdint>
#ifndef DUPM
#define DUPM 0u
#endif
namespace pg8 {
#define PG8_LAS __attribute__((address_space(3)))
typedef unsigned short bf16_t;
typedef short bf16x8 __attribute__((ext_vector_type(8)));
typedef float f32x4 __attribute__((ext_vector_type(4)));
typedef unsigned u32x4 __attribute__((ext_vector_type(4)));
constexpr int BM = 256, BK = 64, HALF = 128, HTB = HALF * BK * 2  , STAGE_BYTES = 8 * HTB, NXCD = 8, WGM = 4;

__host__ __device__ __forceinline__ int lds_byte(int r, int c) { const int st = (r >> 4) * 2 + (c >> 5), rr = r & 15, cc = c & 31, ob = rr * 64 + cc * 2; return st * 1024 + (ob ^ (((ob >> 9) & 1) << 5)); }
__host__ __device__ __forceinline__ void stage_rc(int b, int& R, int& C) { const int st = b / 1024, sb = b % 1024, swz = sb ^ (((sb >> 9) & 1) << 5); R = (st >> 1) * 16 + swz / 64; C = (st & 1) * 32 + (swz % 64) / 2; }
__host__ __device__ __forceinline__ int perm32(int rho) { const int n = rho >> 4, i = rho & 15; return 8 * (i >> 2) + 4 * n + (i & 3); }

__device__ __forceinline__ unsigned long long __builtin_amdgcn_readfirstlane64_(unsigned long long v) { const unsigned lo = __builtin_amdgcn_readfirstlane((unsigned)v), hi = __builtin_amdgcn_readfirstlane((unsigned)(v >> 32)); return ((unsigned long long)hi << 32) | lo; }
struct Unit { int pm, pn, k0, nk, gid; };
struct Gemm { const bf16_t* A; const bf16_t* Bt; int M, N, K; };

struct StaticOrder {
    int nM, nN, nwg, G, c, nkt;
    __host__ __device__ __forceinline__ void init(int M, int N, int K, int G_, int c_) { nM = M / BM; nN = N / BM; nwg = nM * nN; G = G_; c = c_; nkt = K / BK; }
    __host__ __device__ __forceinline__ bool next(int i, Unit& u) const {
        const long L = (long)i * G + c; if (L >= nwg) return false;
        int wgid = (int)L; { const int q = nwg / NXCD, r = nwg % NXCD, xcd = wgid % NXCD, off = wgid / NXCD; wgid = (xcd < r ? xcd * (q + 1) : r * (q + 1) + (xcd - r) * q) + off; }
        const int nig = WGM * nN, gid = wgid / nig, fm = gid * WGM, gsz = (nM - fm) < WGM ? (nM - fm) : WGM;
        u.pm = fm + ((wgid % nig) % gsz); u.pn = (wgid % nig) / gsz; u.k0 = 0; u.nk = nkt; u.gid = 0; return true;
    }
    __device__ __forceinline__ void a_ready(const Unit&) const {}
    __device__ __forceinline__ void done(const Unit&) const {}
};
struct TailSplitOrder {
    StaticOrder S0; int nkt, c, nN;
    __host__ __device__ static int slice_len(int nkt, int s) { const int q = nkt / 8; return (q & 1) ? (s < 4 ? q + 1 : q - 1) : q; }
    __host__ __device__ static int slice_start(int nkt, int s) { const int q = nkt / 8; return (q & 1) ? (s < 4 ? s * (q + 1) : 4 * (q + 1) + (s - 4) * (q - 1)) : s * q; }
    __host__ __device__ static int slice_of(int nkt, int k0) { const int q = nkt / 8; return (q & 1) ? (k0 < 4 * (q + 1) ? k0 / (q + 1) : 4 + (k0 - 4 * (q + 1)) / (q - 1)) : k0 / q; }
    __host__ __device__ __forceinline__ void init(int M, int N, int K, int G_, int c_) { S0.init(M - 4 * BM, N, K, G_, c_); nkt = K / BK; c = c_; nN = N / BM; }
    __host__ __device__ __forceinline__ bool next(int i, Unit& u) const {
        if (i == 0) return S0.next(0, u);
        if (i > 1) return false;
        const int r = c >> 3, sl = c & 7; u.pm = S0.nM + r / nN; u.pn = r % nN; u.k0 = slice_start(nkt, sl); u.nk = slice_len(nkt, sl); u.gid = 0; return true;
    }
    __device__ __forceinline__ void a_ready(const Unit&) const {}
    __device__ __forceinline__ void done(const Unit&) const {}
};
struct SubsetOrder {
    StaticOrder S0; bool on; int i0, i1;
    __host__ __device__ __forceinline__ void init(int M, int N, int K, int G_, int c_, int c0, int i0_ = 0, int i1_ = 1 << 30) { on = c_ >= c0; S0.init(M, N, K, G_ - c0, on ? c_ - c0 : 0); i0 = i0_; i1 = i1_; }
    __host__ __device__ __forceinline__ bool next(int i, Unit& u) const { return on && (i + i0) < i1 && S0.next(i + i0, u); }
    __device__ __forceinline__ void a_ready(const Unit&) const {}
    __device__ __forceinline__ void done(const Unit&) const {}
};
template <bool ROWS> struct NewKeyOrder {
    StaticOrder S0;
    __host__ __device__ static int panel(int p) { return p < 32 ? p : 40 + (33 * (p - 32)) / 4; }
    __host__ __device__ __forceinline__ void init(int M, int N, int K, int G_, int c_) { S0.init(M, N, K, G_, c_); }
    __host__ __device__ __forceinline__ bool next(int i, Unit& u) const { if (!S0.next(i, u)) return false; if (ROWS) u.pm = panel(u.pm); else u.pn = panel(u.pn); return true; }
    __device__ __forceinline__ void a_ready(const Unit&) const {}
    __device__ __forceinline__ void done(const Unit&) const {}
};

struct Gemm4 { Gemm g[4]; };
struct MultiOrder {
    int pm0, pm1, pm2, pm3, pn0, pn1, pn2, pn3, h0, h1, h2, h3, nk;
    __host__ __device__ __forceinline__ void init(int G, int c, int M0, int N0, int M3, int K) {
        nk = K / BK; Unit t;
        { StaticOrder o; o.init(M0, N0, K, G, c); t.pm = 0; t.pn = 0; h0 = o.next(0, t) ? 1 : 0; pm0 = t.pm; pn0 = t.pn; }
        { NewKeyOrder<true> o; o.init(48 * 256, 1024, K, G, (c + G - 64) % G); t.pm = 0; t.pn = 0; h1 = o.next(0, t) ? 1 : 0; pm1 = t.pm; pn1 = t.pn; }
        { NewKeyOrder<false> o; o.init(1024, 48 * 256, K, G, (c + G - 128) % G); t.pm = 0; t.pn = 0; h2 = o.next(0, t) ? 1 : 0; pm2 = t.pm; pn2 = t.pn; }
        { SubsetOrder o; o.init(M3, 1024, K, G, c + 48, 48, 2, 3); t.pm = 0; t.pn = 0; h3 = o.next(0, t) ? 1 : 0; pm3 = t.pm; pn3 = t.pn; }
    }
    __host__ __device__ __forceinline__ bool next(int i, Unit& u) const {
        const int c0 = h0, c1 = c0 + h1, c2 = c1 + h2, c3 = c2 + h3; if (i >= c3) return false;
        const int k = i + 1; const int sel = (h0 && c0 == k) ? 0 : (h1 && c1 == k) ? 1 : (h2 && c2 == k) ? 2 : 3;
        const int e0 = sel == 0, e1 = sel == 1, e2 = sel == 2, e3 = sel == 3;
        u.pm = e0 * pm0 + e1 * pm1 + e2 * pm2 + e3 * pm3; u.pn = e0 * pn0 + e1 * pn1 + e2 * pn2 + e3 * pn3;
        u.k0 = 0; u.nk = nk; u.gid = sel; return true;
    }
    __device__ __forceinline__ void a_ready(const Unit&) const {}
    __device__ __forceinline__ void done(const Unit&) const {}
};


__device__ __forceinline__ unsigned cvt_pk_bf16(float lo, float hi) { unsigned r; asm volatile("v_cvt_pk_bf16_f32 %0, %1, %2" : "=v"(r) : "v"(lo), "v"(hi)); return r; }
typedef unsigned u32x2 __attribute__((ext_vector_type(2)));

struct EpiFmix {
    static constexpr bool PERM = true, AFTER_DRAIN = false;
    bf16_t* C; bf16_t* C1; int ldc; int nkt;
    __device__ __forceinline__ void operator()(const f32x4 (&acc)[2][2][4][2], const Unit& u, int wr, int wc, int fr, int fq) const {
        const int row0 = u.pm * BM + wr * 64 + fr, col0 = u.pn * BM + wc * 32 + 8 * fq;
        bf16_t* Cb = u.k0 == 0 ? C : C1 + (size_t)(TailSplitOrder::slice_of(nkt, u.k0) - 1) * 1024 * ldc - (size_t)8192 * ldc;
#pragma unroll
        for (int ai = 0; ai < 2; ++ai)
#pragma unroll
            for (int m = 0; m < 4; ++m) { bf16_t* rowp = Cb + (size_t)(row0 + ai * HALF + m * 16) * ldc + col0;
#pragma unroll
                for (int bj = 0; bj < 2; ++bj) { const f32x4 v0 = acc[ai][bj][m][0], v1 = acc[ai][bj][m][1];
                    u32x4 w; w.x = cvt_pk_bf16(v0[0], v0[1]); w.y = cvt_pk_bf16(v0[2], v0[3]); w.z = cvt_pk_bf16(v1[0], v1[1]); w.w = cvt_pk_bf16(v1[2], v1[3]);
                    *(u32x4*)(rowp + bj * HALF) = w; } }
    }
};
struct EpiBf16 {
    static constexpr bool PERM = true, AFTER_DRAIN = false;
    bf16_t* O; int ldc; const float* rs;
    __device__ __forceinline__ void operator()(const f32x4 (&acc)[2][2][4][2], const Unit& u, int wr, int wc, int fr, int fq) const {
        const int row0 = u.pm * BM + wr * 64 + fr, col0 = u.pn * BM + wc * 32 + 8 * fq;
        float rv[2][4];
#pragma unroll
        for (int ai = 0; ai < 2; ++ai)
#pragma unroll
            for (int m = 0; m < 4; ++m) rv[ai][m] = rs ? rs[row0 + ai * HALF + m * 16] : 1.0f;
#pragma unroll
        for (int ai = 0; ai < 2; ++ai)
#pragma unroll
            for (int m = 0; m < 4; ++m) { const int row = row0 + ai * HALF + m * 16; bf16_t* rowp = O + (size_t)row * ldc + col0; const float r = rv[ai][m];
#pragma unroll
                for (int bj = 0; bj < 2; ++bj) { const f32x4 v0 = acc[ai][bj][m][0] * r, v1 = acc[ai][bj][m][1] * r;
                    u32x4 w; w.x = cvt_pk_bf16(v0[0], v0[1]); w.y = cvt_pk_bf16(v0[2], v0[3]); w.z = cvt_pk_bf16(v1[0], v1[1]); w.w = cvt_pk_bf16(v1[2], v1[3]);
                    *(u32x4*)(rowp + bj * HALF) = w; } }
    }
};
struct EpiSwiGLU {
    static constexpr bool PERM = true, AFTER_DRAIN = false;
    bf16_t* O; int ldc; const float* rs;
    __device__ __forceinline__ static float silu_mul(float g, float u) { const float e = __builtin_amdgcn_exp2f(-g * 1.4426950408889634f); return g * u * __builtin_amdgcn_rcpf(1.0f + e); }
    __device__ __forceinline__ void operator()(const f32x4 (&acc)[2][2][4][2], const Unit& u, int wr, int wc, int fr, int fq) const {
        const int row0 = u.pm * BM + wr * 64 + fr, col0 = u.pn * HALF + wc * 32 + 8 * fq;
#pragma unroll
        for (int ai = 0; ai < 2; ++ai)
#pragma unroll
            for (int m = 0; m < 4; ++m) { const int row = row0 + ai * HALF + m * 16; bf16_t* rowp = O + (size_t)row * ldc + col0; const float r = rs[row];
                const f32x4 g0 = acc[ai][0][m][0] * r, g1 = acc[ai][0][m][1] * r, u0 = acc[ai][1][m][0] * r, u1 = acc[ai][1][m][1] * r;
                u32x4 w; w.x = cvt_pk_bf16(silu_mul(g0[0], u0[0]), silu_mul(g0[1], u0[1])); w.y = cvt_pk_bf16(silu_mul(g0[2], u0[2]), silu_mul(g0[3], u0[3]));
                w.z = cvt_pk_bf16(silu_mul(g1[0], u1[0]), silu_mul(g1[1], u1[1])); w.w = cvt_pk_bf16(silu_mul(g1[2], u1[2]), silu_mul(g1[3], u1[3]));
                *(u32x4*)rowp = w; }
    }
};
struct EpiSwiGLUi8 {
    static constexpr bool PERM = true, AFTER_DRAIN = false;
    bf16_t* O; int ldc; const float* rs; const float* cs;
    __device__ __forceinline__ void operator()(const f32x4 (&acc)[2][2][4][2], const Unit& u, int wr, int wc, int fr, int fq) const {
        typedef int i32x4e __attribute__((ext_vector_type(4)));
        const int row0 = u.pm * BM + wr * 64 + fr, col0 = u.pn * HALF + wc * 32 + 8 * fq; const float* cg = cs + u.pn * BM + wc * 32 + 8 * fq;
        const f32x4 cg0 = *(const f32x4*)cg * (1.0f / 127.0f), cg1 = *(const f32x4*)(cg + 4) * (1.0f / 127.0f), cu0 = *(const f32x4*)(cg + HALF) * (1.0f / 127.0f), cu1 = *(const f32x4*)(cg + HALF + 4) * (1.0f / 127.0f);
        float rv[2][4];
#pragma unroll
        for (int ai = 0; ai < 2; ++ai)
#pragma unroll
            for (int m = 0; m < 4; ++m) rv[ai][m] = rs[row0 + ai * HALF + m * 16];
#pragma unroll
        for (int ai = 0; ai < 2; ++ai)
#pragma unroll
            for (int m = 0; m < 4; ++m) { const int row = row0 + ai * HALF + m * 16; bf16_t* rowp = O + (size_t)row * ldc + col0; const float r = rv[ai][m];
                const f32x4 g0 = __builtin_convertvector(__builtin_bit_cast(i32x4e, acc[ai][0][m][0]), f32x4) * cg0 * r, g1 = __builtin_convertvector(__builtin_bit_cast(i32x4e, acc[ai][0][m][1]), f32x4) * cg1 * r;
                const f32x4 u0 = __builtin_convertvector(__builtin_bit_cast(i32x4e, acc[ai][1][m][0]), f32x4) * cu0 * r, u1 = __builtin_convertvector(__builtin_bit_cast(i32x4e, acc[ai][1][m][1]), f32x4) * cu1 * r;
                u32x4 w; w.x = cvt_pk_bf16(EpiSwiGLU::silu_mul(g0[0], u0[0]), EpiSwiGLU::silu_mul(g0[1], u0[1])); w.y = cvt_pk_bf16(EpiSwiGLU::silu_mul(g0[2], u0[2]), EpiSwiGLU::silu_mul(g0[3], u0[3]));
                w.z = cvt_pk_bf16(EpiSwiGLU::silu_mul(g1[0], u1[0]), EpiSwiGLU::silu_mul(g1[1], u1[1])); w.w = cvt_pk_bf16(EpiSwiGLU::silu_mul(g1[2], u1[2]), EpiSwiGLU::silu_mul(g1[3], u1[3]));
                *(u32x4*)rowp = w; }
    }
};
template <int NH> struct EpiKBlk {
    static constexpr bool PERM = true, AFTER_DRAIN = false;
    unsigned char* O; int pm0;
    __device__ __forceinline__ void operator()(const f32x4 (&acc)[2][2][4][2], const Unit& u, int wr, int wc, int fr, int fq) const {
        unsigned char* base = O + ((size_t)((4 * (u.pm + pm0) + wr) * NH + 2 * u.pn)) * 16384 + (4 * wc + fq) * 1024 + fr * 16;
#pragma unroll
        for (int ai = 0; ai < 2; ++ai)
#pragma unroll
            for (int m = 0; m < 4; ++m)
#pragma unroll
                for (int bj = 0; bj < 2; ++bj) { const f32x4 v0 = acc[ai][bj][m][0], v1 = acc[ai][bj][m][1];
                    u32x4 w; w.x = cvt_pk_bf16(v0[0], v0[1]); w.y = cvt_pk_bf16(v0[2], v0[3]); w.z = cvt_pk_bf16(v1[0], v1[1]); w.w = cvt_pk_bf16(v1[2], v1[3]);
                    *(u32x4*)(base + ai * (2 * NH * 16384) + bj * 16384 + m * 256) = w; }
    }
};
template <bool TOK, int NH> struct EpiVtBlk {
    static constexpr bool PERM = false, AFTER_DRAIN = false;
    unsigned char* O; int pn0;
    __device__ __forceinline__ void operator()(const f32x4 (&acc)[2][2][4][2], const Unit& u, int wr, int wc, int fr, int fq) const {
        const bool smp = TOK && u.pn >= 32;
        const int tile0 = smp ? 160 + 33 * (4 * (u.pn - 32) + (wc >> 1)) : 4 * (u.pn + pn0) + (wc >> 1);
        const unsigned bjs = smp ? 66u * NH * 16384u : 2u * NH * 16384u;
        unsigned char* base = O + ((size_t)(tile0 * NH + 2 * u.pm)) * 16384 + (4 * (wc & 1) + (fq & 1)) * 2048 + (wr * 64 + fr) * 16 + 8 * (fq >> 1);
#pragma unroll
        for (int bj = 0; bj < 2; ++bj) { unsigned char* bb = base + (size_t)bj * bjs;
#pragma unroll
            for (int ai = 0; ai < 2; ++ai)
#pragma unroll
                for (int m = 0; m < 4; ++m)
#pragma unroll
                    for (int n = 0; n < 2; ++n) { const f32x4 v = acc[ai][bj][m][n];
                        u32x2 w; w.x = cvt_pk_bf16(v[0], v[1]); w.y = cvt_pk_bf16(v[2], v[3]);
                        *(u32x2*)(bb + ai * 16384 + m * 256 + n * 4096) = w; } }
    }
};

template <int NH> struct EpiVtBlkP {
    static constexpr bool PERM = true, AFTER_DRAIN = false;
    unsigned char* O; int pn0;
    __device__ __forceinline__ void operator()(const f32x4 (&acc)[2][2][4][2], const Unit& u, int wr, int wc, int fr, int fq) const {
        const int tile0 = 4 * (u.pn + pn0) + (wc >> 1);
        unsigned char* base = O + ((size_t)(tile0 * NH + 2 * u.pm)) * 16384 + (4 * (wc & 1) + 2 * (fq >> 1)) * 2048 + (wr * 64 + fr) * 16 + 8 * (fq & 1);
#pragma unroll
        for (int bj = 0; bj < 2; ++bj) { unsigned char* bb = base + (size_t)bj * (2u * NH * 16384u);
#pragma unroll
            for (int ai = 0; ai < 2; ++ai)
#pragma unroll
                for (int m = 0; m < 4; ++m)
#pragma unroll
                    for (int n = 0; n < 2; ++n) { const f32x4 v = acc[ai][bj][m][n];
                        u32x2 w; w.x = cvt_pk_bf16(v[0], v[1]); w.y = cvt_pk_bf16(v[2], v[3]);
                        *(u32x2*)(bb + ai * 16384 + m * 256 + n * 2048) = w; } }
    }
};
template <class E0, class E1, class E2, class E3> struct EpiMulti {
    static constexpr bool PERM = true, AFTER_DRAIN = false;
    static_assert(E0::PERM && E1::PERM && E2::PERM && E3::PERM, "one B staging order per call");
    E0 e0; E1 e1; E2 e2; E3 e3;
    __device__ __forceinline__ void operator()(const f32x4 (&acc)[2][2][4][2], const Unit& u, int wr, int wc, int fr, int fq) const {
        if (u.gid == 0) e0(acc, u, wr, wc, fr, fq); else if (u.gid == 1) e1(acc, u, wr, wc, fr, fq); else if (u.gid == 2) e2(acc, u, wr, wc, fr, fq); else e3(acc, u, wr, wc, fr, fq);
    }
};

template <class Epi, class Sched, bool ALIGN_EPI = false, bool SP2 = false, bool I8 = false, bool MULTI = false>
__device__ __forceinline__ void gemm_phase(PG8_LAS unsigned char* lds, const Gemm g, const Sched& S, const Epi& E) {
    int tid_ = threadIdx.x; asm volatile("" : "+v"(tid_));
    const int tid = tid_, wid = __builtin_amdgcn_readfirstlane(tid >> 6), lane = tid & 63, wr = wid >> 2, wc = wid & 3, fr = lane & 15, fq = lane >> 4;
    const int K = g.K;
    unsigned voffA[2], voffB[2];
#pragma unroll
    for (int i = 0; i < 2; ++i) { int R, C; stage_rc(tid * 16 + i * 8192, R, C); const int Rb = Epi::PERM ? ((R & ~31) + perm32(R & 31)) : R;
        voffA[i] = (unsigned)(R * K + C) * 2u; voffB[i] = (unsigned)(Rb * K + C) * 2u; }
    const size_t kstep = (size_t)(BK * 2);
    const size_t hstep = (size_t)HALF * K * 2;
    const size_t tstep = 2 * hstep;
    const unsigned ldsw = (unsigned)wid * 1024u;
    const int aoff = lds_byte(wr * 64 + fr, fq * 8), boff = lds_byte(wc * 32 + fr, fq * 8);
#define PG8_SA(b, h) (((b) * 2 + (h)) * HTB)
#define PG8_SB(b, h) ((4 + (b) * 2 + (h)) * HTB)
#define PG8_STAGE(bufoff, gbase, voff) do { _Pragma("unroll") for (int _i = 0; _i < 2; ++_i) \
        __builtin_amdgcn_global_load_lds((const unsigned*)((const char*)(gbase) + (voff)[_i]), (PG8_LAS unsigned*)(lds + (bufoff) + ldsw + _i * 8192), 16, 0, 0); } while (0)
#define PG8_LDA(dst, b, h) do { _Pragma("unroll") for (int m = 0; m < 4; ++m) _Pragma("unroll") for (int k = 0; k < 2; ++k) dst[m][k] = *(const PG8_LAS bf16x8*)(lds + PG8_SA(b, h) + aoff + m * 2048 + k * 1024); } while (0)
#define PG8_LDB(dst, b, h) do { _Pragma("unroll") for (int n = 0; n < 2; ++n) _Pragma("unroll") for (int k = 0; k < 2; ++k) dst[n][k] = *(const PG8_LAS bf16x8*)(lds + PG8_SB(b, h) + boff + n * 2048 + k * 1024); } while (0)
#define PG8_MMA(ai, bj, At, Bt) do { __builtin_amdgcn_s_setprio(1); _Pragma("unroll") for (int m = 0; m < 4; ++m) _Pragma("unroll") for (int n = 0; n < 2; ++n) _Pragma("unroll") for (int k = 0; k < 2; ++k) { \
        if constexpr (I8) acc[ai][bj][m][n] = __builtin_bit_cast(f32x4, __builtin_amdgcn_mfma_i32_16x16x64_i8(__builtin_bit_cast(i32x4_, Bt[n][k]), __builtin_bit_cast(i32x4_, At[m][k]), __builtin_bit_cast(i32x4_, acc[ai][bj][m][n]), 0, 0, 0)); \
        else acc[ai][bj][m][n] = __builtin_amdgcn_mfma_f32_16x16x32_bf16(Bt[n][k], At[m][k], acc[ai][bj][m][n], 0, 0, 0); } \
        __builtin_amdgcn_s_setprio(0); } while (0)
#define PG8_WAIT_V(n) asm volatile("s_waitcnt vmcnt(" #n ")" ::: "memory")
#define PG8_WAIT_L(n) asm volatile("s_waitcnt lgkmcnt(" #n ")" ::: "memory")
#define PG8_BAR __builtin_amdgcn_s_barrier()
#define PG8_SCHED __builtin_amdgcn_sched_barrier(0)
    Unit cur, nxt; int ui = 0;
    if (!S.next(0, cur)) return;
    f32x4 acc[2][2][4][2];
#pragma unroll
    for (int a = 0; a < 2; ++a)
#pragma unroll
        for (int b = 0; b < 2; ++b)
#pragma unroll
            for (int m = 0; m < 4; ++m)
#pragma unroll
                for (int n = 0; n < 2; ++n) acc[a][b][m][n] = (f32x4){0.f, 0.f, 0.f, 0.f};
    typedef int i32x4_ __attribute__((ext_vector_type(4)));
    bf16x8 At[4][2], B0[2][2], B1[2][2];
#define PG8_ABASE(u_) (MULTI ? (const char*)__builtin_amdgcn_readfirstlane64_(*(volatile PG8_LAS unsigned long long*)(lds + 140288 + (u_).gid * 16)) : (const char*)g.A)
#define PG8_BBASE(u_) (MULTI ? (const char*)__builtin_amdgcn_readfirstlane64_(*(volatile PG8_LAS unsigned long long*)(lds + 140288 + (u_).gid * 16 + 8)) : (const char*)g.Bt)
    const char* cA = PG8_ABASE(cur) + (size_t)cur.pm * tstep + (size_t)cur.k0 * kstep; const char* cB = PG8_BBASE(cur) + (size_t)cur.pn * tstep + (size_t)cur.k0 * kstep;
    S.a_ready(cur);
    if constexpr (SP2) {
        PG8_STAGE(PG8_SB(0, 0), cB, voffB); PG8_STAGE(PG8_SB(0, 1), cB + hstep, voffB); PG8_STAGE(PG8_SA(0, 0), cA, voffA); PG8_STAGE(PG8_SA(0, 1), cA + hstep, voffA);
        if (wr == 1) PG8_BAR;
        PG8_WAIT_V(2); PG8_BAR;
        PG8_STAGE(PG8_SB(1, 0), cB + kstep, voffB); PG8_STAGE(PG8_SA(1, 0), cA + kstep, voffA); PG8_STAGE(PG8_SB(1, 1), cB + hstep + kstep, voffB);
        PG8_WAIT_V(6); PG8_BAR;
    } else {
        PG8_STAGE(PG8_SB(0, 0), cB, voffB); PG8_STAGE(PG8_SA(0, 0), cA, voffA); PG8_STAGE(PG8_SB(0, 1), cB + hstep, voffB); PG8_STAGE(PG8_SA(0, 1), cA + hstep, voffA);
        if (wr == 1) PG8_BAR;
        PG8_WAIT_V(4); PG8_BAR;
        PG8_STAGE(PG8_SB(1, 0), cB + kstep, voffB); PG8_STAGE(PG8_SA(1, 0), cA + kstep, voffA); PG8_STAGE(PG8_SB(1, 1), cB + hstep + kstep, voffB);
        PG8_WAIT_V(6); PG8_BAR;
    }
    for (;;) {
        const bool has_next = S.next(ui + 1, nxt);
        const char* nA = has_next ? PG8_ABASE(nxt) + (size_t)nxt.pm * tstep + (size_t)nxt.k0 * kstep : cA; const char* nB = has_next ? PG8_BBASE(nxt) + (size_t)nxt.pn * tstep + (size_t)nxt.k0 * kstep : cB;
        const int nt = cur.nk;
        for (int t = 0; t < nt; t += 2) {
            const bool last = (t == nt - 2);
            const char* a1 = cA + (size_t)(t + 1) * kstep;
            const char* a2 = last ? nA : cA + (size_t)(t + 2) * kstep; const char* b2 = last ? nB : cB + (size_t)(t + 2) * kstep;
            const char* a3 = a2 + kstep; const char* b3 = b2 + kstep;
            if (last && has_next) S.a_ready(nxt);
            if constexpr (SP2) {
            PG8_LDB(B0, 0, 0); PG8_LDB(B1, 0, 1); PG8_SCHED; PG8_LDA(At, 0, 0); PG8_STAGE(PG8_SA(1, 1), a1 + hstep, voffA);
            PG8_WAIT_V(8); PG8_WAIT_L(0); PG8_BAR; PG8_MMA(0, 0, At, B0); PG8_MMA(0, 1, At, B1); PG8_BAR; PG8_SCHED;
            PG8_LDA(At, 0, 1); PG8_STAGE(PG8_SB(0, 0), b2, voffB); PG8_STAGE(PG8_SB(0, 1), b2 + hstep, voffB); PG8_STAGE(PG8_SA(0, 0), a2, voffA);
            PG8_WAIT_V(8); PG8_WAIT_L(0); PG8_BAR; PG8_MMA(1, 0, At, B0); PG8_MMA(1, 1, At, B1); PG8_BAR; PG8_SCHED;
            PG8_LDB(B0, 1, 0); PG8_LDB(B1, 1, 1); PG8_SCHED; PG8_LDA(At, 1, 0); PG8_STAGE(PG8_SA(0, 1), a2 + hstep, voffA);
            PG8_WAIT_V(8); PG8_WAIT_L(0); PG8_BAR; PG8_MMA(0, 0, At, B0); PG8_MMA(0, 1, At, B1); PG8_BAR; PG8_SCHED;
            PG8_LDA(At, 1, 1); PG8_STAGE(PG8_SB(1, 0), b3, voffB); PG8_STAGE(PG8_SB(1, 1), b3 + hstep, voffB); PG8_STAGE(PG8_SA(1, 0), a3, voffA);
            PG8_WAIT_V(8); PG8_WAIT_L(0); PG8_BAR; PG8_MMA(1, 0, At, B0); PG8_MMA(1, 1, At, B1); PG8_BAR; PG8_SCHED;
            } else {
            PG8_LDB(B0, 0, 0); PG8_SCHED; PG8_LDA(At, 0, 0); PG8_STAGE(PG8_SA(1, 1), a1 + hstep, voffA);
            PG8_WAIT_L(8); PG8_BAR; PG8_WAIT_L(0); PG8_MMA(0, 0, At, B0); PG8_BAR; PG8_SCHED;
            PG8_LDB(B1, 0, 1); PG8_STAGE(PG8_SB(0, 0), b2, voffB);
            PG8_BAR; PG8_WAIT_L(0); PG8_MMA(0, 1, At, B1); PG8_BAR;
            PG8_LDA(At, 0, 1); PG8_STAGE(PG8_SA(0, 0), a2, voffA);
            PG8_BAR; PG8_WAIT_L(0); PG8_MMA(1, 0, At, B0); PG8_BAR; PG8_SCHED;
            PG8_STAGE(PG8_SB(0, 1), b2 + hstep, voffB);
            PG8_WAIT_V(6); PG8_BAR; PG8_MMA(1, 1, At, B1); PG8_BAR;
            PG8_LDB(B0, 1, 0); PG8_SCHED; PG8_LDA(At, 1, 0); PG8_STAGE(PG8_SA(0, 1), a2 + hstep, voffA);
            PG8_WAIT_L(8); PG8_BAR; PG8_WAIT_L(0); PG8_MMA(0, 0, At, B0); PG8_BAR; PG8_SCHED;
            PG8_LDB(B1, 1, 1); PG8_STAGE(PG8_SB(1, 0), b3, voffB);
            PG8_BAR; PG8_WAIT_L(0); PG8_MMA(0, 1, At, B1); PG8_BAR;
            PG8_LDA(At, 1, 1); PG8_STAGE(PG8_SA(1, 0), a3, voffA);
            PG8_BAR; PG8_WAIT_L(0); PG8_MMA(1, 0, At, B0); PG8_BAR; PG8_SCHED;
            PG8_STAGE(PG8_SB(1, 1), b3 + hstep, voffB);
            PG8_WAIT_V(6); PG8_BAR; PG8_MMA(1, 1, At, B1); PG8_BAR;
            }
        }
        if constexpr (ALIGN_EPI) { if (wr == 0) PG8_BAR; }
        if constexpr (!Epi::AFTER_DRAIN) { int te_ = threadIdx.x; asm volatile("" : "+v"(te_));
            const int we_ = __builtin_amdgcn_readfirstlane(te_ >> 6), le_ = te_ & 63; E(acc, cur, we_ >> 2, we_ & 3, le_ & 15, le_ >> 4); S.done(cur); }
        if (!has_next) break;
#pragma unroll
        for (int a = 0; a < 2; ++a)
#pragma unroll
            for (int b = 0; b < 2; ++b)
#pragma unroll
                for (int m = 0; m < 4; ++m)
#pragma unroll
                    for (int n = 0; n < 2; ++n) acc[a][b][m][n] = (f32x4){0.f, 0.f, 0.f, 0.f};
        cur = nxt; cA = nA; cB = nB; ++ui;
        if constexpr (ALIGN_EPI) { if (wr == 1) PG8_BAR; }
    }
    PG8_WAIT_V(0);
    if constexpr (!ALIGN_EPI) { if (wr == 0) PG8_BAR; }
    PG8_BAR;
    if constexpr (Epi::AFTER_DRAIN) { E.fused(acc, cur, wr, wc, fr, fq, lds, wid, lane); S.done(cur); }
#undef PG8_SA
#undef PG8_SB
#undef PG8_STAGE
#undef PG8_LDA
#undef PG8_LDB
#undef PG8_MMA
#undef PG8_WAIT_V
#undef PG8_WAIT_L
#undef PG8_BAR
#undef PG8_SCHED
#undef PG8_ABASE
#undef PG8_BBASE
}
}

constexpr int NWAVES = 8;
constexpr int DM = 2048, TP = 8192, TS = 1024, MT = TP + TS, DFF = 5632, DEPTH = 2;
constexpr int DIN = 4160, DINP = 4352;
constexpr int ZC_CQ = 0, ZC_CKV = 512, ZC_KR = 1024, ZC_GB = 1088, ZC_GC = 1600, ZC_XC = 2112, ZC_QSB = 2624, ZC_KSB = 3136, ZC_VSB = 3648;
constexpr int NKEY = 41984, NTILE = 656;
constexpr int QW = 1536;
constexpr int YW = 1536;
constexpr float EPS = 1e-6f;
constexpr float LOG2E = 1.4426950408889634f, LN2 = 0.6931471805599453f;
constexpr float MLA_QSCALE = 0.07216878364870322f * LOG2E;
constexpr float SB_QSCALE = 0.08838834764831845f;
constexpr float SB_EXIT = -104.0f;

constexpr size_t O_Y = 0;
constexpr size_t O_CKV_P = 18874368, O_KR_P = 27262976, O_SBK_P = 28311552, O_SBV_P = 36700160, O_CONV_P = 45088768;
constexpr size_t O_CKV_S = 45092864, O_KR_S = 46141440, O_SBK_S = 46272512, O_SBV_S = 47321088, O_CONV_S = 48369664, O_END = 48402432;

constexpr size_t WS_CTL = 0, CTL_ZERO_BYTES = 128u << 10;
constexpr size_t WS_RS = 512u << 10;
constexpr size_t WS_CS = 600u << 10;
constexpr size_t WS_ROPE = 1u << 20;
constexpr size_t WS_W = 2u << 20;
constexpr size_t W_GU1 = 0, SZ_GU = (size_t)2 * DFF * DM * 2, W_D1 = W_GU1 + SZ_GU, SZ_D = (size_t)DM * DFF * 2, W_GU2 = W_D1 + SZ_D, W_D2 = W_GU2 + SZ_GU;
constexpr size_t W_IN = W_D2 + SZ_D, SZ_IN = (size_t)DINP * DM * 2, W_UQ = W_IN + SZ_IN, SZ_UQ = (size_t)1536 * 512 * 2, W_UKV = W_UQ + SZ_UQ, SZ_UKV = (size_t)2048 * 512 * 2;
constexpr size_t W_O = W_UKV + SZ_UKV, SZ_O = (size_t)DM * DM * 2, W_LAYER = W_O + SZ_O;
constexpr size_t WS_C = WS_W + DEPTH * W_LAYER;
constexpr size_t C_CKV = 0, SZ_CKV = (size_t)NKEY * 512 * 2, C_KR = C_CKV + SZ_CKV, SZ_KR = (size_t)NTILE * 8192, C_KSB = C_KR + SZ_KR, SZ_KSB = (size_t)NTILE * 4 * 16384;
constexpr size_t C_VTSB = C_KSB + SZ_KSB, C_LAYER = C_VTSB + SZ_KSB;
constexpr size_t WS_XN = WS_C + DEPTH * C_LAYER, SZ_XN = (size_t)MT * DM * 2;
constexpr size_t WS_F = WS_XN + SZ_XN, SZ_F = (size_t)MT * DM * 4;
constexpr size_t WS_HB = WS_F + SZ_F / 2;
constexpr size_t WS_MIX = WS_F + SZ_F;
constexpr size_t WS_HID = WS_MIX, SZ_HID = (size_t)MT * DFF * 2;
constexpr size_t WS_F1_OLD = WS_HID + SZ_HID;
constexpr size_t WS_Z = WS_MIX, SZ_Z = (size_t)MT * DINP * 2, WS_CQN = WS_Z + SZ_Z, SZ_CQN = (size_t)MT * 512 * 2, WS_Q = WS_CQN + SZ_CQN, SZ_Q = (size_t)MT * QW * 2;
constexpr size_t WS_KN = WS_Q + SZ_Q, SZ_KN = (size_t)NTILE * 8 * 16384, WS_VT = WS_KN + SZ_KN, WS_YATT = WS_VT + SZ_KN, SZ_YATT = (size_t)MT * YW * 2;
constexpr size_t WS_F1 = WS_YATT + SZ_YATT, SZ_F1 = (size_t)7 * 1024 * DM * 4;
constexpr size_t WS_PO = WS_F1 + SZ_F1, SZ_PO = (size_t)384 * 64 * 128 * 4, WS_PML = WS_PO + SZ_PO, SZ_PML = (size_t)384 * 64 * 2 * 4;
constexpr size_t WS_HB8 = WS_XN;
constexpr size_t WS_PO16 = WS_PML + SZ_PML, SZ_PO16 = (size_t)128 * 256 * 128 * 2, WS_PML16 = WS_PO16 + SZ_PO16, SZ_PML16 = (size_t)128 * 256 * 2 * 4;
constexpr size_t WS_END = WS_PML16 + SZ_PML16;
static_assert(WS_HID + SZ_HID <= WS_KN, "hidden overlay must stay below KN / VT (the past keys are expanded during FFN1)");
static_assert(WS_END <= 1160000000ull, "workspace");
constexpr int CW_TMO = 0, CW_CODE = 1;
constexpr int CW_BAR = 4096;
constexpr int CW_QUEUE = 16384;

constexpr int RING_BYTES = 131072;
constexpr int LDS_BYTES = 147456;
constexpr int MISC_OFF = LDS_BYTES - 256;

#define GAS __attribute__((address_space(1)))
#define LAS __attribute__((address_space(3)))
typedef unsigned short bf16;
typedef unsigned v4u __attribute__((ext_vector_type(4)));
typedef float f32x4 __attribute__((ext_vector_type(4)));
typedef short bf16x8 __attribute__((ext_vector_type(8)));
typedef GAS unsigned gu32;
typedef GAS unsigned long long gu64;
#define RLX_AGENT __ATOMIC_RELAXED, __HIP_MEMORY_SCOPE_AGENT
#define LDS_WAIT() asm volatile("s_waitcnt lgkmcnt(0)" ::: "memory")
#define VM_WAIT() asm volatile("s_waitcnt vmcnt(0)" ::: "memory")
__device__ __forceinline__ unsigned long long rt() { return __builtin_amdgcn_s_memrealtime(); }
__device__ __forceinline__ unsigned f2bf(float f) { unsigned u = __builtin_bit_cast(unsigned, f); return (u + 0x7fffu + ((u >> 16) & 1u)) >> 16; }
__device__ __forceinline__ unsigned pk2(float lo, float hi) { return f2bf(lo) | (f2bf(hi) << 16); }

#define XB_TMO      128
#define XB_XCNT(j)  (256  + 64 * (j))
#define XB_XSUB(j)  (1280 + 64 * (j))
#define XB_XGEN(j)  (2304 + 64 * (j))
#define XB_TOP      3328
#define XB_TOPGEN   3392
#define XCD_BAR_WORDS 3456
#define XB_SPIN_CAP (1u << 18)

__device__ __forceinline__ unsigned xb_ld(unsigned* p)              { return __hip_atomic_load(p, __ATOMIC_RELAXED, __HIP_MEMORY_SCOPE_AGENT); }
__device__ __forceinline__ unsigned xb_add(unsigned* p, unsigned v) { return __hip_atomic_fetch_add(p, v, __ATOMIC_RELAXED, __HIP_MEMORY_SCOPE_AGENT); }
__device__ __forceinline__ unsigned xb_xcc_id() { return (unsigned)__builtin_amdgcn_s_getreg((3 << 11) | 20) & 0xFu; }
#define XB_SPIN(cond, bar) do { unsigned _sp = 0; while (cond) { __builtin_amdgcn_s_sleep(1); \
    if ((++_sp & 255u) == 0u) { if (xb_ld(&(bar)[XB_TMO])) break; if (_sp > XB_SPIN_CAP) { atomicAdd(&(bar)[XB_TMO], 1u); break; } } } } while (0)

struct XcdBarrier {
    unsigned* bar; unsigned x;
    volatile LAS unsigned* st;
};

__device__ __forceinline__ XcdBarrier xcd_barrier_post(unsigned* bar, volatile LAS unsigned* st) {
    XcdBarrier b; b.bar = bar; b.x = xb_xcc_id(); b.st = st;
    if (threadIdx.x == 0) (void)xb_add(&bar[XB_XCNT(b.x)], 1u);
    return b;
}
__device__ __forceinline__ void xcd_barrier_complete(unsigned* bar, unsigned x, unsigned& nloc, unsigned& nx) {
    const unsigned G = gridDim.x * gridDim.y * gridDim.z;
    unsigned sum, cnt, mine, sp = 0u;
    for (;;) {
        sum = 0u; cnt = 0u; mine = 0u;
#pragma unroll 1
        for (unsigned j = 0; j < 16; ++j) { const unsigned c = xb_ld(&bar[XB_XCNT(j)]); sum += c; cnt += (c > 0u) ? 1u : 0u; mine = (j == x) ? c : mine; }
        if (sum == G) break;
        __builtin_amdgcn_s_sleep(1);
        if ((++sp & 255u) == 0u) { if (xb_ld(&bar[XB_TMO])) break; if (sp > XB_SPIN_CAP) { atomicAdd(&bar[XB_TMO], 1u); break; } }
    }
    nloc = mine > 0u ? mine : 1u; nx = cnt > 0u ? cnt : 1u;
}

__device__ __forceinline__ void xcd_barrier(const XcdBarrier& b) {
    asm volatile("s_waitcnt vmcnt(0)" ::: "memory");
    __syncthreads();
    if (threadIdx.x == 0) {
        unsigned* bar = b.bar;
        __builtin_amdgcn_s_waitcnt(0);
        unsigned nloc = b.st[0], nx = b.st[1];
        if (nloc == 0u) { xcd_barrier_complete(bar, b.x, nloc, nx); b.st[0] = nloc; b.st[1] = nx; }
        const unsigned old = xb_add(&bar[XB_XSUB(b.x)], 1u);
        const unsigned gen = old / nloc;
        if (old + 1u == (gen + 1u) * nloc) {
            __builtin_amdgcn_fence(__ATOMIC_RELEASE, "agent");
            asm volatile("s_waitcnt vmcnt(0)" ::: "memory");
            const unsigned og = xb_add(&bar[XB_TOP], 1u);
            const unsigned tg = og / nx;
            if (og + 1u == (tg + 1u) * nx) xb_add(&bar[XB_TOPGEN], 1u);
            else XB_SPIN(xb_ld(&bar[XB_TOPGEN]) == tg, bar);
            __builtin_amdgcn_fence(__ATOMIC_ACQUIRE, "agent");
            xb_add(&bar[XB_XGEN(b.x)], 1u);
            asm volatile("s_waitcnt vmcnt(0)" ::: "memory");
        } else {
            XB_SPIN(xb_ld(&bar[XB_XGEN(b.x)]) == gen, bar);
            __builtin_amdgcn_fence(__ATOMIC_ACQUIRE, "agent");
            asm volatile("s_waitcnt vmcnt(0)" ::: "memory");
        }
    }
    __syncthreads();
}

typedef unsigned u32x2v __attribute__((ext_vector_type(2)));
typedef float f32x16 __attribute__((ext_vector_type(16)));
struct Args { const float* in[30]; float* out; unsigned char* ws; int ph_lo, ph_hi; };
struct Frame {
    LAS unsigned char* lds;
    volatile LAS unsigned* MISC;
    gu32* ctl;
    int tid, lane, wave;
    int gw, ngw;
};
constexpr int PARAM_OFF = MISC_OFF - 512;
__device__ __forceinline__ unsigned long long ldparam(LAS unsigned char* lds, int k) {
    volatile LAS unsigned* p = (volatile LAS unsigned*)(lds + PARAM_OFF) + 2 * k;
    const unsigned lo = __builtin_amdgcn_readfirstlane(p[0]), hi = __builtin_amdgcn_readfirstlane(p[1]);
    return ((unsigned long long)hi << 32) | lo;
}
#define PIN(k) ((const float*)(const GAS float*)ldparam(F.lds, (k)))
#define POUT() ((float*)(GAS float*)ldparam(F.lds, 30))
#define PWS() ((unsigned char*)(GAS unsigned char*)ldparam(F.lds, 31))
__device__ __forceinline__ float wave_sum(float v) {
#pragma unroll
    for (int o = 1; o < 64; o <<= 1) v += __shfl_xor(v, o);
    return v;
}
__device__ __forceinline__ unsigned pkbf(float lo, float hi) { return pg8::cvt_pk_bf16(lo, hi); }
__device__ __forceinline__ float bflo(unsigned w) { return __uint_as_float(w << 16); }
__device__ __forceinline__ float bfhi(unsigned w) { return __uint_as_float(w & 0xffff0000u); }
__device__ __forceinline__ void unpack8(const v4u w, float (&f)[8]) { f[0] = bflo(w.x); f[1] = bfhi(w.x); f[2] = bflo(w.y); f[3] = bfhi(w.y); f[4] = bflo(w.z); f[5] = bfhi(w.z); f[6] = bflo(w.w); f[7] = bfhi(w.w); }
__device__ __forceinline__ v4u pack8(const float (&f)[8]) { v4u w; w.x = pkbf(f[0], f[1]); w.y = pkbf(f[2], f[3]); w.z = pkbf(f[4], f[5]); w.w = pkbf(f[6], f[7]); return w; }
__device__ __forceinline__ void ld8f(const float* p, float (&f)[8]) { const f32x4 a = *(const f32x4*)p, b = *(const f32x4*)(p + 4); f[0] = a.x; f[1] = a.y; f[2] = a.z; f[3] = a.w; f[4] = b.x; f[5] = b.y; f[6] = b.z; f[7] = b.w; }
__device__ __forceinline__ void st8f(float* p, const float (&f)[8]) { *(f32x4*)p = (f32x4){f[0], f[1], f[2], f[3]}; *(f32x4*)(p + 4) = (f32x4){f[4], f[5], f[6], f[7]}; }

__device__ __forceinline__ void transpose_item(const float* W, int K, int N, bf16* WT, int k0, int n0, int drow, float scale0, const float* gk, LAS float* scr, int lane) {
    const int kr = lane >> 4, nc = (lane & 15) * 4;
    f32x4 tv[16]; float tg[16];
#pragma unroll
    for (int i = 0; i < 16; ++i) { const int kk = 4 * i + kr; tv[i] = *(const f32x4*)(W + (size_t)(k0 + kk) * N + n0 + nc); tg[i] = gk ? scale0 * gk[k0 + kk] : scale0; }
#pragma unroll
    for (int i = 0; i < 16; ++i) { const int kk = 4 * i + kr; const f32x4 v = tv[i]; const float scale = tg[i];
        LAS float* s = scr + kk * 65 + nc; s[0] = v.x * scale; s[1] = v.y * scale; s[2] = v.z * scale; s[3] = v.w * scale; }
    LDS_WAIT(); asm volatile("" ::: "memory");
    const int c = lane & 7;
#pragma unroll
    for (int j = 0; j < 8; ++j) { const int n = (lane >> 3) + 8 * j; const LAS float* s = scr + (8 * c) * 65 + n;
        v4u o; o.x = pkbf(s[0 * 65], s[1 * 65]); o.y = pkbf(s[2 * 65], s[3 * 65]); o.z = pkbf(s[4 * 65], s[5 * 65]); o.w = pkbf(s[6 * 65], s[7 * 65]);
        *(v4u*)(WT + (size_t)(drow + n) * K + k0 + 8 * c) = o; }
    LDS_WAIT(); asm volatile("" ::: "memory");
}
__device__ __forceinline__ int gu_row(int n, int up) { return 256 * (n >> 7) + (n & 127) + 128 * up; }
__device__ __forceinline__ unsigned q8x4(float a, float b, float c, float d, float inv) {
    const unsigned ua = __float_as_uint(fmaf(a, inv, 12582912.0f)), ub = __float_as_uint(fmaf(b, inv, 12582912.0f)), uc = __float_as_uint(fmaf(c, inv, 12582912.0f)), ud = __float_as_uint(fmaf(d, inv, 12582912.0f));
    const unsigned lo = __builtin_amdgcn_perm(ub, ua, 0x0c0c0400u), hi = __builtin_amdgcn_perm(ud, uc, 0x0c0c0400u);
    return __builtin_amdgcn_perm(hi, lo, 0x05040100u);
}
template <class RowMap>
__device__ __forceinline__ void transpose_matrix(Frame& F, const float* W, int K, int N, bf16* WT, float scale_lo, int sc_n0, int sc_n1, float scale_in, RowMap rm, int& base, const float* gk = nullptr) {
    LAS float* scr = (LAS float*)(F.lds + F.wave * 16640);
    const int nkb = K / 64, nnb = N / 64, nit = nkb * nnb;
    int it = (F.gw - base % F.ngw + F.ngw) % F.ngw;
    for (; it < nit; it += F.ngw) { const int kb = it / nnb, nb = it % nnb, n0 = nb * 64;
        const float sc = (n0 >= sc_n0 && n0 < sc_n1) ? scale_in : scale_lo;
        transpose_item(W, K, N, WT, kb * 64, n0, rm(n0), sc, gk, scr, F.lane); }
    base += nit;
}
struct RmIdent { __device__ __forceinline__ int operator()(int n0) const { return n0; } };
struct RmOff { int off; __device__ __forceinline__ int operator()(int n0) const { return n0 + off; } };
struct RmGU { int up; __device__ __forceinline__ int operator()(int n0) const { return 256 * (n0 >> 7) + (n0 & 127) + 128 * up; } };

__device__ __forceinline__ float wave_max(float v) {
#pragma unroll
    for (int o = 1; o < 64; o <<= 1) v = fmaxf(v, __shfl_xor(v, o));
    return v;
}
__device__ __forceinline__ float quant_row_i8(const f32x4 (&v)[8], unsigned char* o8, int lane) {
    float mx = 0.f;
#pragma unroll
    for (int j = 0; j < 8; ++j) mx = fmaxf(mx, fmaxf(fmaxf(fabsf(v[j].x), fabsf(v[j].y)), fmaxf(fabsf(v[j].z), fabsf(v[j].w))));
    mx = wave_max(mx); const float inv = mx > 0.f ? 127.0f / mx : 0.f;
#pragma unroll
    for (int j = 0; j < 8; ++j) *((unsigned*)o8 + lane + 64 * j) = q8x4(v[j].x, v[j].y, v[j].z, v[j].w, inv);
    return mx * (1.0f / 127.0f);
}
__device__ __forceinline__ void row_to_bf16_rs(Frame& F, const float* xrow, bf16* orow, float* rs, unsigned char* o8) {
    f32x4 v[8]; float s = 0.f;
#pragma unroll
    for (int j = 0; j < 8; ++j) { v[j] = *((const f32x4*)xrow + F.lane + 64 * j); s += (v[j].x * v[j].x + v[j].y * v[j].y) + (v[j].z * v[j].z + v[j].w * v[j].w); }
    const float rstd = 1.0f / sqrtf(wave_sum(s) * (1.0f / DM) + EPS);
#pragma unroll
    for (int j = 0; j < 8; ++j) { u32x2v w; w.x = pkbf(v[j].x, v[j].y); w.y = pkbf(v[j].z, v[j].w); *((u32x2v*)orow + F.lane + 64 * j) = w; }
    const float step = quant_row_i8(v, o8, F.lane);
    if (F.lane == 0) *rs = rstd * step;
}

constexpr int QS_PITCH = 2056;
__device__ __forceinline__ void quant_strips(Frame& F) {
    unsigned char* ws = PWS(); LAS bf16* T = (LAS bf16*)F.lds; LAS float* red = (LAS float*)(F.lds + 32 * QS_PITCH * 2);
    const int G = F.ngw >> 3, vcu = F.gw >> 3, tid = F.tid;
    const int r = tid >> 3, c4 = (tid & 7) * 4;
    constexpr int NSTRIP = 8 * (DFF / 32);
    f32x4 v[2][8]; float gv[2][8];
#define QS_SRC(sI_, W_, gk_) const int mat_##W_ = (sI_) / (DFF / 32), n0_##W_ = ((sI_) - mat_##W_ * (DFF / 32)) * 32, l_##W_ = mat_##W_ >> 2, f_##W_ = (mat_##W_ >> 1) & 1, up_##W_ = mat_##W_ & 1; \
        const float* W_ = PIN(f_##W_ ? 26 + up_##W_ : 8 + up_##W_) + (size_t)l_##W_ * DM * DFF + n0_##W_; const float* gk_ = PIN(f_##W_ ? 25 : 7) + l_##W_ * DM
#define QS_LOAD(b_, W_, gk_) do { int rl_ = r; asm volatile("" : "+v"(rl_));   _Pragma("unroll") for (int it = 0; it < 8; ++it) { const int k = ((b_) * 8 + it) * 64 + rl_; v[(b_) & 1][it] = __builtin_nontemporal_load((const f32x4*)((W_) + (size_t)k * DFF + c4)); gv[(b_) & 1][it] = (gk_)[k]; } } while (0)
#define QS_WRITE(b_) do { _Pragma("unroll") for (int it = 0; it < 8; ++it) { const int k = ((b_) * 8 + it) * 64 + r; const f32x4 w = v[(b_) & 1][it] * gv[(b_) & 1][it]; const unsigned p0 = pkbf(w.x, w.y), p1 = pkbf(w.z, w.w); \
              LAS bf16* t_ = T + c4 * QS_PITCH + k; t_[0] = (bf16)p0; t_[QS_PITCH] = (bf16)(p0 >> 16); t_[2 * QS_PITCH] = (bf16)p1; t_[3 * QS_PITCH] = (bf16)(p1 >> 16); } } while (0)
#define QS_BAR() do { LDS_WAIT(); __builtin_amdgcn_s_barrier(); asm volatile("" ::: "memory"); } while (0)
    if (vcu < NSTRIP) { QS_SRC(vcu, W0, gk0); QS_LOAD(0, W0, gk0); }
    for (int sI = vcu; sI < NSTRIP; sI += G) {
        const int mat = sI / (DFF / 32), n0 = (sI - mat * (DFF / 32)) * 32, l = mat >> 2, f = (mat >> 1) & 1, up = mat & 1;
        unsigned char* WT = ws + WS_W + (size_t)l * W_LAYER + (f ? W_GU2 : W_GU1); float* cmax = (float*)(ws + WS_CS) + (size_t)(l * 2 + f) * 2 * DFF;
        { QS_SRC(sI, W, gk);
          QS_LOAD(1, W, gk); __builtin_amdgcn_sched_barrier(0);
          QS_WRITE(0); QS_LOAD(2, W, gk); __builtin_amdgcn_sched_barrier(0);
          QS_WRITE(1); QS_LOAD(3, W, gk); __builtin_amdgcn_sched_barrier(0);
          QS_WRITE(2); QS_WRITE(3); __builtin_amdgcn_sched_barrier(0); }
        if (sI + G < NSTRIP) { QS_SRC(sI + G, Wn, gkn); QS_LOAD(0, Wn, gkn); }
        QS_BAR();
        v4u q[8][2]; float mx[8];
#pragma unroll
        for (int j = 0; j < 8; ++j) { const LAS v4u* p_ = (const LAS v4u*)(T + (4 * j + (tid >> 7)) * QS_PITCH + 16 * (tid & 127)); float m = 0.f;
#pragma unroll
            for (int e = 0; e < 2; ++e) { q[j][e] = p_[e]; float x[8]; unpack8(q[j][e], x);
#pragma unroll
                for (int i = 0; i < 8; ++i) m = fmaxf(m, fabsf(x[i])); }
            mx[j] = wave_max(m); }
        if (F.lane == 0) {
#pragma unroll
            for (int j = 0; j < 8; ++j) red[(4 * j + (tid >> 7)) * 2 + (F.wave & 1)] = mx[j]; }
        QS_BAR();
#pragma unroll
        for (int j = 0; j < 8; ++j) { const int c = 4 * j + (tid >> 7), row = gu_row(n0 + c, up); const float cm = fmaxf(red[2 * c], red[2 * c + 1]), inv = cm > 0.f ? 127.0f / cm : 0.f;
            float x[8], y[8]; unpack8(q[j][0], x); unpack8(q[j][1], y);
            v4u o; o.x = q8x4(x[0], x[1], x[2], x[3], inv); o.y = q8x4(x[4], x[5], x[6], x[7], inv); o.z = q8x4(y[0], y[1], y[2], y[3], inv); o.w = q8x4(y[4], y[5], y[6], y[7], inv);
            *(v4u*)(WT + (size_t)row * DM + 16 * (tid & 127)) = o;
            if ((tid & 127) == 0) cmax[row] = cm; }
        QS_BAR();
    }
#undef QS_SRC
#undef QS_LOAD
#undef QS_WRITE
#undef QS_BAR
}

__device__ __forceinline__ void layer_weights(Frame& F, int l, int& base) {
    unsigned char* wl = PWS() + WS_W + (size_t)l * W_LAYER;
    transpose_matrix(F, PIN(10) + (size_t)l * DFF * DM, DFF, DM, (bf16*)(wl + W_D1), 1.f, 0, 0, 1.f, RmIdent{}, base);
    transpose_matrix(F, PIN(28) + (size_t)l * DFF * DM, DFF, DM, (bf16*)(wl + W_D2), 1.f, 0, 0, 1.f, RmIdent{}, base);
    transpose_matrix(F, PIN(13) + (size_t)l * DM * DIN, DM, DIN, (bf16*)(wl + W_IN), 1.f, ZC_QSB, ZC_KSB, SB_QSCALE, RmIdent{}, base, PIN(12) + l * DM);
    transpose_matrix(F, PIN(16) + (size_t)l * 512 * 1536, 512, 1536, (bf16*)(wl + W_UQ), MLA_QSCALE, 0, 0, 1.f, RmIdent{}, base);
    transpose_matrix(F, PIN(17) + (size_t)l * 512 * 1024, 512, 1024, (bf16*)(wl + W_UKV), 1.f, 0, 0, 1.f, RmIdent{}, base);
    transpose_matrix(F, PIN(18) + (size_t)l * 512 * 1024, 512, 1024, (bf16*)(wl + W_UKV), 1.f, 0, 0, 1.f, RmOff{1024}, base);
    transpose_matrix(F, PIN(23) + (size_t)l * DM * DM, DM, DM, (bf16*)(wl + W_O), 1.f, 0, 0, 1.f, RmIdent{}, base);
}
__device__ __forceinline__ void layer_caches(Frame& F, int l, bool skew) {
    unsigned char* cl = PWS() + WS_C + (size_t)l * C_LAYER;
    { const float* src = PIN(2) + (size_t)l * 16 * 2048 * 512; bf16* dst = (bf16*)(cl + C_CKV);
      const int ntrip = skew ? (F.gw < 1024 ? 1 : 3) : (4096 - F.gw + F.ngw - 1) / F.ngw;
      for (int ti = 0; ti < ntrip; ++ti) { const int r0 = 8 * (skew ? (F.gw < 1024 ? F.gw : 1024 + 3 * (F.gw - 1024) + ti) : F.gw + ti * F.ngw); float f[8][8];
#pragma unroll
          for (int u = 0; u < 8; ++u) ld8f(src + (size_t)(r0 + u) * 512 + 8 * F.lane, f[u]);
#pragma unroll
          for (int u = 0; u < 8; ++u) { const int r = r0 + u, s = r >> 11, p = r & 2047; *(v4u*)(dst + (size_t)(8192 + s * 2112 + p) * 512 + 8 * F.lane) = pack8(f[u]); } } }
    { const float* src = PIN(3) + (size_t)l * 16 * 2048 * 64; unsigned char* dst = cl + C_KR;
      for (int it = F.gw; it < 16 * 32; it += F.ngw) { const int s = it >> 5, t = it & 31, tile = 128 + 33 * s + t; const float* rp = src + ((size_t)s * 2048 + t * 64 + F.lane) * 64;
          float f[8][8];
#pragma unroll
          for (int c = 0; c < 8; ++c) ld8f(rp + 8 * c, f[c]);
#pragma unroll
          for (int c = 0; c < 8; ++c) *(v4u*)(dst + ((size_t)(tile * 8 + c) * 64 + F.lane) * 16) = pack8(f[c]); } }
}
__device__ __forceinline__ void p0_prologue(Frame& F) {
    unsigned char* ws = PWS();
    int base = 0;
    for (int l = 0; l < DEPTH; ++l) {
        unsigned char* wl = ws + WS_W + (size_t)l * W_LAYER;
        if (l == 0 || F.ngw != 2048)
            layer_weights(F, l, base);
        { v4u* p = (v4u*)(wl + W_IN + (size_t)DIN * DM * 2); const int n16 = (DINP - DIN) * DM * 2 / 16;
          for (int i = F.gw * 64 + F.lane; i < n16; i += F.ngw * 64) p[i] = (v4u){0u, 0u, 0u, 0u}; }
    }
    { float* ct = (float*)(ws + WS_ROPE); float* st = ct + 4096 * 32;
      for (int i = F.gw * 64 + F.lane; i < 4096 * 32; i += F.ngw * 64) { const int pos = i >> 5, k = i & 31;
          const float inv = powf(10000.0f, -(float)k * (1.0f / 32.0f)); const float ang = (float)pos * inv; ct[i] = cosf(ang); st[i] = sinf(ang); } }
    for (int l = 0; l < DEPTH; ++l) layer_caches(F, l, F.ngw == 2048);
    { bf16* hb = (bf16*)(ws + WS_HB); float* rs = (float*)(ws + WS_RS);
      for (int m = (F.gw + F.ngw / 2) % F.ngw; m < MT; m += F.ngw) {   const float* xr = m < TP ? PIN(0) + (size_t)m * DM : PIN(1) + (size_t)(m - TP) * DM; row_to_bf16_rs(F, xr, hb + (size_t)m * DM, rs + m, ws + WS_HB8 + (size_t)m * DM); } }
}

__device__ __forceinline__ void deferred_layer1(Frame& F) {
    const int bid = (int)blockIdx.x; if (bid < 48 || F.ngw != 2048) return;
    Frame F2 = F; F2.gw = (bid - 48) * NWAVES + F.wave; F2.ngw = ((int)gridDim.x - 48) * NWAVES;
    int base = 0; layer_weights(F2, 1, base);
}

template <bool IN32> struct NormHRaw;
template <> struct NormHRaw<true> { typedef f32x4 T; static __device__ __forceinline__ T ld(const void* p, int i) { return *((const f32x4*)p + i); } static __device__ __forceinline__ f32x4 cvt(const T& w) { return w; } };
template <> struct NormHRaw<false> { typedef u32x2v T; static __device__ __forceinline__ T ld(const void* p, int i) { return *((const u32x2v*)p + i); } static __device__ __forceinline__ f32x4 cvt(const T& w) { return (f32x4){bflo(w.x), bfhi(w.x), bflo(w.y), bfhi(w.y)}; } };
template <bool IN32, bool OUT32>
__device__ __forceinline__ void norm_phase(Frame& F, const bf16* f, const bf16* f1, const void* hin_p, const void* hin_s, float coef, const float* g1, float* rs, void* hout, unsigned char* h8 = nullptr) {
    const bool deal = (F.ngw == 2048);
    const int nrow = deal ? (F.gw < 1024 ? 4 : 5) : (MT - F.gw + F.ngw - 1) / F.ngw;
#define NP_ROW(it_) (deal ? (F.gw < 1024 ? ((it_) == 0 ? TP + F.gw : 3 * F.gw + (it_) - 1) : 3072 + 5 * (F.gw - 1024) + (it_)) : F.gw + (it_) * F.ngw)
    typedef typename NormHRaw<IN32>::T HRaw;
    f32x4 gv[8]; u32x2v nf[8]; HRaw nh[8];
#pragma unroll
    for (int j = 0; j < 8; ++j) gv[j] = *((const f32x4*)g1 + F.lane + 64 * j);
#define NP_ISSUE(m_) do { const bf16* fr_ = f + (size_t)(m_) * DM; _Pragma("unroll") for (int j = 0; j < 8; ++j) nf[j] = *((const u32x2v*)fr_ + F.lane + 64 * j); \
        if (IN32) { const float* hr_ = (m_) < TP ? (const float*)hin_p + (size_t)(m_) * DM : (const float*)hin_s + (size_t)((m_) - TP) * DM; _Pragma("unroll") for (int j = 0; j < 8; ++j) nh[j] = NormHRaw<IN32>::ld(hr_, F.lane + 64 * j); } \
        else { const bf16* hr_ = (const bf16*)hin_p + (size_t)(m_) * DM; _Pragma("unroll") for (int j = 0; j < 8; ++j) nh[j] = NormHRaw<IN32>::ld(hr_, F.lane + 64 * j); } } while (0)
    if (nrow > 0) { const int m0_ = NP_ROW(0); NP_ISSUE(m0_); }
    for (int it = 0; it < nrow; ++it) {
        const int m = NP_ROW(it);
        f32x4 v[8], hv[8]; float s = 0.f;
#pragma unroll
        for (int j = 0; j < 8; ++j) { const u32x2v w = nf[j]; v[j] = (f32x4){bflo(w.x), bfhi(w.x), bflo(w.y), bfhi(w.y)}; hv[j] = NormHRaw<IN32>::cvt(nh[j]); }
        if (it + 1 < nrow) { const int mn_ = NP_ROW(it + 1); NP_ISSUE(mn_); }
        if (m >= TP) { const bf16* pr = f1 + (size_t)(m - TP) * DM;
            u32x2v pw[4][8];
#pragma unroll
            for (int p = 0; p < 4; ++p)
#pragma unroll
                for (int j = 0; j < 8; ++j) pw[p][j] = *((const u32x2v*)(pr + (size_t)p * 1024 * DM) + F.lane + 64 * j);
#pragma unroll
            for (int p = 0; p < 4; ++p)
#pragma unroll
                for (int j = 0; j < 8; ++j) v[j] = v[j] + (f32x4){bflo(pw[p][j].x), bfhi(pw[p][j].x), bflo(pw[p][j].y), bfhi(pw[p][j].y)};
#pragma unroll
            for (int p = 0; p < 3; ++p)
#pragma unroll
                for (int j = 0; j < 8; ++j) pw[p][j] = *((const u32x2v*)(pr + (size_t)(4 + p) * 1024 * DM) + F.lane + 64 * j);
#pragma unroll
            for (int p = 0; p < 3; ++p)
#pragma unroll
                for (int j = 0; j < 8; ++j) v[j] = v[j] + (f32x4){bflo(pw[p][j].x), bfhi(pw[p][j].x), bflo(pw[p][j].y), bfhi(pw[p][j].y)}; }
#pragma unroll
        for (int j = 0; j < 8; ++j) s += (v[j].x * v[j].x + v[j].y * v[j].y) + (v[j].z * v[j].z + v[j].w * v[j].w);
        const float rstd = coef / sqrtf(wave_sum(s) * (1.0f / DM) + EPS); float s2 = 0.f;
#pragma unroll
        for (int j = 0; j < 8; ++j) { const f32x4 gg = gv[j]; hv[j] = hv[j] + v[j] * gg * rstd;
            if (OUT32) *((f32x4*)((float*)hout + (size_t)m * DM) + F.lane + 64 * j) = hv[j];
            else { u32x2v w; w.x = pkbf(hv[j].x, hv[j].y); w.y = pkbf(hv[j].z, hv[j].w); *((u32x2v*)((bf16*)hout + (size_t)m * DM) + F.lane + 64 * j) = w; }
            s2 += (hv[j].x * hv[j].x + hv[j].y * hv[j].y) + (hv[j].z * hv[j].z + hv[j].w * hv[j].w); }
        if (rs) { float r2 = 1.0f / sqrtf(wave_sum(s2) * (1.0f / DM) + EPS); if (h8) r2 *= quant_row_i8(hv, h8 + (size_t)m * DM, F.lane); if (F.lane == 0) rs[m] = r2; }
    }
}
#undef NP_ROW
#undef NP_ISSUE

__device__ __forceinline__ void postz_phase(Frame& F, int l) {
    unsigned char* ws = PWS(); const bf16* Z = (const bf16*)(ws + WS_Z); bf16* CQN = (bf16*)(ws + WS_CQN); bf16* MRG = (bf16*)(ws + WS_XN);
    unsigned char* cl = ws + WS_C + (size_t)l * C_LAYER; bf16* CKV = (bf16*)(cl + C_CKV);
    const float* ctab = (const float*)(ws + WS_ROPE); const float* stab = ctab + 4096 * 32;
    const float* gq = PIN(14) + l * 512; const float* gkv = PIN(15) + l * 512; const float* cw = PIN(19) + l * 3 * 512; const float* gcv = PIN(21) + l * 512;
    float* out = POUT(); const int L8 = 8 * F.lane;
    float gq8[8], gkv8[8], gcv8[8], w0[8], w1[8], w2[8];
    ld8f(gq + L8, gq8); ld8f(gkv + L8, gkv8); ld8f(gcv + L8, gcv8); ld8f(cw + L8, w0); ld8f(cw + 512 + L8, w1); ld8f(cw + 1024 + L8, w2);
    for (int r = F.gw; r < MT; r += F.ngw) {
        const bool smp = r >= TP; const int b = smp ? (r - TP) >> 6 : r >> 12, t = smp ? (r - TP) & 63 : r & 4095, pos = smp ? 2048 + t : t;
        const int g = smp ? 8192 + b * 2112 + 2048 + t : r, tile = g >> 6, kap = g & 63;
        const bf16* zr = Z + (size_t)r * DINP;
        const v4u zq = *(const v4u*)(zr + ZC_CQ + L8), zkv = *(const v4u*)(zr + ZC_CKV + L8), zkr = *(const v4u*)(zr + ZC_KR + 8 * (F.lane & 7));
        const v4u zgc2 = *(const v4u*)(zr + ZC_GC + L8), zxc2 = *(const v4u*)(zr + ZC_XC + L8), zgb = *(const v4u*)(zr + ZC_GB + L8), zks = *(const v4u*)(zr + ZC_KSB + L8), zvs = *(const v4u*)(zr + ZC_VSB + L8);
        v4u zgc1 = (v4u){0u, 0u, 0u, 0u}, zxc1 = zgc1, zgc0 = zgc1, zxc0 = zgc1;
        float rc8[8], rs8[8]; ld8f(ctab + pos * 32 + 8 * (F.lane & 3), rc8); ld8f(stab + pos * 32 + 8 * (F.lane & 3), rs8);
        if (t >= 1) { zgc1 = *(const v4u*)(zr - DINP + ZC_GC + L8); zxc1 = *(const v4u*)(zr - DINP + ZC_XC + L8); }
        if (t >= 2) { zgc0 = *(const v4u*)(zr - 2 * DINP + ZC_GC + L8); zxc0 = *(const v4u*)(zr - 2 * DINP + ZC_XC + L8); }
        { float f[8]; unpack8(zq, f); float s = 0.f;
#pragma unroll
          for (int i = 0; i < 8; ++i) s += f[i] * f[i];
          const float rs = 1.0f / sqrtf(wave_sum(s) * (1.0f / 512) + EPS);
#pragma unroll
          for (int i = 0; i < 8; ++i) f[i] = f[i] * rs * gq8[i];
          *(v4u*)(CQN + (size_t)r * 512 + L8) = pack8(f); }
        { float f[8]; unpack8(zkv, f); float s = 0.f;
#pragma unroll
          for (int i = 0; i < 8; ++i) s += f[i] * f[i];
          const float rs = 1.0f / sqrtf(wave_sum(s) * (1.0f / 512) + EPS);
#pragma unroll
          for (int i = 0; i < 8; ++i) f[i] = f[i] * rs * gkv8[i];
          float* op = smp ? out + O_CKV_S + ((size_t)(l * 16 + b) * 64 + t) * 512 : out + O_CKV_P + ((size_t)(l * 2 + b) * 4096 + t) * 512;
          st8f(op + L8, f); *(v4u*)(CKV + (size_t)g * 512 + L8) = pack8(f); }
        { float f[8], p[8]; const int lz = F.lane & 7; unpack8(zkr, f);
#pragma unroll
          for (int i = 0; i < 8; ++i) p[i] = __shfl_xor(f[i], 4);
#pragma unroll
          for (int i = 0; i < 8; ++i) f[i] = (lz < 4) ? f[i] * rc8[i] - p[i] * rs8[i] : f[i] * rc8[i] + p[i] * rs8[i];
          if (F.lane < 8) { float* op = smp ? out + O_KR_S + ((size_t)(l * 16 + b) * 64 + t) * 64 : out + O_KR_P + ((size_t)(l * 2 + b) * 4096 + t) * 64;
              st8f(op + 8 * F.lane, f); *(v4u*)(cl + C_KR + ((size_t)(tile * 8 + F.lane) * 64 + kap) * 16) = pack8(f); } }
        { float uc0[8], uc1[8], uc2[8];
          { float a[8], x[8]; unpack8(zgc2, a); unpack8(zxc2, x);
#pragma unroll
            for (int i = 0; i < 8; ++i) uc2[i] = a[i] * x[i]; }
          if (t >= 1) { float a[8], x[8]; unpack8(zgc1, a); unpack8(zxc1, x);
#pragma unroll
            for (int i = 0; i < 8; ++i) uc1[i] = a[i] * x[i]; }
          else if (smp) ld8f(PIN(6) + ((size_t)(l * 16 + b) * 2 + 1) * 512 + L8, uc1);
          else {
#pragma unroll
            for (int i = 0; i < 8; ++i) uc1[i] = 0.f; }
          if (t >= 2) { float a[8], x[8]; unpack8(zgc0, a); unpack8(zxc0, x);
#pragma unroll
            for (int i = 0; i < 8; ++i) uc0[i] = a[i] * x[i]; }
          else if (smp) ld8f(PIN(6) + ((size_t)(l * 16 + b) * 2 + t) * 512 + L8, uc0);
          else {
#pragma unroll
            for (int i = 0; i < 8; ++i) uc0[i] = 0.f; }
          float gb[8], y[8]; unpack8(zgb, gb); float s = 0.f;
#pragma unroll
          for (int i = 0; i < 8; ++i) { y[i] = gb[i] * ((w0[i] * uc0[i] + w1[i] * uc1[i]) + w2[i] * uc2[i]); s += y[i] * y[i]; }
          const float rs = 1.0f / sqrtf(wave_sum(s) * (1.0f / 512) + EPS);
#pragma unroll
          for (int i = 0; i < 8; ++i) y[i] = y[i] * rs * gcv8[i];
          *(v4u*)(MRG + (size_t)r * DM + 1024 + L8) = pack8(y);
          const int S = smp ? 64 : 4096;
          if (t >= S - 2) { float* op = smp ? out + O_CONV_S + ((size_t)(l * 16 + b) * 2 + (t - (S - 2))) * 512 : out + O_CONV_P + ((size_t)(l * 2 + b) * 2 + (t - (S - 2))) * 512; st8f(op + L8, uc2); } }
        { float f[8]; const v4u kw = zks; unpack8(kw, f);
          float* op = smp ? out + O_SBK_S + ((size_t)(l * 16 + b) * 64 + t) * 512 : out + O_SBK_P + ((size_t)(l * 2 + b) * 4096 + t) * 512; st8f(op + L8, f);
          *(v4u*)(cl + C_KSB + ((size_t)((tile * 4 + (F.lane >> 4)) * 16 + (F.lane & 15)) * 64 + kap) * 16) = kw;
          unpack8(zvs, f);
          op = smp ? out + O_SBV_S + ((size_t)(l * 16 + b) * 64 + t) * 512 : out + O_SBV_P + ((size_t)(l * 2 + b) * 4096 + t) * 512; st8f(op + L8, f); }
    }
    { LAS unsigned char* tl = F.lds + F.wave * 17408;
      for (int it = (F.gw + F.ngw / 2) % F.ngw; it < 144 * 4; it += F.ngw) {   const int h = it & 3, ti = it >> 2; const int r0 = ti < 128 ? ti * 64 : TP + (ti - 128) * 64, tile = ti < 128 ? ti : 128 + 33 * (ti - 128) + 32;
          const bf16* zp = Z + (size_t)r0 * DINP + ZC_VSB + h * 128; const int kr = F.lane >> 4, c16 = F.lane & 15;
          v4u tw[16];
#pragma unroll
          for (int i = 0; i < 16; ++i) tw[i] = *(const v4u*)(zp + (size_t)(4 * i + kr) * DINP + 8 * c16);
#pragma unroll
          for (int i = 0; i < 16; ++i) { const int key = 4 * i + kr; *(LAS v4u*)(tl + key * 272 + c16 * 16) = tw[i]; }
          LDS_WAIT(); asm volatile("" ::: "memory");
#pragma unroll
          for (int dh = 0; dh < 2; ++dh) { const int d = dh * 64 + F.lane;
#pragma unroll
              for (int P = 0; P < 8; ++P) { unsigned e[8];
#pragma unroll
                  for (int j = 0; j < 8; ++j) { const int key = 16 * (P >> 1) + 4 * (P & 1) + (j < 4 ? j : j + 4); e[j] = *(const LAS unsigned short*)(tl + key * 272 + d * 2); }
                  v4u o; o.x = e[0] | (e[1] << 16); o.y = e[2] | (e[3] << 16); o.z = e[4] | (e[5] << 16); o.w = e[6] | (e[7] << 16);
                  *(v4u*)(cl + C_VTSB + ((size_t)((tile * 4 + h) * 8 + P) * 128 + d) * 16) = o; } }
          LDS_WAIT(); asm volatile("" ::: "memory"); } }
}

__device__ __forceinline__ void postattn_phase(Frame& F, int l) {
    const bf16* Y = (const bf16*)(PWS() + WS_YATT); bf16* MRG = (bf16*)(PWS() + WS_XN); const float* PO = (const float*)(PWS() + WS_PO); const float* PML = (const float*)(PWS() + WS_PML);
    const float* gm = PIN(20) + l * 1024; const float* gs = PIN(22) + l * 512; const int L8 = 8 * F.lane;
    float g0[8], g1[8], g2[8]; ld8f(gm + L8, g0); ld8f(gm + 512 + L8, g1); ld8f(gs + L8, g2);
    for (int r = F.gw; r < MT; r += F.ngw) {
        const bf16* yr = Y + (size_t)r * YW; float a[8], b[8], c[8];
        if (r >= TP) {
            const int sI = (r - TP) >> 6, rr = (r - TP) & 63;
#pragma unroll
            for (int hh = 0; hh < 2; ++hh) { const int h = 4 * hh + (F.lane >> 4); const size_t pu = (size_t)((sI * 8 + h) * 3);
                float mp[3], lp[3], mm = -INFINITY;
#pragma unroll
                for (int p = 0; p < 3; ++p) { mp[p] = PML[((pu + p) * 64 + rr) * 2]; lp[p] = PML[((pu + p) * 64 + rr) * 2 + 1]; mm = fmaxf(mm, mp[p]); }
                float acc[8], den = 0.f;
#pragma unroll
                for (int i = 0; i < 8; ++i) acc[i] = 0.f;
#pragma unroll
                for (int p = 0; p < 3; ++p) { const float w = __builtin_amdgcn_exp2f(mp[p] - mm); den += lp[p] * w; float x[8]; ld8f(PO + ((pu + p) * 64 + rr) * 128 + 8 * (F.lane & 15), x);
#pragma unroll
                    for (int i = 0; i < 8; ++i) acc[i] += x[i] * w; }
                const float inv = 1.0f / den;
#pragma unroll
                for (int i = 0; i < 8; ++i) { if (hh) b[i] = acc[i] * inv; else a[i] = acc[i] * inv; } }
        } else if (((r & 4095) >> 8) >= 12) {
            const int qb = (r & 4095) >> 8, bI = r >> 12, rr = r & 255;
            const bf16* PO16 = (const bf16*)(PWS() + WS_PO16); const float* PML16 = (const float*)(PWS() + WS_PML16);
#pragma unroll
            for (int hh = 0; hh < 2; ++hh) { const int h = 4 * hh + (F.lane >> 4); const size_t pu = (size_t)((bI * 8 + h) * 8 + 2 * (qb - 12));
                const float m0 = PML16[(pu * 256 + rr) * 2], l0 = PML16[(pu * 256 + rr) * 2 + 1], m1 = PML16[((pu + 1) * 256 + rr) * 2], l1 = PML16[((pu + 1) * 256 + rr) * 2 + 1];
                const float mm = fmaxf(m0, m1), w0 = __builtin_amdgcn_exp2f(m0 - mm), w1 = __builtin_amdgcn_exp2f(m1 - mm), inv = 1.0f / (l0 * w0 + l1 * w1);
                float x0[8], x1[8]; unpack8(*(const v4u*)(PO16 + (pu * 256 + rr) * 128 + 8 * (F.lane & 15)), x0); unpack8(*(const v4u*)(PO16 + ((pu + 1) * 256 + rr) * 128 + 8 * (F.lane & 15)), x1);
#pragma unroll
                for (int i = 0; i < 8; ++i) { const float v = (x0[i] * w0 + x1[i] * w1) * inv; if (hh) b[i] = v; else a[i] = v; } }
        } else { unpack8(*(const v4u*)(yr + L8), a); unpack8(*(const v4u*)(yr + 512 + L8), b); }
        unpack8(*(const v4u*)(yr + 1024 + L8), c);
        float s1 = 0.f, s2 = 0.f;
#pragma unroll
        for (int i = 0; i < 8; ++i) { s1 += a[i] * a[i] + b[i] * b[i]; s2 += c[i] * c[i]; }
        const float r1 = 1.0f / sqrtf(wave_sum(s1) * (1.0f / 1024) + EPS), r2 = 1.0f / sqrtf(wave_sum(s2) * (1.0f / 512) + EPS);
#pragma unroll
        for (int i = 0; i < 8; ++i) { a[i] = a[i] * r1 * g0[i]; b[i] = b[i] * r1 * g1[i]; c[i] = c[i] * r2 * g2[i]; }
        bf16* mr = MRG + (size_t)r * DM; *(v4u*)(mr + L8) = pack8(a); *(v4u*)(mr + 512 + L8) = pack8(b); *(v4u*)(mr + 1536 + L8) = pack8(c);
    }
}

struct AttnJob {
    const bf16* q; int qpitch; int nrows; int pos0;
    const unsigned char* kA; int kA_ts; const unsigned char* kB; int kB_ts; const unsigned char* vt; int vt_ts;
    int ntiles; bf16* out; int opitch;
    int t0; bf16* po; float* pml;
    const float* kc; const float* vc; int ncache;
};
constexpr int ATT_BUF = 40960, ATT_K = 0, ATT_KB = 16384, ATT_V = 24576, ATT_FLAGS = 139264, ATT_QWORD = ATT_FLAGS + 64;
constexpr int S4_KR = 65536, S4_V = 73728;
#define ATT_GLDS(gp, loff) __builtin_amdgcn_global_load_lds((const unsigned*)(gp), (LAS unsigned*)(lds + (loff)), 16, 0, 0)
#define ATT_MFMA(a, b, c) __builtin_amdgcn_mfma_f32_32x32x16_bf16((a), (b), (c), 0, 0, 0)

template <bool SB>
__device__ __forceinline__ void attn_issue(LAS unsigned char* lds, const AttnJob& J, int t, int buf, int wid, int lane) {
    const int lb = buf * ATT_BUF;
    const unsigned char* ka = J.kA + (size_t)t * J.kA_ts + wid * 2048 + lane * 16;
    ATT_GLDS(ka, lb + ATT_K + wid * 2048); ATT_GLDS(ka + 1024, lb + ATT_K + wid * 2048 + 1024);
    if (!SB) { const unsigned char* kb = J.kB + (size_t)t * J.kB_ts + wid * 1024 + lane * 16; ATT_GLDS(kb, lb + ATT_KB + wid * 1024); }
    const unsigned char* vp = J.vt + (size_t)t * J.vt_ts + wid * 2048 + lane * 16;
    ATT_GLDS(vp, lb + ATT_V + wid * 2048); ATT_GLDS(vp + 1024, lb + ATT_V + wid * 2048 + 1024);
}

__device__ __forceinline__ void attn_stage_cache(LAS unsigned char* lds, const AttnJob& J, int t, int buf, int tid) {
    const int lb = buf * ATT_BUF;
    { const int key = tid & 63, cg = tid >> 6; const float* kp = J.kc + (size_t)(64 * t + key) * 512;
#pragma unroll
      for (int i = 0; i < 2; ++i) { const int c = cg + 8 * i; float f[8]; ld8f(kp + 8 * c, f); *(LAS v4u*)(lds + lb + ATT_K + (c * 64 + key) * 16) = pack8(f); } }
    { const int d = tid & 127, pq = tid >> 7; const float* vp = J.vc + (size_t)(64 * t) * 512 + d;
#pragma unroll
      for (int i = 0; i < 2; ++i) { const int P = pq + 4 * i; float f[8];
#pragma unroll
          for (int j = 0; j < 8; ++j) { const int key = 16 * (P >> 1) + 4 * (P & 1) + (j < 4 ? j : j + 4); f[j] = vp[(size_t)key * 512]; }
          *(LAS v4u*)(lds + lb + ATT_V + (P * 128 + d) * 16) = pack8(f); } }
}

template <bool SB>
__device__ __forceinline__ void attn_unit(LAS unsigned char* lds, const AttnJob& J, const float* ctab, const float* stab, int wid, int lane) {
    constexpr int NQ = SB ? 8 : 12;
    const int r32 = lane & 31, hi = lane >> 5, r0 = wid * 32;
    const bool active = r0 < J.nrows;
    const int nt = J.ntiles;
    const int ncache = SB ? J.ncache : 0;
    if (!SB || nt - 1 >= ncache) attn_issue<SB>(lds, J, SB ? nt - 1 : 0, 0, wid, lane);
    bf16x8 qf[NQ];
    const int qpos = J.pos0 + r0 + r32;
    if (active) {
        const bf16* qp = J.q + (size_t)(r0 + r32) * J.qpitch + 8 * hi;
#pragma unroll
        for (int d0 = 0; d0 < NQ; ++d0) qf[d0] = *(const bf16x8*)(qp + 16 * d0);
        if (!SB) {
#pragma unroll
            for (int fi = 0; fi < 2; ++fi) {
                float x1[8], x2[8], c[8], s[8]; unpack8(__builtin_bit_cast(v4u, qf[8 + fi]), x1); unpack8(__builtin_bit_cast(v4u, qf[10 + fi]), x2);
                ld8f(ctab + qpos * 32 + 16 * fi + 8 * hi, c); ld8f(stab + qpos * 32 + 16 * fi + 8 * hi, s);
                float o1[8], o2[8];
#pragma unroll
                for (int j = 0; j < 8; ++j) { o1[j] = x1[j] * c[j] - x2[j] * s[j]; o2[j] = x2[j] * c[j] + x1[j] * s[j]; }
                qf[8 + fi] = __builtin_bit_cast(bf16x8, pack8(o1)); qf[10 + fi] = __builtin_bit_cast(bf16x8, pack8(o2));
            }
        }
    } else {
#pragma unroll
        for (int d0 = 0; d0 < NQ; ++d0) qf[d0] = (bf16x8){0, 0, 0, 0, 0, 0, 0, 0};
    }
    f32x16 o[4];
#pragma unroll
    for (int db = 0; db < 4; ++db)
#pragma unroll
        for (int r = 0; r < 16; ++r) o[db][r] = 0.f;
    float m_run = -INFINITY, l_run = 0.f, R = 0.f;
    const int wave_lim = SB ? 0 : ((J.pos0 + r0) >> 6);
    const int max_qp = J.pos0 + r0 + 31;
    for (int i = 0; i < nt; ++i) {
        const int t = SB ? nt - 1 - i : i;
        if (SB) {
            const bool nxt_dma = (i + 1 < nt) && (t - 1 >= ncache);
            if (nxt_dma) attn_issue<SB>(lds, J, t - 1, (i + 1) & 1, wid, lane);
            if (t >= ncache) { if (nxt_dma) asm volatile("s_waitcnt vmcnt(4)" ::: "memory"); else asm volatile("s_waitcnt vmcnt(0)" ::: "memory"); }
            else { attn_stage_cache(lds, J, t, i & 1, (int)threadIdx.x); asm volatile("s_waitcnt vmcnt(0) lgkmcnt(0)" ::: "memory"); }
        } else {
            if (i + 1 < nt) { attn_issue<SB>(lds, J, t + 1, (i + 1) & 1, wid, lane); asm volatile("s_waitcnt vmcnt(5)" ::: "memory"); }
            else asm volatile("s_waitcnt vmcnt(0)" ::: "memory");
        }
        __builtin_amdgcn_s_barrier(); asm volatile("" ::: "memory");
        const bool work = active && (SB ? (64 * t < max_qp) : (t + J.t0 <= wave_lim));
        if (work) {
            LAS unsigned char* kbuf = lds + (i & 1) * ATT_BUF + hi * 1024 + r32 * 16;
            LAS unsigned char* vbuf = lds + (i & 1) * ATT_BUF + ATT_V + hi * 2048 + r32 * 16;
            f32x16 s0, s1;
#pragma unroll
            for (int r = 0; r < 16; ++r) { s0[r] = 0.f; s1[r] = 0.f; }
            bf16x8 ka[2][4];
#define ATT_RDK(buf, dbase) do { _Pragma("unroll") for (int j_ = 0; j_ < 2; ++j_) { ka[buf][2 * j_] = *(const LAS bf16x8*)(kbuf + ((dbase) + j_) * 2048); ka[buf][2 * j_ + 1] = *(const LAS bf16x8*)(kbuf + ((dbase) + j_) * 2048 + 512); } } while (0)
#define ATT_MMK(buf, dbase) do { _Pragma("unroll") for (int j_ = 0; j_ < 2; ++j_) { s0 = ATT_MFMA(ka[buf][2 * j_], qf[(dbase) + j_], s0); s1 = ATT_MFMA(ka[buf][2 * j_ + 1], qf[(dbase) + j_], s1); } } while (0)
#define ATT_RDV(buf, g) do { _Pragma("unroll") for (int db_ = 0; db_ < 4; ++db_) ka[buf][db_] = *(const LAS bf16x8*)(vbuf + (g) * 4096 + db_ * 512); } while (0)
#define ATT_MMV(buf, g) do { _Pragma("unroll") for (int db_ = 0; db_ < 4; ++db_) o[db_] = ATT_MFMA(ka[buf][db_], pb[g], o[db_]); } while (0)
#define ATT_SB0 __builtin_amdgcn_sched_barrier(0)
            ATT_RDK(0, 0); ATT_SB0;
            ATT_RDK(1, 2); ATT_MMK(0, 0); ATT_SB0;
            ATT_RDK(0, 4); ATT_MMK(1, 2); ATT_SB0;
            ATT_RDK(1, 6); ATT_MMK(0, 4); ATT_SB0;
            if (NQ == 12) { ATT_RDK(0, 8); ATT_MMK(1, 6); ATT_SB0;
                            ATT_RDK(1, 10); ATT_MMK(0, 8); ATT_SB0;
                            ATT_RDV(0, 0); ATT_MMK(1, 10); ATT_SB0; }
            else          { ATT_MMK(1, 6); ATT_SB0; }
            if (!SB) {
                float mx = s0[0];
#pragma unroll
                for (int r = 1; r < 16; ++r) mx = fmaxf(mx, s0[r]);
#pragma unroll
                for (int r = 0; r < 16; ++r) mx = fmaxf(mx, s1[r]);
                mx = fmaxf(mx, __shfl_xor(mx, 32));
                const float mn = fmaxf(m_run, mx), alpha = __builtin_amdgcn_exp2f(m_run - mn); m_run = mn;
                float ls = 0.f;
#pragma unroll
                for (int r = 0; r < 16; ++r) { s0[r] = __builtin_amdgcn_exp2f(s0[r] - mn); s1[r] = __builtin_amdgcn_exp2f(s1[r] - mn); ls += s0[r] + s1[r]; }
                l_run = l_run * alpha + ls;
#pragma unroll
                for (int db = 0; db < 4; ++db)
#pragma unroll
                    for (int r = 0; r < 16; ++r) o[db][r] *= alpha;
            } else {
                const int kbase = 64 * t + 4 * hi;
                float gs[8], L0[16], L1[16];
#pragma unroll
                for (int kb = 0; kb < 2; ++kb)
#pragma unroll
                    for (int gq = 0; gq < 4; ++gq) { float acc = 0.f;
#pragma unroll
                        for (int e = 0; e < 4; ++e) { const int r = 4 * gq + e; const float x = kb ? s1[r] : s0[r];
                            const float sp = fmaxf(x, 0.f) + LN2 * __builtin_amdgcn_logf(1.0f + __builtin_amdgcn_exp2f(-fabsf(x) * LOG2E));
                            const bool earlier = (kbase + 32 * kb + e + 8 * gq) < qpos;
                            const float lk = earlier ? -sp : 0.f; acc += lk;
                            if (kb) { L1[r] = lk; s1[r] = x - sp; } else { L0[r] = lk; s0[r] = x - sp; } }
                        gs[4 * kb + gq] = acc; }
                float pgs[8];
#pragma unroll
                for (int j = 0; j < 8; ++j) pgs[j] = __shfl_xor(gs[j], 32);
                float T = 0.f;
#pragma unroll
                for (int j = 7; j >= 0; --j) { const int kb = j >> 2, gq = j & 3;
                    float W = T + (hi == 0 ? pgs[j] : 0.f) + R;
#pragma unroll
                    for (int e = 3; e >= 0; --e) { const int r = 4 * gq + e; const float lb = kb ? s1[r] : s0[r];
                        const bool earlier = (kbase + 32 * kb + e + 8 * gq) < qpos;
                        const float w = earlier ? __builtin_amdgcn_exp2f((lb + W) * LOG2E) : 0.f;
                        W += kb ? L1[r] : L0[r];
                        if (kb) s1[r] = w; else s0[r] = w; }
                    T += gs[j] + pgs[j]; }
                R += T;
            }
            bf16x8 pb[4];
            { v4u w;
              w.x = pkbf(s0[0], s0[1]); w.y = pkbf(s0[2], s0[3]); w.z = pkbf(s0[4], s0[5]); w.w = pkbf(s0[6], s0[7]); pb[0] = __builtin_bit_cast(bf16x8, w);
              w.x = pkbf(s0[8], s0[9]); w.y = pkbf(s0[10], s0[11]); w.z = pkbf(s0[12], s0[13]); w.w = pkbf(s0[14], s0[15]); pb[1] = __builtin_bit_cast(bf16x8, w);
              w.x = pkbf(s1[0], s1[1]); w.y = pkbf(s1[2], s1[3]); w.z = pkbf(s1[4], s1[5]); w.w = pkbf(s1[6], s1[7]); pb[2] = __builtin_bit_cast(bf16x8, w);
              w.x = pkbf(s1[8], s1[9]); w.y = pkbf(s1[10], s1[11]); w.z = pkbf(s1[12], s1[13]); w.w = pkbf(s1[14], s1[15]); pb[3] = __builtin_bit_cast(bf16x8, w); }
            ATT_SB0;
            if (SB) { ATT_RDV(0, 0); ATT_RDV(1, 1); ATT_SB0; } else { ATT_RDV(1, 1); ATT_SB0; }
            ATT_MMV(0, 0); ATT_RDV(0, 2); ATT_SB0;
            ATT_MMV(1, 1); ATT_RDV(1, 3); ATT_SB0;
            ATT_MMV(0, 2); ATT_SB0;
            ATT_MMV(1, 3);
#undef ATT_SB0
#undef ATT_RDK
#undef ATT_MMK
#undef ATT_RDV
#undef ATT_MMV
        }
        if (SB) { const bool done = !active || __all(R < SB_EXIT); if (lane == 0) *(volatile LAS unsigned*)(lds + ATT_FLAGS + (i & 1) * 32 + wid * 4) = done ? 1u : 0u; }
        asm volatile("s_waitcnt lgkmcnt(0)" ::: "memory"); __builtin_amdgcn_s_barrier(); asm volatile("" ::: "memory");
        if (SB) { const volatile LAS unsigned* fl = (const volatile LAS unsigned*)(lds + ATT_FLAGS + (i & 1) * 32);
            unsigned all = fl[0] & fl[1] & fl[2] & fl[3] & fl[4] & fl[5] & fl[6] & fl[7];
            if (__builtin_amdgcn_readfirstlane(all)) break; }
    }
    asm volatile("s_waitcnt vmcnt(0)" ::: "memory");
    if (active) {
        float inv = 1.f; bf16* op = J.out + (size_t)(r0 + r32) * J.opitch + 4 * hi;
        if (!SB) { const float lt = l_run + __shfl_xor(l_run, 32); inv = 1.0f / lt;
            if (J.po) { inv = 1.0f; op = J.po + (size_t)(r0 + r32) * 128 + 4 * hi; if (hi == 0) { float* ml = J.pml + (size_t)(r0 + r32) * 2; ml[0] = m_run; ml[1] = lt; } } }
#pragma unroll
        for (int db = 0; db < 4; ++db)
#pragma unroll
            for (int gq = 0; gq < 4; ++gq) { u32x2v w; w.x = pkbf(o[db][4 * gq] * inv, o[db][4 * gq + 1] * inv); w.y = pkbf(o[db][4 * gq + 2] * inv, o[db][4 * gq + 3] * inv);
                *(u32x2v*)(op + 32 * db + 8 * gq) = w; }
    }
    __builtin_amdgcn_s_barrier();
}

__device__ __forceinline__ void attn_unit_pp(LAS unsigned char* lds, const AttnJob& J, const float* ctab, const float* stab, int wid, int lane) {
    constexpr int NQ = 12, PPK = 24576, PPV0 = 49152, PPV = 16384;
    const int r32 = lane & 31, hi = lane >> 5, r0 = wid * 32;
    const bool late = wid >= 4;
    const int nt = J.ntiles;
#define PP_ISSUE(t, kb, vb) do { const unsigned char* ka_ = J.kA + (size_t)(t) * J.kA_ts + wid * 2048 + lane * 16; \
        ATT_GLDS(ka_, (kb) * PPK + wid * 2048); ATT_GLDS(ka_ + 1024, (kb) * PPK + wid * 2048 + 1024); \
        const unsigned char* kr_ = J.kB + (size_t)(t) * J.kB_ts + wid * 1024 + lane * 16; ATT_GLDS(kr_, (kb) * PPK + 16384 + wid * 1024); \
        const unsigned char* vp_ = J.vt + (size_t)(t) * J.vt_ts + wid * 2048 + lane * 16; \
        ATT_GLDS(vp_, PPV0 + (vb) * PPV + wid * 2048); ATT_GLDS(vp_ + 1024, PPV0 + (vb) * PPV + wid * 2048 + 1024); } while (0)
    PP_ISSUE(0, 0, 0);
    if (wid == 0 && lane == 0) { volatile LAS unsigned long long* st = (volatile LAS unsigned long long*)(lds + ATT_FLAGS + 256); st[0] = (unsigned long long)J.out; st[1] = (unsigned long long)J.po; st[2] = (unsigned long long)J.pml; }
    const int opitch_ = J.opitch;
    bf16x8 qf[NQ];
    const int qpos = J.pos0 + r0 + r32;
    { const bf16* qp = J.q + (size_t)(r0 + r32) * J.qpitch + 8 * hi;
#pragma unroll
      for (int d0 = 0; d0 < NQ; ++d0) qf[d0] = *(const bf16x8*)(qp + 16 * d0);
#pragma unroll
      for (int fi = 0; fi < 2; ++fi) {
          float x1[8], x2[8], c[8], sn[8]; unpack8(__builtin_bit_cast(v4u, qf[8 + fi]), x1); unpack8(__builtin_bit_cast(v4u, qf[10 + fi]), x2);
          ld8f(ctab + qpos * 32 + 16 * fi + 8 * hi, c); ld8f(stab + qpos * 32 + 16 * fi + 8 * hi, sn);
          float o1[8], o2[8];
#pragma unroll
          for (int j = 0; j < 8; ++j) { o1[j] = x1[j] * c[j] - x2[j] * sn[j]; o2[j] = x2[j] * c[j] + x1[j] * sn[j]; }
          qf[8 + fi] = __builtin_bit_cast(bf16x8, pack8(o1)); qf[10 + fi] = __builtin_bit_cast(bf16x8, pack8(o2)); } }
    f32x16 o[4];
#pragma unroll
    for (int db = 0; db < 4; ++db)
#pragma unroll
        for (int r = 0; r < 16; ++r) o[db][r] = 0.f;
    float m_run = -INFINITY, l_run = 0.f;
    const int wave_lim = (J.pos0 + r0) >> 6;
    bf16x8 pb[4]; bool pend = false;
    int vb = 0;
#define PP_SB0 __builtin_amdgcn_sched_barrier(0)
#define PP_RDK(buf, d0_) do { kq[buf][0] = *(const LAS bf16x8*)(kbuf + (d0_) * 2048); kq[buf][1] = *(const LAS bf16x8*)(kbuf + (d0_) * 2048 + 512); } while (0)
#define PP_MMK(buf, d0_) do { s0 = ATT_MFMA(kq[buf][0], qf[d0_], s0); s1 = ATT_MFMA(kq[buf][1], qf[d0_], s1); } while (0)
#define PP_RDV(buf, g, vbuf_) do { _Pragma("unroll") for (int db_ = 0; db_ < 4; ++db_) ka[buf][db_] = *(const LAS bf16x8*)((vbuf_) + (g) * 4096 + db_ * 512); } while (0)
#define PP_MMV(buf, g) do { _Pragma("unroll") for (int db_ = 0; db_ < 4; ++db_) o[db_] = ATT_MFMA(ka[buf][db_], pb[g], o[db_]); } while (0)
#define PP_PV(vbuf_) do { bf16x8 ka[2][4]; PP_SB0; PP_RDV(0, 0, vbuf_); PP_RDV(1, 1, vbuf_); PP_SB0; PP_MMV(0, 0); PP_RDV(0, 2, vbuf_); PP_SB0; PP_MMV(1, 1); PP_RDV(1, 3, vbuf_); PP_SB0; PP_MMV(0, 2); PP_SB0; PP_MMV(1, 3); PP_SB0; } while (0)
    for (int i = 0; i < nt; ++i) {
        asm volatile("s_waitcnt vmcnt(0) lgkmcnt(0)" ::: "memory"); __builtin_amdgcn_s_barrier(); asm volatile("" ::: "memory");
        const int vn = (vb == 2) ? 0 : vb + 1, vp = (vb == 0) ? 2 : vb - 1;
        if (i + 1 < nt) PP_ISSUE(i + 1, (i + 1) & 1, vn);
        LAS unsigned char* kbuf = lds + (i & 1) * PPK + hi * 1024 + r32 * 16;
        LAS unsigned char* vcur = lds + PPV0 + vb * PPV + hi * 2048 + r32 * 16;
        LAS unsigned char* vprv = lds + PPV0 + vp * PPV + hi * 2048 + r32 * 16;
        if (pend) { PP_PV(vprv); pend = false; }
        if (i + J.t0 <= wave_lim) {
            f32x16 s0, s1;
#pragma unroll
            for (int r = 0; r < 16; ++r) { s0[r] = 0.f; s1[r] = 0.f; }
            bf16x8 kq[2][2];
            PP_RDK(0, 0); PP_SB0;
#pragma unroll
            for (int d0 = 0; d0 < NQ; ++d0) { if (d0 + 1 < NQ) PP_RDK((d0 + 1) & 1, d0 + 1); PP_MMK(d0 & 1, d0); PP_SB0; }
            float mx = s0[0];
#pragma unroll
            for (int r = 1; r < 16; ++r) mx = fmaxf(mx, s0[r]);
#pragma unroll
            for (int r = 0; r < 16; ++r) mx = fmaxf(mx, s1[r]);
            mx = fmaxf(mx, __shfl_xor(mx, 32));
            const float mn = fmaxf(m_run, mx), alpha = __builtin_amdgcn_exp2f(m_run - mn); m_run = mn;
            float ls = 0.f;
#pragma unroll
            for (int r = 0; r < 16; ++r) { s0[r] = __builtin_amdgcn_exp2f(s0[r] - mn); s1[r] = __builtin_amdgcn_exp2f(s1[r] - mn); ls += s0[r] + s1[r]; }
            l_run = l_run * alpha + ls;
#pragma unroll
            for (int db = 0; db < 4; ++db)
#pragma unroll
                for (int r = 0; r < 16; ++r) o[db][r] *= alpha;
            { v4u w;
              w.x = pkbf(s0[0], s0[1]); w.y = pkbf(s0[2], s0[3]); w.z = pkbf(s0[4], s0[5]); w.w = pkbf(s0[6], s0[7]); pb[0] = __builtin_bit_cast(bf16x8, w);
              w.x = pkbf(s0[8], s0[9]); w.y = pkbf(s0[10], s0[11]); w.z = pkbf(s0[12], s0[13]); w.w = pkbf(s0[14], s0[15]); pb[1] = __builtin_bit_cast(bf16x8, w);
              w.x = pkbf(s1[0], s1[1]); w.y = pkbf(s1[2], s1[3]); w.z = pkbf(s1[4], s1[5]); w.w = pkbf(s1[6], s1[7]); pb[2] = __builtin_bit_cast(bf16x8, w);
              w.x = pkbf(s1[8], s1[9]); w.y = pkbf(s1[10], s1[11]); w.z = pkbf(s1[12], s1[13]); w.w = pkbf(s1[14], s1[15]); pb[3] = __builtin_bit_cast(bf16x8, w); }
            if (late) pend = true; else { PP_PV(vcur); }
        }
        vb = vn;
    }
    if (pend) { const int vl = (vb == 0) ? 2 : vb - 1; LAS unsigned char* vlast = lds + PPV0 + vl * PPV + hi * 2048 + r32 * 16; PP_PV(vlast); }
    asm volatile("s_waitcnt vmcnt(0) lgkmcnt(0)" ::: "memory");
    { const int r32e = r32, hie = hi;
      const volatile LAS unsigned long long* st = (const volatile LAS unsigned long long*)(lds + ATT_FLAGS + 256);
      bf16* out_ = (bf16*)st[0]; bf16* po_ = (bf16*)st[1]; float* pml_ = (float*)st[2];
      float inv = 1.f; bf16* op = out_ + (size_t)(r0 + r32e) * opitch_ + 4 * hie;
      const float lt = l_run + __shfl_xor(l_run, 32); inv = 1.0f / lt;
      if (po_) { inv = 1.0f; op = po_ + (size_t)(r0 + r32e) * 128 + 4 * hie; if (hie == 0) { float* ml = pml_ + (size_t)(r0 + r32e) * 2; ml[0] = m_run; ml[1] = lt; } }
#pragma unroll
      for (int db = 0; db < 4; ++db)
#pragma unroll
          for (int gq = 0; gq < 4; ++gq) { u32x2v w; w.x = pkbf(o[db][4 * gq] * inv, o[db][4 * gq + 1] * inv); w.y = pkbf(o[db][4 * gq + 2] * inv, o[db][4 * gq + 3] * inv);
              *(u32x2v*)(op + 32 * db + 8 * gq) = w; } }
    __builtin_amdgcn_s_barrier();
#undef PP_ISSUE
#undef PP_SB0
#undef PP_RDK
#undef PP_MMK
#undef PP_RDV
#undef PP_MMV
#undef PP_PV
}

__device__ __forceinline__ void attn_unit_s4(LAS unsigned char* lds, const bf16* qrow0, const unsigned char* kn, const unsigned char* kr, const unsigned char* vt, int nt, float* po, float* pml,
                                             const float* ctab, const float* stab, int wid, int lane) {
    const int r32 = lane & 31, hi = lane >> 5, hs = wid >> 1, r0 = (wid & 1) * 32;
#define S4_ISSUE_K(t) do { const unsigned char* g_ = kn + (size_t)(t) * (8 * 16384) + wid * 8192 + lane * 16; \
        _Pragma("unroll") for (int p_ = 0; p_ < 8; ++p_) ATT_GLDS(g_ + p_ * 1024, wid * 8192 + p_ * 1024); \
        ATT_GLDS(kr + (size_t)(t) * 8192 + wid * 1024 + lane * 16, S4_KR + wid * 1024); } while (0)
#define S4_ISSUE_V(t) do { const unsigned char* g_ = vt + (size_t)(t) * (8 * 16384) + wid * 8192 + lane * 16; \
        _Pragma("unroll") for (int p_ = 0; p_ < 8; ++p_) ATT_GLDS(g_ + p_ * 1024, S4_V + wid * 8192 + p_ * 1024); } while (0)
    S4_ISSUE_K(0);
    bf16x8 qf[12];
    const int qpos = 2048 + r0 + r32;
    { const bf16* qp = qrow0 + (size_t)(r0 + r32) * QW + hs * 192 + 8 * hi;
#pragma unroll
      for (int d0 = 0; d0 < 12; ++d0) qf[d0] = *(const bf16x8*)(qp + 16 * d0);
#pragma unroll
      for (int fi = 0; fi < 2; ++fi) {
          float x1[8], x2[8], c[8], sn[8]; unpack8(__builtin_bit_cast(v4u, qf[8 + fi]), x1); unpack8(__builtin_bit_cast(v4u, qf[10 + fi]), x2);
          ld8f(ctab + qpos * 32 + 16 * fi + 8 * hi, c); ld8f(stab + qpos * 32 + 16 * fi + 8 * hi, sn);
          float o1[8], o2[8];
#pragma unroll
          for (int j = 0; j < 8; ++j) { o1[j] = x1[j] * c[j] - x2[j] * sn[j]; o2[j] = x2[j] * c[j] + x1[j] * sn[j]; }
          qf[8 + fi] = __builtin_bit_cast(bf16x8, pack8(o1)); qf[10 + fi] = __builtin_bit_cast(bf16x8, pack8(o2)); } }
    f32x16 o[4];
#pragma unroll
    for (int db = 0; db < 4; ++db)
#pragma unroll
        for (int r = 0; r < 16; ++r) o[db][r] = 0.f;
    float m_run = -INFINITY, l_run = 0.f;
    LAS unsigned char* kbuf = lds + hs * 16384 + hi * 1024 + r32 * 16;
    LAS unsigned char* krbuf = lds + S4_KR + hi * 1024 + r32 * 16;
    LAS unsigned char* vbuf = lds + S4_V + hs * 16384 + hi * 2048 + r32 * 16;
    for (int i = 0; i < nt; ++i) {
        asm volatile("s_waitcnt vmcnt(0) lgkmcnt(0)" ::: "memory"); __builtin_amdgcn_s_barrier(); asm volatile("" ::: "memory");
        S4_ISSUE_V(i);
        f32x16 s0, s1;
#pragma unroll
        for (int r = 0; r < 16; ++r) { s0[r] = 0.f; s1[r] = 0.f; }
        bf16x8 ka[2][4];
#define S4_RDK(buf, dbase) do { _Pragma("unroll") for (int j_ = 0; j_ < 2; ++j_) { LAS unsigned char* kb_ = ((dbase) + j_) < 8 ? kbuf + ((dbase) + j_) * 2048 : krbuf + ((dbase) + j_ - 8) * 2048; \
            ka[buf][2 * j_] = *(const LAS bf16x8*)(kb_); ka[buf][2 * j_ + 1] = *(const LAS bf16x8*)(kb_ + 512); } } while (0)
#define S4_MMK(buf, dbase) do { _Pragma("unroll") for (int j_ = 0; j_ < 2; ++j_) { s0 = ATT_MFMA(ka[buf][2 * j_], qf[(dbase) + j_], s0); s1 = ATT_MFMA(ka[buf][2 * j_ + 1], qf[(dbase) + j_], s1); } } while (0)
#define S4_RDV(buf, g) do { _Pragma("unroll") for (int db_ = 0; db_ < 4; ++db_) ka[buf][db_] = *(const LAS bf16x8*)(vbuf + (g) * 4096 + db_ * 512); } while (0)
#define S4_MMV(buf, g) do { _Pragma("unroll") for (int db_ = 0; db_ < 4; ++db_) o[db_] = ATT_MFMA(ka[buf][db_], pb[g], o[db_]); } while (0)
#define S4_SB0 __builtin_amdgcn_sched_barrier(0)
        S4_RDK(0, 0); S4_SB0;
        S4_RDK(1, 2); S4_MMK(0, 0); S4_SB0;
        S4_RDK(0, 4); S4_MMK(1, 2); S4_SB0;
        S4_RDK(1, 6); S4_MMK(0, 4); S4_SB0;
        S4_RDK(0, 8); S4_MMK(1, 6); S4_SB0;
        S4_RDK(1, 10); S4_MMK(0, 8); S4_SB0;
        S4_MMK(1, 10); S4_SB0;
        float mx = s0[0];
#pragma unroll
        for (int r = 1; r < 16; ++r) mx = fmaxf(mx, s0[r]);
#pragma unroll
        for (int r = 0; r < 16; ++r) mx = fmaxf(mx, s1[r]);
        mx = fmaxf(mx, __shfl_xor(mx, 32));
        const float mn = fmaxf(m_run, mx), alpha = __builtin_amdgcn_exp2f(m_run - mn); m_run = mn;
        float ls = 0.f;
#pragma unroll
        for (int r = 0; r < 16; ++r) { s0[r] = __builtin_amdgcn_exp2f(s0[r] - mn); s1[r] = __builtin_amdgcn_exp2f(s1[r] - mn); ls += s0[r] + s1[r]; }
        l_run = l_run * alpha + ls;
#pragma unroll
        for (int db = 0; db < 4; ++db)
#pragma unroll
            for (int r = 0; r < 16; ++r) o[db][r] *= alpha;
        bf16x8 pb[4];
        { v4u w;
          w.x = pkbf(s0[0], s0[1]); w.y = pkbf(s0[2], s0[3]); w.z = pkbf(s0[4], s0[5]); w.w = pkbf(s0[6], s0[7]); pb[0] = __builtin_bit_cast(bf16x8, w);
          w.x = pkbf(s0[8], s0[9]); w.y = pkbf(s0[10], s0[11]); w.z = pkbf(s0[12], s0[13]); w.w = pkbf(s0[14], s0[15]); pb[1] = __builtin_bit_cast(bf16x8, w);
          w.x = pkbf(s1[0], s1[1]); w.y = pkbf(s1[2], s1[3]); w.z = pkbf(s1[4], s1[5]); w.w = pkbf(s1[6], s1[7]); pb[2] = __builtin_bit_cast(bf16x8, w);
          w.x = pkbf(s1[8], s1[9]); w.y = pkbf(s1[10], s1[11]); w.z = pkbf(s1[12], s1[13]); w.w = pkbf(s1[14], s1[15]); pb[3] = __builtin_bit_cast(bf16x8, w); }
        asm volatile("s_waitcnt vmcnt(0) lgkmcnt(0)" ::: "memory"); __builtin_amdgcn_s_barrier(); asm volatile("" ::: "memory");
        if (i + 1 < nt) S4_ISSUE_K(i + 1);
        S4_SB0;
        S4_RDV(0, 0); S4_RDV(1, 1); S4_SB0;
        S4_MMV(0, 0); S4_RDV(0, 2); S4_SB0;
        S4_MMV(1, 1); S4_RDV(1, 3); S4_SB0;
        S4_MMV(0, 2); S4_SB0;
        S4_MMV(1, 3);
#undef S4_RDK
#undef S4_MMK
#undef S4_RDV
#undef S4_MMV
#undef S4_SB0
    }
    asm volatile("s_waitcnt vmcnt(0) lgkmcnt(0)" ::: "memory");
    { const float lt = l_run + __shfl_xor(l_run, 32);
      float* pp = po + ((size_t)hs * 3 * 64 + (r0 + r32)) * 128 + 4 * hi;
#pragma unroll
      for (int db = 0; db < 4; ++db)
#pragma unroll
          for (int gq = 0; gq < 4; ++gq) *(f32x4*)(pp + 32 * db + 8 * gq) = (f32x4){o[db][4 * gq], o[db][4 * gq + 1], o[db][4 * gq + 2], o[db][4 * gq + 3]};
      if (hi == 0) { float* ml = pml + ((size_t)hs * 3 * 64 + (r0 + r32)) * 2; ml[0] = m_run; ml[1] = lt; } }
    __builtin_amdgcn_s_barrier();
#undef S4_ISSUE_K
#undef S4_ISSUE_V
}

__device__ __forceinline__ int queue_next(Frame& F, gu32* head) {
    volatile LAS unsigned* w = (volatile LAS unsigned*)(F.lds + ATT_QWORD);
    if (F.tid == 0) *w = __hip_atomic_fetch_add(head, 1u, RLX_AGENT);
    LDS_WAIT(); __syncthreads();
    const int v = (int)*w;
    LDS_WAIT(); __syncthreads();
    return v;
}

constexpr int MLA_NITEMS = 416;
__constant__ unsigned mla_items[MLA_NITEMS][2] = {
{0x6002c0u, 0xffffu}, {0x6002c2u, 0xffffu}, {0x6002c4u, 0xffffu}, {0x6002c6u, 0xffffu}, {0x6002c8u, 0xffffu}, {0x6002cau, 0xffffu}, {0x6002ccu, 0xffffu}, {0x6002ceu, 0xffffu},
{0x6002d0u, 0xffffu}, {0x6002d2u, 0xffffu}, {0x6002d4u, 0xffffu}, {0x6002d6u, 0xffffu}, {0x6002d8u, 0xffffu}, {0x6002dau, 0xffffu}, {0x6002dcu, 0xffffu}, {0x6002deu, 0xffffu},
{0x580280u, 0xffffu}, {0x580282u, 0xffffu}, {0x580284u, 0xffffu}, {0x580286u, 0xffffu}, {0x580288u, 0xffffu}, {0x58028au, 0xffffu}, {0x58028cu, 0xffffu}, {0x58028eu, 0xffffu},
{0x580290u, 0xffffu}, {0x580292u, 0xffffu}, {0x580294u, 0xffffu}, {0x580296u, 0xffffu}, {0x580298u, 0xffffu}, {0x58029au, 0xffffu}, {0x58029cu, 0xffffu}, {0x58029eu, 0xffffu},
{0x500240u, 0xffffu}, {0x500242u, 0xffffu}, {0x500244u, 0xffffu}, {0x500246u, 0xffffu}, {0x500248u, 0xffffu}, {0x50024au, 0xffffu}, {0x50024cu, 0xffffu}, {0x50024eu, 0xffffu},
{0x500250u, 0xffffu}, {0x500252u, 0xffffu}, {0x500254u, 0xffffu}, {0x500256u, 0xffffu}, {0x500258u, 0xffffu}, {0x50025au, 0xffffu}, {0x50025cu, 0xffffu}, {0x50025eu, 0xffffu},
{0x480200u, 0xffffu}, {0x480202u, 0xffffu}, {0x480204u, 0xffffu}, {0x480206u, 0xffffu}, {0x480208u, 0xffffu}, {0x48020au, 0xffffu}, {0x48020cu, 0xffffu}, {0x48020eu, 0xffffu},
{0x480210u, 0xffffu}, {0x480212u, 0xffffu}, {0x480214u, 0xffffu}, {0x480216u, 0xffffu}, {0x480218u, 0xffffu}, {0x48021au, 0xffffu}, {0x48021cu, 0xffffu}, {0x48021eu, 0xffffu},
{0x4001c0u, 0xffffu}, {0x4001c2u, 0xffffu}, {0x4001c4u, 0xffffu}, {0x4001c6u, 0xffffu}, {0x4001c8u, 0xffffu}, {0x4001cau, 0xffffu}, {0x4001ccu, 0xffffu}, {0x4001ceu, 0xffffu},
{0x4001d0u, 0xffffu}, {0x4001d2u, 0xffffu}, {0x4001d4u, 0xffffu}, {0x4001d6u, 0xffffu}, {0x4001d8u, 0xffffu}, {0x4001dau, 0xffffu}, {0x4001dcu, 0xffffu}, {0x4001deu, 0xffffu},
{0x4003c0u, 0x6u}, {0x4083c0u, 0x7u}, {0x4003c2u, 0xeu}, {0x4083c2u, 0xfu}, {0x4003c4u, 0x16u}, {0x4083c4u, 0x17u}, {0x4003c6u, 0x1eu}, {0x4083c6u, 0x1fu},
{0x4003c8u, 0x26u}, {0x4083c8u, 0x27u}, {0x4003cau, 0x2eu}, {0x4083cau, 0x2fu}, {0x4003ccu, 0x36u}, {0x4083ccu, 0x37u}, {0x4003ceu, 0x3eu}, {0x4083ceu, 0x3fu},
{0x4003d0u, 0x46u}, {0x4083d0u, 0x47u}, {0x4003d2u, 0x4eu}, {0x4083d2u, 0x4fu}, {0x4003d4u, 0x56u}, {0x4083d4u, 0x57u}, {0x4003d6u, 0x5eu}, {0x4083d6u, 0x5fu},
{0x4003d8u, 0x66u}, {0x4083d8u, 0x67u}, {0x4003dau, 0x6eu}, {0x4083dau, 0x6fu}, {0x4003dcu, 0x76u}, {0x4083dcu, 0x77u}, {0x4003deu, 0x7eu}, {0x4083deu, 0x7fu},
{0x3c0380u, 0x4u}, {0x3c7b80u, 0x5u}, {0x3c0382u, 0xcu}, {0x3c7b82u, 0xdu}, {0x3c0384u, 0x14u}, {0x3c7b84u, 0x15u}, {0x3c0386u, 0x1cu}, {0x3c7b86u, 0x1du},
{0x3c0388u, 0x24u}, {0x3c7b88u, 0x25u}, {0x3c038au, 0x2cu}, {0x3c7b8au, 0x2du}, {0x3c038cu, 0x34u}, {0x3c7b8cu, 0x35u}, {0x3c038eu, 0x3cu}, {0x3c7b8eu, 0x3du},
{0x3c0390u, 0x44u}, {0x3c7b90u, 0x45u}, {0x3c0392u, 0x4cu}, {0x3c7b92u, 0x4du}, {0x3c0394u, 0x54u}, {0x3c7b94u, 0x55u}, {0x3c0396u, 0x5cu}, {0x3c7b96u, 0x5du},
{0x3c0398u, 0x64u}, {0x3c7b98u, 0x65u}, {0x3c039au, 0x6cu}, {0x3c7b9au, 0x6du}, {0x3c039cu, 0x74u}, {0x3c7b9cu, 0x75u}, {0x3c039eu, 0x7cu}, {0x3c7b9eu, 0x7du},
{0x380180u, 0xffffu}, {0x380182u, 0xffffu}, {0x380184u, 0xffffu}, {0x380186u, 0xffffu}, {0x380188u, 0xffffu}, {0x38018au, 0xffffu}, {0x38018cu, 0xffffu}, {0x38018eu, 0xffffu},
{0x380190u, 0xffffu}, {0x380192u, 0xffffu}, {0x380194u, 0xffffu}, {0x380196u, 0xffffu}, {0x380198u, 0xffffu}, {0x38019au, 0xffffu}, {0x38019cu, 0xffffu}, {0x38019eu, 0xffffu},
{0x380340u, 0x2u}, {0x387340u, 0x3u}, {0x380342u, 0xau}, {0x387342u, 0xbu}, {0x380344u, 0x12u}, {0x387344u, 0x13u}, {0x380346u, 0x1au}, {0x387346u, 0x1bu},
{0x380348u, 0x22u}, {0x387348u, 0x23u}, {0x38034au, 0x2au}, {0x38734au, 0x2bu}, {0x38034cu, 0x32u}, {0x38734cu, 0x33u}, {0x38034eu, 0x3au}, {0x38734eu, 0x3bu},
{0x380350u, 0x42u}, {0x387350u, 0x43u}, {0x380352u, 0x4au}, {0x387352u, 0x4bu}, {0x380354u, 0x52u}, {0x387354u, 0x53u}, {0x380356u, 0x5au}, {0x387356u, 0x5bu},
{0x380358u, 0x62u}, {0x387358u, 0x63u}, {0x38035au, 0x6au}, {0x38735au, 0x6bu}, {0x38035cu, 0x72u}, {0x38735cu, 0x73u}, {0x38035eu, 0x7au}, {0x38735eu, 0x7bu},
{0x340300u, 0x0u}, {0x346b00u, 0x1u}, {0x340302u, 0x8u}, {0x346b02u, 0x9u}, {0x340304u, 0x10u}, {0x346b04u, 0x11u}, {0x340306u, 0x18u}, {0x346b06u, 0x19u},
{0x340308u, 0x20u}, {0x346b08u, 0x21u}, {0x34030au, 0x28u}, {0x346b0au, 0x29u}, {0x34030cu, 0x30u}, {0x346b0cu, 0x31u}, {0x34030eu, 0x38u}, {0x346b0eu, 0x39u},
{0x340310u, 0x40u}, {0x346b10u, 0x41u}, {0x340312u, 0x48u}, {0x346b12u, 0x49u}, {0x340314u, 0x50u}, {0x346b14u, 0x51u}, {0x340316u, 0x58u}, {0x346b16u, 0x59u},
{0x340318u, 0x60u}, {0x346b18u, 0x61u}, {0x34031au, 0x68u}, {0x346b1au, 0x69u}, {0x34031cu, 0x70u}, {0x346b1cu, 0x71u}, {0x34031eu, 0x78u}, {0x346b1eu, 0x79u},
{0x300140u, 0xffffu}, {0x300142u, 0xffffu}, {0x300144u, 0xffffu}, {0x300146u, 0xffffu}, {0x300148u, 0xffffu}, {0x30014au, 0xffffu}, {0x30014cu, 0xffffu}, {0x30014eu, 0xffffu},
{0x300150u, 0xffffu}, {0x300152u, 0xffffu}, {0x300154u, 0xffffu}, {0x300156u, 0xffffu}, {0x300158u, 0xffffu}, {0x30015au, 0xffffu}, {0x30015cu, 0xffffu}, {0x30015eu, 0xffffu},
{0x280100u, 0xffffu}, {0x280102u, 0xffffu}, {0x280104u, 0xffffu}, {0x280106u, 0xffffu}, {0x280108u, 0xffffu}, {0x28010au, 0xffffu}, {0x28010cu, 0xffffu}, {0x28010eu, 0xffffu},
{0x280110u, 0xffffu}, {0x280112u, 0xffffu}, {0x280114u, 0xffffu}, {0x280116u, 0xffffu}, {0x280118u, 0xffffu}, {0x28011au, 0xffffu}, {0x28011cu, 0xffffu}, {0x28011eu, 0xffffu},
{0x2000c0u, 0xffffu}, {0x2000c2u, 0xffffu}, {0x2000c4u, 0xffffu}, {0x2000c6u, 0xffffu}, {0x2000c8u, 0xffffu}, {0x2000cau, 0xffffu}, {0x2000ccu, 0xffffu}, {0x2000ceu, 0xffffu},
{0x2000d0u, 0xffffu}, {0x2000d2u, 0xffffu}, {0x2000d4u, 0xffffu}, {0x2000d6u, 0xffffu}, {0x2000d8u, 0xffffu}, {0x2000dau, 0xffffu}, {0x2000dcu, 0xffffu}, {0x2000deu, 0xffffu},
{0x180080u, 0xffffu}, {0x180082u, 0xffffu}, {0x180084u, 0xffffu}, {0x180086u, 0xffffu}, {0x180088u, 0xffffu}, {0x18008au, 0xffffu}, {0x18008cu, 0xffffu}, {0x18008eu, 0xffffu},
{0x180090u, 0xffffu}, {0x180092u, 0xffffu}, {0x180094u, 0xffffu}, {0x180096u, 0xffffu}, {0x180098u, 0xffffu}, {0x18009au, 0xffffu}, {0x18009cu, 0xffffu}, {0x18009eu, 0xffffu},
{0x160001u, 0x0u}, {0x160041u, 0x0u}, {0x160081u, 0x0u}, {0x160003u, 0x0u}, {0x160043u, 0x0u}, {0x160083u, 0x0u}, {0x160005u, 0x0u}, {0x160045u, 0x0u},
{0x160085u, 0x0u}, {0x160007u, 0x0u}, {0x160047u, 0x0u}, {0x160087u, 0x0u}, {0x160009u, 0x0u}, {0x160049u, 0x0u}, {0x160089u, 0x0u}, {0x16000bu, 0x0u},
{0x16004bu, 0x0u}, {0x16008bu, 0x0u}, {0x16000du, 0x0u}, {0x16004du, 0x0u}, {0x16008du, 0x0u}, {0x16000fu, 0x0u}, {0x16004fu, 0x0u}, {0x16008fu, 0x0u},
{0x160011u, 0x0u}, {0x160051u, 0x0u}, {0x160091u, 0x0u}, {0x160013u, 0x0u}, {0x160053u, 0x0u}, {0x160093u, 0x0u}, {0x160015u, 0x0u}, {0x160055u, 0x0u},
{0x160095u, 0x0u}, {0x160017u, 0x0u}, {0x160057u, 0x0u}, {0x160097u, 0x0u}, {0x160019u, 0x0u}, {0x160059u, 0x0u}, {0x160099u, 0x0u}, {0x16001bu, 0x0u},
{0x16005bu, 0x0u}, {0x16009bu, 0x0u}, {0x16001du, 0x0u}, {0x16005du, 0x0u}, {0x16009du, 0x0u}, {0x16001fu, 0x0u}, {0x16005fu, 0x0u}, {0x16009fu, 0x0u},
{0x160021u, 0x0u}, {0x160061u, 0x0u}, {0x1600a1u, 0x0u}, {0x160023u, 0x0u}, {0x160063u, 0x0u}, {0x1600a3u, 0x0u}, {0x160025u, 0x0u}, {0x160065u, 0x0u},
{0x1600a5u, 0x0u}, {0x160027u, 0x0u}, {0x160067u, 0x0u}, {0x1600a7u, 0x0u}, {0x160029u, 0x0u}, {0x160069u, 0x0u}, {0x1600a9u, 0x0u}, {0x16002bu, 0x0u},
{0x16006bu, 0x0u}, {0x1600abu, 0x0u}, {0x16002du, 0x0u}, {0x16006du, 0x0u}, {0x1600adu, 0x0u}, {0x16002fu, 0x0u}, {0x16006fu, 0x0u}, {0x1600afu, 0x0u},
{0x160031u, 0x0u}, {0x160071u, 0x0u}, {0x1600b1u, 0x0u}, {0x160033u, 0x0u}, {0x160073u, 0x0u}, {0x1600b3u, 0x0u}, {0x160035u, 0x0u}, {0x160075u, 0x0u},
{0x1600b5u, 0x0u}, {0x160037u, 0x0u}, {0x160077u, 0x0u}, {0x1600b7u, 0x0u}, {0x160039u, 0x0u}, {0x160079u, 0x0u}, {0x1600b9u, 0x0u}, {0x16003bu, 0x0u},
{0x16007bu, 0x0u}, {0x1600bbu, 0x0u}, {0x16003du, 0x0u}, {0x16007du, 0x0u}, {0x1600bdu, 0x0u}, {0x16003fu, 0x0u}, {0x16007fu, 0x0u}, {0x1600bfu, 0x0u},
{0x100040u, 0xffffu}, {0x100042u, 0xffffu}, {0x100044u, 0xffffu}, {0x100046u, 0xffffu}, {0x100048u, 0xffffu}, {0x10004au, 0xffffu}, {0x10004cu, 0xffffu}, {0x10004eu, 0xffffu},
{0x100050u, 0xffffu}, {0x100052u, 0xffffu}, {0x100054u, 0xffffu}, {0x100056u, 0xffffu}, {0x100058u, 0xffffu}, {0x10005au, 0xffffu}, {0x10005cu, 0xffffu}, {0x10005eu, 0xffffu},
{0x80000u, 0xffffu}, {0x80002u, 0xffffu}, {0x80004u, 0xffffu}, {0x80006u, 0xffffu}, {0x80008u, 0xffffu}, {0x8000au, 0xffffu}, {0x8000cu, 0xffffu}, {0x8000eu, 0xffffu},
{0x80010u, 0xffffu}, {0x80012u, 0xffffu}, {0x80014u, 0xffffu}, {0x80016u, 0xffffu}, {0x80018u, 0xffffu}, {0x8001au, 0xffffu}, {0x8001cu, 0xffffu}, {0x8001eu, 0xffffu} };
__device__ __forceinline__ void attention_phase(Frame& F, int l, int rep) {
    unsigned char* ws = PWS(); unsigned char* cl = ws + WS_C + (size_t)l * C_LAYER;
    const float* ctab = (const float*)(ws + WS_ROPE); const float* stab = ctab + 4096 * 32;
    const bf16* Q = (const bf16*)(ws + WS_Q); const bf16* Z = (const bf16*)(ws + WS_Z); bf16* Y = (bf16*)(ws + WS_YATT);
    const unsigned char* KN = ws + WS_KN; const unsigned char* VT = ws + WS_VT; const unsigned char* KR = cl + C_KR; const unsigned char* KSB = cl + C_KSB; const unsigned char* VTSB = cl + C_VTSB;
    if (rep == 0 || ((DUPM >> 14) & 1u))
    { gu32* head = F.ctl + CW_QUEUE + 64 * (2 * l + 4 * rep);
      float* PO = (float*)(ws + WS_PO); float* PML = (float*)(ws + WS_PML);
      bf16* PO16 = (bf16*)(ws + WS_PO16); float* PML16 = (float*)(ws + WS_PML16);
      for (;;) { const int id = queue_next(F, head); if (id >= MLA_NITEMS) break;
          const unsigned w0 = mla_items[id][0], w1 = mla_items[id][1];
          if ((w0 & 1u) == 0u) { AttnJob J; J.kc = nullptr; J.vc = nullptr; J.ncache = 0;
              const int bh = (w0 >> 1) & 31, qb = (w0 >> 6) & 15, t0 = (w0 >> 10) & 127, ntl = (w0 >> 17) & 127, b = bh >> 3, h = bh & 7, row0 = b * 4096 + 256 * qb, tile0 = b * 64 + t0;
              J.nrows = 256; J.pos0 = 256 * qb; J.ntiles = ntl; J.t0 = t0; J.po = nullptr; J.pml = nullptr;
              if (w1 != 0xffffu) { J.po = PO16 + (size_t)w1 * 256 * 128; J.pml = PML16 + (size_t)w1 * 256 * 2; }
              J.q = Q + (size_t)row0 * QW + h * 192; J.qpitch = QW;
              J.kA = KN + ((size_t)tile0 * 8 + h) * 16384; J.kA_ts = 8 * 16384; J.kB = KR + (size_t)tile0 * 8192; J.kB_ts = 8192; J.vt = VT + ((size_t)tile0 * 8 + h) * 16384; J.vt_ts = 8 * 16384;
              J.out = Y + (size_t)row0 * YW + h * 128; J.opitch = YW;
              int ln_ = F.lane; asm volatile("" : "+v"(ln_));
              attn_unit_pp(F.lds, J, ctab, stab, F.wave, ln_); }
          else { const int sg = (w0 >> 1) & 31, part = (w0 >> 6) & 15, sI = sg >> 1, hg = sg & 1, tile0 = 128 + 33 * sI + 11 * part;
              const size_t pu = (size_t)((sI * 8 + 4 * hg) * 3 + part);
              int ln_ = F.lane; asm volatile("" : "+v"(ln_));
              attn_unit_s4(F.lds, Q + (size_t)(TP + 64 * sI) * QW + 4 * hg * 192, KN + ((size_t)tile0 * 8 + 4 * hg) * 16384, KR + (size_t)tile0 * 8192, VT + ((size_t)tile0 * 8 + 4 * hg) * 16384, 11,
                           PO + pu * 64 * 128, PML + pu * 64 * 2, ctab, stab, F.wave, ln_); } } }
    if (rep == 0 || ((DUPM >> 15) & 1u))
    { gu32* head = F.ctl + CW_QUEUE + 64 * (2 * l + 1 + 4 * rep);
      for (;;) { const int id = queue_next(F, head); if (id >= 192) break;
          AttnJob J; int row0, tile0, h; J.kc = nullptr; J.vc = nullptr; J.ncache = 0; J.t0 = 0; J.po = nullptr; J.pml = nullptr;
          if (id < 128) { const int qb = 15 - (id >> 3), b = (id >> 2) & 1; h = id & 3; row0 = b * 4096 + 256 * qb; tile0 = b * 64; J.nrows = 256; J.pos0 = 256 * qb; J.ntiles = 4 * qb + 4; }
          else { const int u = id - 128, s = u >> 2; h = u & 3; row0 = TP + 64 * s; tile0 = 128 + 33 * s; J.nrows = 64; J.pos0 = 2048; J.ntiles = 33;
              J.kc = PIN(4) + ((size_t)(l * 16 + s) * 2048) * 512 + h * 128; J.vc = PIN(5) + ((size_t)(l * 16 + s) * 2048) * 512 + h * 128; J.ncache = 32; }
          J.q = Z + (size_t)row0 * DINP + ZC_QSB + h * 128; J.qpitch = DINP;
          J.kA = KSB + ((size_t)tile0 * 4 + h) * 16384; J.kA_ts = 4 * 16384; J.kB = nullptr; J.kB_ts = 0; J.vt = VTSB + ((size_t)tile0 * 4 + h) * 16384; J.vt_ts = 4 * 16384;
          J.out = Y + (size_t)row0 * YW + 1024 + h * 128; J.opitch = YW;
          int ln_ = F.lane; asm volatile("" : "+v"(ln_));
          attn_unit<true>(F.lds, J, ctab, stab, F.wave, ln_); } }
}

#ifndef MK_SPLIT
#define MK_SPLIT 0
#endif
constexpr int NPH = 1 + 13 * DEPTH;
using EVtSb = pg8::EpiVtBlk<true, 4>; using EVtMla = pg8::EpiVtBlk<false, 8>; using EKnMla = pg8::EpiKBlk<8>;
__global__ void __launch_bounds__(NWAVES * 64, 2) fwd_kernel(Args args) {
    extern __shared__ __attribute__((aligned(16))) unsigned char lds_raw[];
    Frame F;
    F.lds = (LAS unsigned char*)lds_raw;
    F.MISC = (volatile LAS unsigned*)(F.lds + MISC_OFF);
    F.tid = threadIdx.x; F.lane = F.tid & 63; F.wave = __builtin_amdgcn_readfirstlane(F.tid >> 6);
    const int G = gridDim.x; const int vcu = (G % 8 == 0) ? ((int)blockIdx.x % 8) * (G / 8) + (int)blockIdx.x / 8 : (int)blockIdx.x;
    F.gw = vcu * NWAVES + F.wave; F.ngw = G * NWAVES;
    F.ctl = (gu32*)(args.ws + WS_CTL);
    { LAS unsigned long long* pp = (LAS unsigned long long*)(F.lds + PARAM_OFF);
      if (F.tid == 0) {
#pragma unroll
          for (int k = 0; k < 30; ++k) pp[k] = (unsigned long long)args.in[k];
          pp[30] = (unsigned long long)args.out; pp[31] = (unsigned long long)args.ws; } }
    for (int u = F.tid; u < 64; u += NWAVES * 64) ((LAS unsigned*)(F.lds + MISC_OFF))[u] = 0u;
    __syncthreads();
    XcdBarrier bar; bar.bar = (unsigned*)(F.ctl + CW_BAR); bar.x = 0; bar.st = nullptr;
    if (!MK_SPLIT) bar = xcd_barrier_post((unsigned*)(F.ctl + CW_BAR), F.MISC + 8);
    const int lo = args.ph_lo, hi = args.ph_hi;
#ifndef PHM
#define PHM 0xFFFFFFFFu
#endif
#define EN(j) ((PHM >> (j)) & 1u)
#define NREP(j) (((DUPM >> (j)) & 1u) ? 3 : 1)
#define IN(k) (lo <= (k) && (k) < hi)
#define SEAM(k) do { if (IN((k) + 1)) xcd_barrier(bar); } while (0)
#define LAUNDER() asm volatile("" : "+v"(F.tid), "+v"(F.lane), "+s"(F.wave), "+s"(F.gw))
#define WL() (PWS() + WS_W + (size_t)l * W_LAYER)
#define CL() (PWS() + WS_C + (size_t)l * C_LAYER)
#define GEMM_CALL(EPI, AP, BP, MM, NN, KK, EOBJ) do { int bid_ = (int)blockIdx.x; asm volatile("" : "+s"(bid_)); pg8::Gemm g{(const bf16*)(AP), (const bf16*)(BP), (MM), (NN), (KK)}; pg8::StaticOrder S; S.init((MM), (NN), (KK), (int)gridDim.x, bid_); \
        pg8::gemm_phase<EPI, pg8::StaticOrder, true, true>(F.lds, g, S, (EOBJ)); } while (0)
#define GEMM_CALL_I8(EPI, AP, BP, MM, NN, KK, EOBJ) do { int bid_ = (int)blockIdx.x; asm volatile("" : "+s"(bid_)); pg8::Gemm g{(const bf16*)(AP), (const bf16*)(BP), (MM), (NN), (KK)}; pg8::StaticOrder S; S.init((MM), (NN), (KK), (int)gridDim.x, bid_); \
        pg8::gemm_phase<EPI, pg8::StaticOrder, true, true, true>(F.lds, g, S, (EOBJ)); } while (0)
#define GEMM_CALL_SUB(EPI, AP, BP, MM, NN, KK, EOBJ, C0, CIDX, I0, I1) do { int bid_ = (int)blockIdx.x; asm volatile("" : "+s"(bid_)); pg8::Gemm g{(const bf16*)(AP), (const bf16*)(BP), (MM), (NN), (KK)}; pg8::SubsetOrder S; \
        S.init((MM), (NN), (KK), (int)gridDim.x, (CIDX), (C0), (I0), (I1)); pg8::gemm_phase<EPI, pg8::SubsetOrder, true, true>(F.lds, g, S, (EOBJ)); } while (0)
#define GEMM_CALL_NEW(EPI, ROWS, AP, BP, MM, NN, KK, EOBJ, ROT) do { int bid_ = (int)blockIdx.x; asm volatile("" : "+s"(bid_)); bid_ = (bid_ + (int)gridDim.x - (ROT)) % (int)gridDim.x; pg8::Gemm g{(const bf16*)(AP), (const bf16*)(BP), (MM), (NN), (KK)}; pg8::NewKeyOrder<ROWS> S; S.init((MM), (NN), (KK), (int)gridDim.x, bid_); \
        pg8::gemm_phase<EPI, pg8::NewKeyOrder<ROWS>, true, true>(F.lds, g, S, (EOBJ)); } while (0)
#define GEMM_CALL_SK(EPI, AP, BP, MM, NN, KK, EOBJ) do { pg8::Gemm g{(const bf16*)(AP), (const bf16*)(BP), (MM), (NN), (KK)}; int bid_ = (int)blockIdx.x; asm volatile("" : "+s"(bid_)); pg8::TailSplitOrder S; S.init((MM), (NN), (KK), (int)gridDim.x, bid_); \
        pg8::gemm_phase<EPI, pg8::TailSplitOrder, true, true>(F.lds, g, S, (EOBJ)); } while (0)
    if (EN(13) && IN(0)) for (int rep = 0; rep < NREP(13); ++rep) { LAUNDER(); p0_prologue(F); LAUNDER(); __syncthreads(); quant_strips(F); SEAM(0); }
    for (int l = 0; l < DEPTH; ++l) {
        const int pb = 1 + 13 * l;
        if (EN(0) && IN(pb + 0)) for (int rep = 0; rep < NREP(0); ++rep) { LAUNDER();
            { unsigned char* ws = PWS(); pg8::EpiSwiGLUi8 E{(bf16*)(ws + WS_HID), DFF, (const float*)(ws + WS_RS), (const float*)(ws + WS_CS) + (size_t)(l * 2) * 2 * DFF};
              GEMM_CALL_I8(pg8::EpiSwiGLUi8, ws + WS_HB8, WL() + W_GU1, MT, 2 * DFF, DM / 2, E); }
            { unsigned char* ws = PWS(); EKnMla E{ws + WS_KN, 32}; GEMM_CALL_SUB(EKnMla, CL() + C_CKV + (size_t)8192 * 512 * 2, WL() + W_UKV, NKEY - 8192, 1024, 512, E, 48, bid_, 0, 2); }
            SEAM(pb + 0); }
        if (EN(1) && IN(pb + 1)) for (int rep = 0; rep < NREP(1); ++rep) { LAUNDER(); unsigned char* ws = PWS(); pg8::EpiFmix E{(bf16*)(ws + WS_F), (bf16*)(ws + WS_F1), DM, DFF / 64}; GEMM_CALL_SK(pg8::EpiFmix, ws + WS_HID, WL() + W_D1, MT, DM, DFF, E); SEAM(pb + 1); }
        if (EN(2) && IN(pb + 2)) { LAUNDER(); unsigned char* ws = PWS(); bf16* HB = (bf16*)(ws + WS_HB);
            if (l == 0) norm_phase<true, false>(F, (const bf16*)(ws + WS_F), (const bf16*)(ws + WS_F1), PIN(0), PIN(1), 0.5f, PIN(11) + l * DM, (float*)(ws + WS_RS), HB);
            else norm_phase<false, false>(F, (const bf16*)(ws + WS_F), (const bf16*)(ws + WS_F1), HB, nullptr, 0.5f, PIN(11) + l * DM, (float*)(ws + WS_RS), HB);
            SEAM(pb + 2); }
        if (EN(3) && IN(pb + 3)) for (int rep = 0; rep < NREP(3); ++rep) { LAUNDER();
            { unsigned char* ws = PWS(); pg8::EpiBf16 E{(bf16*)(ws + WS_Z), DINP, (const float*)(ws + WS_RS)}; GEMM_CALL(pg8::EpiBf16, ws + WS_HB, WL() + W_IN, MT, DINP, DM, E); }
            { unsigned char* ws = PWS(); EVtMla E{ws + WS_VT, 32}; GEMM_CALL_SUB(EVtMla, WL() + W_UKV + (size_t)1024 * 512 * 2, CL() + C_CKV + (size_t)8192 * 512 * 2, 1024, NKEY - 8192, 512, E, 100, bid_, 0, 1 << 30); }
            SEAM(pb + 3); }
        if (EN(4) && IN(pb + 4)) for (int rep = 0; rep < NREP(4); ++rep) { LAUNDER(); postz_phase(F, l); SEAM(pb + 4); }
        if (EN(5) && IN(pb + 5)) for (int rep = 0; rep < NREP(5); ++rep) { LAUNDER();
            { unsigned char* ws = PWS(); const int G_ = (int)gridDim.x; int bid_ = (int)blockIdx.x; asm volatile("" : "+s"(bid_));
              using EMulti = pg8::EpiMulti<pg8::EpiBf16, EKnMla, pg8::EpiVtBlkP<8>, EKnMla>;
              EMulti E{pg8::EpiBf16{(bf16*)(ws + WS_Q), QW, nullptr}, EKnMla{ws + WS_KN, 0}, pg8::EpiVtBlkP<8>{ws + WS_VT, 0}, EKnMla{ws + WS_KN, 32}};
              if (F.tid == 0) { volatile LAS unsigned long long* mp = (volatile LAS unsigned long long*)(F.lds + 140288);
                  mp[0] = (unsigned long long)(ws + WS_CQN); mp[1] = (unsigned long long)(WL() + W_UQ);
                  mp[2] = (unsigned long long)(CL() + C_CKV); mp[3] = (unsigned long long)(WL() + W_UKV);
                  mp[4] = (unsigned long long)(WL() + W_UKV + (size_t)1024 * 512 * 2); mp[5] = (unsigned long long)(CL() + C_CKV);
                  mp[6] = (unsigned long long)(CL() + C_CKV + (size_t)8192 * 512 * 2); mp[7] = (unsigned long long)(WL() + W_UKV); }
              LDS_WAIT(); __syncthreads();
              pg8::Gemm g0{(const bf16*)(ws + WS_CQN), (const bf16*)(WL() + W_UQ), MT, QW, 512};
              pg8::MultiOrder S; S.init(G_, bid_, MT, QW, NKEY - 8192, 512);
              pg8::gemm_phase<EMulti, pg8::MultiOrder, true, true, false, true>(F.lds, g0, S, E); }
            SEAM(pb + 5); }
        if (EN(6) && IN(pb + 6)) for (int rep = 0; rep < NREP(6); ++rep) { LAUNDER(); attention_phase(F, l, rep); SEAM(pb + 6); }
        if (EN(7) && IN(pb + 7)) for (int rep = 0; rep < NREP(7); ++rep) { LAUNDER(); postattn_phase(F, l); SEAM(pb + 7); }
        if (EN(8) && IN(pb + 8)) for (int rep = 0; rep < NREP(8); ++rep) { LAUNDER(); unsigned char* ws = PWS(); pg8::EpiFmix E{(bf16*)(ws + WS_F), (bf16*)(ws + WS_F1), DM, DM / 64}; GEMM_CALL_SK(pg8::EpiFmix, ws + WS_XN, WL() + W_O, MT, DM, DM, E); SEAM(pb + 8); }
        if (EN(9) && IN(pb + 9)) { LAUNDER(); unsigned char* ws = PWS(); bf16* HB = (bf16*)(ws + WS_HB);
            norm_phase<false, false>(F, (const bf16*)(ws + WS_F), (const bf16*)(ws + WS_F1), HB, nullptr, 1.0f, PIN(24) + l * DM, (float*)(ws + WS_RS), HB, ws + WS_HB8); SEAM(pb + 9); }
        if (EN(10) && IN(pb + 10)) for (int rep = 0; rep < NREP(10); ++rep) { LAUNDER(); unsigned char* ws = PWS();
            pg8::EpiSwiGLUi8 E{(bf16*)(ws + WS_HID), DFF, (const float*)(ws + WS_RS), (const float*)(ws + WS_CS) + (size_t)(l * 2 + 1) * 2 * DFF};
            GEMM_CALL_I8(pg8::EpiSwiGLUi8, ws + WS_HB8, WL() + W_GU2, MT, 2 * DFF, DM / 2, E);
            if (l == 0 && DEPTH == 2) { LAUNDER(); __syncthreads(); deferred_layer1(F); }
            SEAM(pb + 10); }
        if (EN(11) && IN(pb + 11)) for (int rep = 0; rep < NREP(11); ++rep) { LAUNDER(); unsigned char* ws = PWS(); pg8::EpiFmix E{(bf16*)(ws + WS_F), (bf16*)(ws + WS_F1), DM, DFF / 64}; GEMM_CALL_SK(pg8::EpiFmix, ws + WS_HID, WL() + W_D2, MT, DM, DFF, E); SEAM(pb + 11); }
        if (EN(12) && IN(pb + 12)) { LAUNDER(); unsigned char* ws = PWS(); bf16* HB = (bf16*)(ws + WS_HB);
            if (l + 1 < DEPTH) norm_phase<false, false>(F, (const bf16*)(ws + WS_F), (const bf16*)(ws + WS_F1), HB, nullptr, 0.5f, PIN(29) + l * DM, (float*)(ws + WS_RS), HB, ws + WS_HB8);
            else norm_phase<false, true>(F, (const bf16*)(ws + WS_F), (const bf16*)(ws + WS_F1), HB, nullptr, 0.5f, PIN(29) + l * DM, nullptr, POUT());
            SEAM(pb + 12); }
    }
#undef IN
#undef SEAM
}

extern "C" void kernel_launch(void* const* d_in, const int* in_sizes, int n_in, void* d_out, int out_size, void* d_ws, size_t ws_size, hipStream_t stream) {
    static int grid = 0;
    if (grid == 0) {
        if (n_in != 30 || out_size != (int)O_END || ws_size < WS_END) { fprintf(stderr, "kernel_launch: unexpected shapes: n_in %d out %d ws %zu (need %zu)\n", n_in, out_size, ws_size, (size_t)WS_END); grid = -1; return; }
        int dev = 0, cus = 0, per_cu = 0;
        if (hipGetDevice(&dev) != hipSuccess || hipDeviceGetAttribute(&cus, hipDeviceAttributeMultiprocessorCount, dev) != hipSuccess) { grid = -1; return; }
        if (hipFuncSetAttribute((const void*)fwd_kernel, hipFuncAttributeMaxDynamicSharedMemorySize, LDS_BYTES) != hipSuccess) { fprintf(stderr, "kernel_launch: hipFuncSetAttribute failed\n"); grid = -1; return; }
        if (hipOccupancyMaxActiveBlocksPerMultiprocessor(&per_cu, (const void*)fwd_kernel, NWAVES * 64, LDS_BYTES) != hipSuccess || per_cu < 1) { fprintf(stderr, "kernel_launch: occupancy query says %d\n", per_cu); (void)hipGetLastError(); grid = -1; return; }
        grid = cus;
    }
    if (grid < 0) return;
    (void)hipMemsetAsync((char*)d_ws + WS_CTL, 0, CTL_ZERO_BYTES, stream);
    Args a{};
    for (int i = 0; i < 30; ++i) a.in[i] = (const float*)d_in[i];
    a.out = (float*)d_out; a.ws = (unsigned char*)d_ws;
#if MK_SPLIT
    for (int p = 0; p < NPH; ++p) { a.ph_lo = p; a.ph_hi = p + 1; hipLaunchKernelGGL(fwd_kernel, dim3(grid), dim3(NWAVES * 64), LDS_BYTES, stream, a); }
#else
    a.ph_lo = 0; a.ph_hi = NPH;
    hipLaunchKernelGGL(fwd_kernel, dim3(grid), dim3(NWAVES * 64), LDS_BYTES, stream, a);
#endif
}
```

```cpp
#include <hip/hip_runtime.h>
#include <cstdio>
#include <cstdint>
#ifndef DUPM
#define DUPM 0u
#endif
namespace pg8 {
#define PG8_LAS __attribute__((address_space(3)))
typedef unsigned short bf16_t;
typedef short bf16x8 __attribute__((ext_vector_type(8)));
typedef float f32x4 __attribute__((ext_vector_type(4)));
typedef unsigned u32x4 __attribute__((ext_vector_type(4)));
constexpr int BM = 256, BK = 64, HALF = 128, HTB = HALF * BK * 2  , STAGE_BYTES = 8 * HTB, NXCD = 8, WGM = 4;

__host__ __device__ __forceinline__ int lds_byte(int r, int c) { const int st = (r >> 4) * 2 + (c >> 5), rr = r & 15, cc = c & 31, ob = rr * 64 + cc * 2; return st * 1024 + (ob ^ (((ob >> 9) & 1) << 5)); }
__host__ __device__ __forceinline__ void stage_rc(int b, int& R, int& C) { const int st = b / 1024, sb = b % 1024, swz = sb ^ (((sb >> 9) & 1) << 5); R = (st >> 1) * 16 + swz / 64; C = (st & 1) * 32 + (swz % 64) / 2; }
__host__ __device__ __forceinline__ int perm32(int rho) { const int n = rho >> 4, i = rho & 15; return 8 * (i >> 2) + 4 * n + (i & 3); }

struct Unit { int pm, pn, k0, nk; };
struct Gemm { const bf16_t* A; const bf16_t* Bt; int M, N, K; };

struct StaticOrder {
    int nM, nN, nwg, G, c, nkt;
    __host__ __device__ void init(int M, int N, int K, int G_, int c_) { nM = M / BM; nN = N / BM; nwg = nM * nN; G = G_; c = c_; nkt = K / BK; }
    __host__ __device__ bool next(int i, Unit& u) const {
        const long L = (long)i * G + c; if (L >= nwg) return false;
        int wgid = (int)L; { const int q = nwg / NXCD, r = nwg % NXCD, xcd = wgid % NXCD, off = wgid / NXCD; wgid = (xcd < r ? xcd * (q + 1) : r * (q + 1) + (xcd - r) * q) + off; }
        const int nig = WGM * nN, gid = wgid / nig, fm = gid * WGM, gsz = (nM - fm) < WGM ? (nM - fm) : WGM;
        u.pm = fm + ((wgid % nig) % gsz); u.pn = (wgid % nig) / gsz; u.k0 = 0; u.nk = nkt; return true;
    }
    __device__ __forceinline__ void a_ready(const Unit&) const {}
    __device__ __forceinline__ void done(const Unit&) const {}
};
struct TailSplitOrder {
    StaticOrder S0; int nkt, c, nN;
    __host__ __device__ static int slice_len(int nkt, int s) { const int q = nkt / 8; return (q & 1) ? (s < 4 ? q + 1 : q - 1) : q; }
    __host__ __device__ static int slice_start(int nkt, int s) { const int q = nkt / 8; return (q & 1) ? (s < 4 ? s * (q + 1) : 4 * (q + 1) + (s - 4) * (q - 1)) : s * q; }
    __host__ __device__ static int slice_of(int nkt, int k0) { const int q = nkt / 8; return (q & 1) ? (k0 < 4 * (q + 1) ? k0 / (q + 1) : 4 + (k0 - 4 * (q + 1)) / (q - 1)) : k0 / q; }
    __host__ __device__ void init(int M, int N, int K, int G_, int c_) { S0.init(M - 4 * BM, N, K, G_, c_); nkt = K / BK; c = c_; nN = N / BM; }
    __host__ __device__ bool next(int i, Unit& u) const {
        if (i == 0) return S0.next(0, u);
        if (i > 1) return false;
        const int r = c >> 3, sl = c & 7; u.pm = S0.nM + r / nN; u.pn = r % nN; u.k0 = slice_start(nkt, sl); u.nk = slice_len(nkt, sl); return true;
    }
    __device__ __forceinline__ void a_ready(const Unit&) const {}
    __device__ __forceinline__ void done(const Unit&) const {}
};
struct SubsetOrder {
    StaticOrder S0; bool on; int i0, i1;
    __host__ __device__ void init(int M, int N, int K, int G_, int c_, int c0, int i0_ = 0, int i1_ = 1 << 30) { on = c_ >= c0; S0.init(M, N, K, G_ - c0, on ? c_ - c0 : 0); i0 = i0_; i1 = i1_; }
    __host__ __device__ bool next(int i, Unit& u) const { return on && (i + i0) < i1 && S0.next(i + i0, u); }
    __device__ __forceinline__ void a_ready(const Unit&) const {}
    __device__ __forceinline__ void done(const Unit&) const {}
};
template <bool ROWS> struct NewKeyOrder {
    StaticOrder S0;
    __host__ __device__ static int panel(int p) { return p < 32 ? p : 40 + (33 * (p - 32)) / 4; }
    __host__ __device__ void init(int M, int N, int K, int G_, int c_) { S0.init(M, N, K, G_, c_); }
    __host__ __device__ bool next(int i, Unit& u) const { if (!S0.next(i, u)) return false; if (ROWS) u.pm = panel(u.pm); else u.pn = panel(u.pn); return true; }
    __device__ __forceinline__ void a_ready(const Unit&) const {}
    __device__ __forceinline__ void done(const Unit&) const {}
};

struct PastPanelOrder {
    SubsetOrder S;
    __host__ __device__ static __forceinline__ int past_panel(int j) { int s = 0;
#pragma unroll
        for (int k = 0; k < 16; ++k) s = (8 + (33 * k) / 4 - k <= j) ? k + 1 : s;
        return j + s; }
    __host__ __device__ __forceinline__ void init(int M, int N, int K, int G_, int c_, int c0) { S.init(M, N, K, G_, c_, c0); }
    __host__ __device__ __forceinline__ bool next(int i, Unit& u) const { if (!S.next(i, u)) return false; u.pn = past_panel(u.pn); return true; }
    __device__ __forceinline__ void a_ready(const Unit&) const {}
    __device__ __forceinline__ void done(const Unit&) const {}
};


__device__ __forceinline__ unsigned cvt_pk_bf16(float lo, float hi) { unsigned r; asm volatile("v_cvt_pk_bf16_f32 %0, %1, %2" : "=v"(r) : "v"(lo), "v"(hi)); return r; }
typedef unsigned u32x2 __attribute__((ext_vector_type(2)));

struct EpiFmix {
    static constexpr bool PERM = true, AFTER_DRAIN = false;
    bf16_t* C; bf16_t* C1; int ldc; int nkt;
    __device__ __forceinline__ void operator()(const f32x4 (&acc)[2][2][4][2], const Unit& u, int wr, int wc, int fr, int fq) const {
        const int row0 = u.pm * BM + wr * 64 + fr, col0 = u.pn * BM + wc * 32 + 8 * fq;
        bf16_t* Cb = u.k0 == 0 ? C : C1 + (size_t)(TailSplitOrder::slice_of(nkt, u.k0) - 1) * 1024 * ldc - (size_t)8192 * ldc;
#pragma unroll
        for (int ai = 0; ai < 2; ++ai)
#pragma unroll
            for (int m = 0; m < 4; ++m) { bf16_t* rowp = Cb + (size_t)(row0 + ai * HALF + m * 16) * ldc + col0;
#pragma unroll
                for (int bj = 0; bj < 2; ++bj) { const f32x4 v0 = acc[ai][bj][m][0], v1 = acc[ai][bj][m][1];
                    u32x4 w; w.x = cvt_pk_bf16(v0[0], v0[1]); w.y = cvt_pk_bf16(v0[2], v0[3]); w.z = cvt_pk_bf16(v1[0], v1[1]); w.w = cvt_pk_bf16(v1[2], v1[3]);
                    *(u32x4*)(rowp + bj * HALF) = w; } }
    }
};
struct EpiBf16 {
    static constexpr bool PERM = true, AFTER_DRAIN = false;
    bf16_t* O; int ldc; const float* rs;
    __device__ __forceinline__ void operator()(const f32x4 (&acc)[2][2][4][2], const Unit& u, int wr, int wc, int fr, int fq) const {
        const int row0 = u.pm * BM + wr * 64 + fr, col0 = u.pn * BM + wc * 32 + 8 * fq;
        float rv[2][4];
#pragma unroll
        for (int ai = 0; ai < 2; ++ai)
#pragma unroll
            for (int m = 0; m < 4; ++m) rv[ai][m] = rs ? rs[row0 + ai * HALF + m * 16] : 1.0f;
#pragma unroll
        for (int ai = 0; ai < 2; ++ai)
#pragma unroll
            for (int m = 0; m < 4; ++m) { const int row = row0 + ai * HALF + m * 16; bf16_t* rowp = O + (size_t)row * ldc + col0; const float r = rv[ai][m];
#pragma unroll
                for (int bj = 0; bj < 2; ++bj) { const f32x4 v0 = acc[ai][bj][m][0] * r, v1 = acc[ai][bj][m][1] * r;
                    u32x4 w; w.x = cvt_pk_bf16(v0[0], v0[1]); w.y = cvt_pk_bf16(v0[2], v0[3]); w.z = cvt_pk_bf16(v1[0], v1[1]); w.w = cvt_pk_bf16(v1[2], v1[3]);
                    *(u32x4*)(rowp + bj * HALF) = w; } }
    }
};
struct EpiSwiGLU {
    static constexpr bool PERM = true, AFTER_DRAIN = false;
    bf16_t* O; int ldc; const float* rs;
    __device__ __forceinline__ static float silu_mul(float g, float u) { const float e = __builtin_amdgcn_exp2f(-g * 1.4426950408889634f); return g * u * __builtin_amdgcn_rcpf(1.0f + e); }
    __device__ __forceinline__ void operator()(const f32x4 (&acc)[2][2][4][2], const Unit& u, int wr, int wc, int fr, int fq) const {
        const int row0 = u.pm * BM + wr * 64 + fr, col0 = u.pn * HALF + wc * 32 + 8 * fq;
#pragma unroll
        for (int ai = 0; ai < 2; ++ai)
#pragma unroll
            for (int m = 0; m < 4; ++m) { const int row = row0 + ai * HALF + m * 16; bf16_t* rowp = O + (size_t)row * ldc + col0; const float r = rs[row];
                const f32x4 g0 = acc[ai][0][m][0] * r, g1 = acc[ai][0][m][1] * r, u0 = acc[ai][1][m][0] * r, u1 = acc[ai][1][m][1] * r;
                u32x4 w; w.x = cvt_pk_bf16(silu_mul(g0[0], u0[0]), silu_mul(g0[1], u0[1])); w.y = cvt_pk_bf16(silu_mul(g0[2], u0[2]), silu_mul(g0[3], u0[3]));
                w.z = cvt_pk_bf16(silu_mul(g1[0], u1[0]), silu_mul(g1[1], u1[1])); w.w = cvt_pk_bf16(silu_mul(g1[2], u1[2]), silu_mul(g1[3], u1[3]));
                *(u32x4*)rowp = w; }
    }
};
struct EpiSwiGLUi8 {
    static constexpr bool PERM = true, AFTER_DRAIN = false;
    bf16_t* O; int ldc; const float* rs; const float* cs;
    __device__ __forceinline__ void operator()(const f32x4 (&acc)[2][2][4][2], const Unit& u, int wr, int wc, int fr, int fq) const {
        typedef int i32x4e __attribute__((ext_vector_type(4)));
        const int row0 = u.pm * BM + wr * 64 + fr, col0 = u.pn * HALF + wc * 32 + 8 * fq; const float* cg = cs + u.pn * BM + wc * 32 + 8 * fq;
        const f32x4 cg0 = *(const f32x4*)cg * (1.0f / 127.0f), cg1 = *(const f32x4*)(cg + 4) * (1.0f / 127.0f), cu0 = *(const f32x4*)(cg + HALF) * (1.0f / 127.0f), cu1 = *(const f32x4*)(cg + HALF + 4) * (1.0f / 127.0f);
        float rv[2][4];
#pragma unroll
        for (int ai = 0; ai < 2; ++ai)
#pragma unroll
            for (int m = 0; m < 4; ++m) rv[ai][m] = rs[row0 + ai * HALF + m * 16];
#pragma unroll
        for (int ai = 0; ai < 2; ++ai)
#pragma unroll
            for (int m = 0; m < 4; ++m) { const int row = row0 + ai * HALF + m * 16; bf16_t* rowp = O + (size_t)row * ldc + col0; const float r = rv[ai][m];
                const f32x4 g0 = __builtin_convertvector(__builtin_bit_cast(i32x4e, acc[ai][0][m][0]), f32x4) * cg0 * r, g1 = __builtin_convertvector(__builtin_bit_cast(i32x4e, acc[ai][0][m][1]), f32x4) * cg1 * r;
                const f32x4 u0 = __builtin_convertvector(__builtin_bit_cast(i32x4e, acc[ai][1][m][0]), f32x4) * cu0 * r, u1 = __builtin_convertvector(__builtin_bit_cast(i32x4e, acc[ai][1][m][1]), f32x4) * cu1 * r;
                u32x4 w; w.x = cvt_pk_bf16(EpiSwiGLU::silu_mul(g0[0], u0[0]), EpiSwiGLU::silu_mul(g0[1], u0[1])); w.y = cvt_pk_bf16(EpiSwiGLU::silu_mul(g0[2], u0[2]), EpiSwiGLU::silu_mul(g0[3], u0[3]));
                w.z = cvt_pk_bf16(EpiSwiGLU::silu_mul(g1[0], u1[0]), EpiSwiGLU::silu_mul(g1[1], u1[1])); w.w = cvt_pk_bf16(EpiSwiGLU::silu_mul(g1[2], u1[2]), EpiSwiGLU::silu_mul(g1[3], u1[3]));
                *(u32x4*)rowp = w; }
    }
};
template <int NH> struct EpiKBlk {
    static constexpr bool PERM = true, AFTER_DRAIN = false;
    unsigned char* O; int pm0;
    __device__ __forceinline__ void operator()(const f32x4 (&acc)[2][2][4][2], const Unit& u, int wr, int wc, int fr, int fq) const {
        unsigned char* base = O + ((size_t)((4 * (u.pm + pm0) + wr) * NH + 2 * u.pn)) * 16384 + (4 * wc + fq) * 1024 + fr * 16;
#pragma unroll
        for (int ai = 0; ai < 2; ++ai)
#pragma unroll
            for (int m = 0; m < 4; ++m)
#pragma unroll
                for (int bj = 0; bj < 2; ++bj) { const f32x4 v0 = acc[ai][bj][m][0], v1 = acc[ai][bj][m][1];
                    u32x4 w; w.x = cvt_pk_bf16(v0[0], v0[1]); w.y = cvt_pk_bf16(v0[2], v0[3]); w.z = cvt_pk_bf16(v1[0], v1[1]); w.w = cvt_pk_bf16(v1[2], v1[3]);
                    *(u32x4*)(base + ai * (2 * NH * 16384) + bj * 16384 + m * 256) = w; }
    }
};
template <bool TOK, int NH> struct EpiVtBlk {
    static constexpr bool PERM = false, AFTER_DRAIN = false;
    unsigned char* O; int pn0;
    __device__ __forceinline__ void operator()(const f32x4 (&acc)[2][2][4][2], const Unit& u, int wr, int wc, int fr, int fq) const {
        const bool smp = TOK && u.pn >= 32;
        const int tile0 = smp ? 160 + 33 * (4 * (u.pn - 32) + (wc >> 1)) : 4 * (u.pn + pn0) + (wc >> 1);
        const unsigned bjs = smp ? 66u * NH * 16384u : 2u * NH * 16384u;
        unsigned char* base = O + ((size_t)(tile0 * NH + 2 * u.pm)) * 16384 + (4 * (wc & 1) + (fq & 1)) * 2048 + (wr * 64 + fr) * 16 + 8 * (fq >> 1);
#pragma unroll
        for (int bj = 0; bj < 2; ++bj) { unsigned char* bb = base + (size_t)bj * bjs;
#pragma unroll
            for (int ai = 0; ai < 2; ++ai)
#pragma unroll
                for (int m = 0; m < 4; ++m)
#pragma unroll
                    for (int n = 0; n < 2; ++n) { const f32x4 v = acc[ai][bj][m][n];
                        u32x2 w; w.x = cvt_pk_bf16(v[0], v[1]); w.y = cvt_pk_bf16(v[2], v[3]);
                        *(u32x2*)(bb + ai * 16384 + m * 256 + n * 4096) = w; } }
    }
};

template <class Epi, class Sched, bool ALIGN_EPI = false, bool SP2 = false, bool I8 = false>
__device__ __forceinline__ void gemm_phase(PG8_LAS unsigned char* lds, const Gemm g, const Sched& S, const Epi& E) {
    int tid_ = threadIdx.x; asm volatile("" : "+v"(tid_));
    const int tid = tid_, wid = __builtin_amdgcn_readfirstlane(tid >> 6), lane = tid & 63, wr = wid >> 2, wc = wid & 3, fr = lane & 15, fq = lane >> 4;
    const int K = g.K;
    unsigned voffA[2], voffB[2];
#pragma unroll
    for (int i = 0; i < 2; ++i) { int R, C; stage_rc(tid * 16 + i * 8192, R, C); const int Rb = Epi::PERM ? ((R & ~31) + perm32(R & 31)) : R;
        voffA[i] = (unsigned)(R * K + C) * 2u; voffB[i] = (unsigned)(Rb * K + C) * 2u; }
    const size_t kstep = (size_t)(BK * 2);
    const size_t hstep = (size_t)HALF * K * 2;
    const size_t tstep = 2 * hstep;
    const unsigned ldsw = (unsigned)wid * 1024u;
    const int aoff = lds_byte(wr * 64 + fr, fq * 8), boff = lds_byte(wc * 32 + fr, fq * 8);
#define PG8_SA(b, h) (((b) * 2 + (h)) * HTB)
#define PG8_SB(b, h) ((4 + (b) * 2 + (h)) * HTB)
#define PG8_STAGE(bufoff, gbase, voff) do { _Pragma("unroll") for (int _i = 0; _i < 2; ++_i) \
        __builtin_amdgcn_global_load_lds((const unsigned*)((const char*)(gbase) + (voff)[_i]), (PG8_LAS unsigned*)(lds + (bufoff) + ldsw + _i * 8192), 16, 0, 0); } while (0)
#define PG8_LDA(dst, b, h) do { _Pragma("unroll") for (int m = 0; m < 4; ++m) _Pragma("unroll") for (int k = 0; k < 2; ++k) dst[m][k] = *(const PG8_LAS bf16x8*)(lds + PG8_SA(b, h) + aoff + m * 2048 + k * 1024); } while (0)
#define PG8_LDB(dst, b, h) do { _Pragma("unroll") for (int n = 0; n < 2; ++n) _Pragma("unroll") for (int k = 0; k < 2; ++k) dst[n][k] = *(const PG8_LAS bf16x8*)(lds + PG8_SB(b, h) + boff + n * 2048 + k * 1024); } while (0)
#define PG8_MMA(ai, bj, At, Bt) do { __builtin_amdgcn_s_setprio(1); _Pragma("unroll") for (int m = 0; m < 4; ++m) _Pragma("unroll") for (int n = 0; n < 2; ++n) _Pragma("unroll") for (int k = 0; k < 2; ++k) { \
        if constexpr (I8) acc[ai][bj][m][n] = __builtin_bit_cast(f32x4, __builtin_amdgcn_mfma_i32_16x16x64_i8(__builtin_bit_cast(i32x4_, Bt[n][k]), __builtin_bit_cast(i32x4_, At[m][k]), __builtin_bit_cast(i32x4_, acc[ai][bj][m][n]), 0, 0, 0)); \
        else acc[ai][bj][m][n] = __builtin_amdgcn_mfma_f32_16x16x32_bf16(Bt[n][k], At[m][k], acc[ai][bj][m][n], 0, 0, 0); } \
        __builtin_amdgcn_s_setprio(0); } while (0)
#define PG8_WAIT_V(n) asm volatile("s_waitcnt vmcnt(" #n ")" ::: "memory")
#define PG8_WAIT_L(n) asm volatile("s_waitcnt lgkmcnt(" #n ")" ::: "memory")
#define PG8_BAR __builtin_amdgcn_s_barrier()
#define PG8_SCHED __builtin_amdgcn_sched_barrier(0)
    Unit cur, nxt; int ui = 0;
    if (!S.next(0, cur)) return;
    f32x4 acc[2][2][4][2];
#pragma unroll
    for (int a = 0; a < 2; ++a)
#pragma unroll
        for (int b = 0; b < 2; ++b)
#pragma unroll
            for (int m = 0; m < 4; ++m)
#pragma unroll
                for (int n = 0; n < 2; ++n) acc[a][b][m][n] = (f32x4){0.f, 0.f, 0.f, 0.f};
    typedef int i32x4_ __attribute__((ext_vector_type(4)));
    bf16x8 At[4][2], B0[2][2], B1[2][2];
    const char* cA = (const char*)g.A + (size_t)cur.pm * tstep + (size_t)cur.k0 * kstep; const char* cB = (const char*)g.Bt + (size_t)cur.pn * tstep + (size_t)cur.k0 * kstep;
    S.a_ready(cur);
    if constexpr (SP2) {
        PG8_STAGE(PG8_SB(0, 0), cB, voffB); PG8_STAGE(PG8_SB(0, 1), cB + hstep, voffB); PG8_STAGE(PG8_SA(0, 0), cA, voffA); PG8_STAGE(PG8_SA(0, 1), cA + hstep, voffA);
        if (wr == 1) PG8_BAR;
        PG8_WAIT_V(2); PG8_BAR;
        PG8_STAGE(PG8_SB(1, 0), cB + kstep, voffB); PG8_STAGE(PG8_SA(1, 0), cA + kstep, voffA); PG8_STAGE(PG8_SB(1, 1), cB + hstep + kstep, voffB);
        PG8_WAIT_V(6); PG8_BAR;
    } else {
        PG8_STAGE(PG8_SB(0, 0), cB, voffB); PG8_STAGE(PG8_SA(0, 0), cA, voffA); PG8_STAGE(PG8_SB(0, 1), cB + hstep, voffB); PG8_STAGE(PG8_SA(0, 1), cA + hstep, voffA);
        if (wr == 1) PG8_BAR;
        PG8_WAIT_V(4); PG8_BAR;
        PG8_STAGE(PG8_SB(1, 0), cB + kstep, voffB); PG8_STAGE(PG8_SA(1, 0), cA + kstep, voffA); PG8_STAGE(PG8_SB(1, 1), cB + hstep + kstep, voffB);
        PG8_WAIT_V(6); PG8_BAR;
    }
    for (;;) {
        const bool has_next = S.next(ui + 1, nxt);
        const char* nA = has_next ? (const char*)g.A + (size_t)nxt.pm * tstep + (size_t)nxt.k0 * kstep : cA; const char* nB = has_next ? (const char*)g.Bt + (size_t)nxt.pn * tstep + (size_t)nxt.k0 * kstep : cB;
        const int nt = cur.nk;
        for (int t = 0; t < nt; t += 2) {
            const bool last = (t == nt - 2);
            const char* a1 = cA + (size_t)(t + 1) * kstep;
            const char* a2 = last ? nA : cA + (size_t)(t + 2) * kstep; const char* b2 = last ? nB : cB + (size_t)(t + 2) * kstep;
            const char* a3 = a2 + kstep; const char* b3 = b2 + kstep;
            if (last && has_next) S.a_ready(nxt);
            if constexpr (SP2) {
            PG8_LDB(B0, 0, 0); PG8_LDB(B1, 0, 1); PG8_SCHED; PG8_LDA(At, 0, 0); PG8_STAGE(PG8_SA(1, 1), a1 + hstep, voffA);
            PG8_WAIT_V(8); PG8_WAIT_L(0); PG8_BAR; PG8_MMA(0, 0, At, B0); PG8_MMA(0, 1, At, B1); PG8_BAR; PG8_SCHED;
            PG8_LDA(At, 0, 1); PG8_STAGE(PG8_SB(0, 0), b2, voffB); PG8_STAGE(PG8_SB(0, 1), b2 + hstep, voffB); PG8_STAGE(PG8_SA(0, 0), a2, voffA);
            PG8_WAIT_V(8); PG8_WAIT_L(0); PG8_BAR; PG8_MMA(1, 0, At, B0); PG8_MMA(1, 1, At, B1); PG8_BAR; PG8_SCHED;
            PG8_LDB(B0, 1, 0); PG8_LDB(B1, 1, 1); PG8_SCHED; PG8_LDA(At, 1, 0); PG8_STAGE(PG8_SA(0, 1), a2 + hstep, voffA);
            PG8_WAIT_V(8); PG8_WAIT_L(0); PG8_BAR; PG8_MMA(0, 0, At, B0); PG8_MMA(0, 1, At, B1); PG8_BAR; PG8_SCHED;
            PG8_LDA(At, 1, 1); PG8_STAGE(PG8_SB(1, 0), b3, voffB); PG8_STAGE(PG8_SB(1, 1), b3 + hstep, voffB); PG8_STAGE(PG8_SA(1, 0), a3, voffA);
            PG8_WAIT_V(8); PG8_WAIT_L(0); PG8_BAR; PG8_MMA(1, 0, At, B0); PG8_MMA(1, 1, At, B1); PG8_BAR; PG8_SCHED;
            } else {
            PG8_LDB(B0, 0, 0); PG8_SCHED; PG8_LDA(At, 0, 0); PG8_STAGE(PG8_SA(1, 1), a1 + hstep, voffA);
            PG8_WAIT_L(8); PG8_BAR; PG8_WAIT_L(0); PG8_MMA(0, 0, At, B0); PG8_BAR; PG8_SCHED;
            PG8_LDB(B1, 0, 1); PG8_STAGE(PG8_SB(0, 0), b2, voffB);
            PG8_BAR; PG8_WAIT_L(0); PG8_MMA(0, 1, At, B1); PG8_BAR;
            PG8_LDA(At, 0, 1); PG8_STAGE(PG8_SA(0, 0), a2, voffA);
            PG8_BAR; PG8_WAIT_L(0); PG8_MMA(1, 0, At, B0); PG8_BAR; PG8_SCHED;
            PG8_STAGE(PG8_SB(0, 1), b2 + hstep, voffB);
            PG8_WAIT_V(6); PG8_BAR; PG8_MMA(1, 1, At, B1); PG8_BAR;
            PG8_LDB(B0, 1, 0); PG8_SCHED; PG8_LDA(At, 1, 0); PG8_STAGE(PG8_SA(0, 1), a2 + hstep, voffA);
            PG8_WAIT_L(8); PG8_BAR; PG8_WAIT_L(0); PG8_MMA(0, 0, At, B0); PG8_BAR; PG8_SCHED;
            PG8_LDB(B1, 1, 1); PG8_STAGE(PG8_SB(1, 0), b3, voffB);
            PG8_BAR; PG8_WAIT_L(0); PG8_MMA(0, 1, At, B1); PG8_BAR;
            PG8_LDA(At, 1, 1); PG8_STAGE(PG8_SA(1, 0), a3, voffA);
            PG8_BAR; PG8_WAIT_L(0); PG8_MMA(1, 0, At, B0); PG8_BAR; PG8_SCHED;
            PG8_STAGE(PG8_SB(1, 1), b3 + hstep, voffB);
            PG8_WAIT_V(6); PG8_BAR; PG8_MMA(1, 1, At, B1); PG8_BAR;
            }
        }
        if constexpr (ALIGN_EPI) { if (wr == 0) PG8_BAR; }
        if constexpr (!Epi::AFTER_DRAIN) { int te_ = threadIdx.x; asm volatile("" : "+v"(te_));
            const int we_ = __builtin_amdgcn_readfirstlane(te_ >> 6), le_ = te_ & 63; E(acc, cur, we_ >> 2, we_ & 3, le_ & 15, le_ >> 4); S.done(cur); }
        if (!has_next) break;
#pragma unroll
        for (int a = 0; a < 2; ++a)
#pragma unroll
            for (int b = 0; b < 2; ++b)
#pragma unroll
                for (int m = 0; m < 4; ++m)
#pragma unroll
                    for (int n = 0; n < 2; ++n) acc[a][b][m][n] = (f32x4){0.f, 0.f, 0.f, 0.f};
        cur = nxt; cA = nA; cB = nB; ++ui;
        if constexpr (ALIGN_EPI) { if (wr == 1) PG8_BAR; }
    }
    PG8_WAIT_V(0);
    if constexpr (!ALIGN_EPI) { if (wr == 0) PG8_BAR; }
    PG8_BAR;
    if constexpr (Epi::AFTER_DRAIN) { E.fused(acc, cur, wr, wc, fr, fq, lds, wid, lane); S.done(cur); }
#undef PG8_SA
#undef PG8_SB
#undef PG8_STAGE
#undef PG8_LDA
#undef PG8_LDB
#undef PG8_MMA
#undef PG8_WAIT_V
#undef PG8_WAIT_L
#undef PG8_BAR
#undef PG8_SCHED
}
}

constexpr int NWAVES = 8;
constexpr int DM = 2048, TP = 8192, TS = 1024, MT = TP + TS, DFF = 5632, DEPTH = 2;
constexpr int DIN = 4160, DINP = 4352;
constexpr int ZC_CQ = 0, ZC_CKV = 512, ZC_KR = 1024, ZC_GB = 1088, ZC_GC = 1600, ZC_XC = 2112, ZC_QSB = 2624, ZC_KSB = 3136, ZC_VSB = 3648;
constexpr int NKEY = 41984, NTILE = 656;
constexpr int QW = 1536;
constexpr int YW = 1536;
constexpr float EPS = 1e-6f;
constexpr float LOG2E = 1.4426950408889634f, LN2 = 0.6931471805599453f;
constexpr float MLA_QSCALE = 0.07216878364870322f * LOG2E;
constexpr float SB_QSCALE = 0.08838834764831845f;
constexpr float SB_EXIT = -104.0f;

constexpr size_t O_Y = 0;
constexpr size_t O_CKV_P = 18874368, O_KR_P = 27262976, O_SBK_P = 28311552, O_SBV_P = 36700160, O_CONV_P = 45088768;
constexpr size_t O_CKV_S = 45092864, O_KR_S = 46141440, O_SBK_S = 46272512, O_SBV_S = 47321088, O_CONV_S = 48369664, O_END = 48402432;

constexpr size_t WS_CTL = 0, CTL_ZERO_BYTES = 128u << 10;
constexpr size_t WS_RS = 512u << 10;
constexpr size_t WS_CS = 600u << 10;
constexpr size_t WS_ROPE = 1u << 20;
constexpr size_t WS_W = 2u << 20;
constexpr size_t W_GU1 = 0, SZ_GU = (size_t)2 * DFF * DM * 2, W_D1 = W_GU1 + SZ_GU, SZ_D = (size_t)DM * DFF * 2, W_GU2 = W_D1 + SZ_D, W_D2 = W_GU2 + SZ_GU;
constexpr size_t W_IN = W_D2 + SZ_D, SZ_IN = (size_t)DINP * DM * 2, W_UQ = W_IN + SZ_IN, SZ_UQ = (size_t)1536 * 512 * 2, W_UKV = W_UQ + SZ_UQ, SZ_UKV = (size_t)2048 * 512 * 2;
constexpr size_t W_O = W_UKV + SZ_UKV, SZ_O = (size_t)DM * DM * 2, W_LAYER = W_O + SZ_O;
constexpr size_t WS_C = WS_W + DEPTH * W_LAYER;
constexpr size_t C_CKV = 0, SZ_CKV = (size_t)NKEY * 512 * 2, C_KR = C_CKV + SZ_CKV, SZ_KR = (size_t)NTILE * 8192, C_KSB = C_KR + SZ_KR, SZ_KSB = (size_t)NTILE * 4 * 16384;
constexpr size_t C_VTSB = C_KSB + SZ_KSB, C_LAYER = C_VTSB + SZ_KSB;
constexpr size_t WS_XN = WS_C + DEPTH * C_LAYER, SZ_XN = (size_t)MT * DM * 2;
constexpr size_t WS_F = WS_XN + SZ_XN, SZ_F = (size_t)MT * DM * 4;
constexpr size_t WS_HB = WS_F + SZ_F / 2;
constexpr size_t WS_MIX = WS_F + SZ_F;
constexpr size_t WS_HID = WS_MIX, SZ_HID = (size_t)MT * DFF * 2;
constexpr size_t WS_F1_OLD = WS_HID + SZ_HID;
constexpr size_t WS_Z = WS_MIX, SZ_Z = (size_t)MT * DINP * 2, WS_CQN = WS_Z + SZ_Z, SZ_CQN = (size_t)MT * 512 * 2, WS_Q = WS_CQN + SZ_CQN, SZ_Q = (size_t)MT * QW * 2;
constexpr size_t WS_KN = WS_Q + SZ_Q, SZ_KN = (size_t)NTILE * 8 * 16384, WS_VT = WS_KN + SZ_KN, WS_YATT = WS_VT + SZ_KN, SZ_YATT = (size_t)MT * YW * 2;
constexpr size_t WS_F1 = WS_YATT + SZ_YATT, SZ_F1 = (size_t)7 * 1024 * DM * 4;
constexpr size_t WS_PO = WS_F1 + SZ_F1, SZ_PO = (size_t)384 * 64 * 128 * 4, WS_PML = WS_PO + SZ_PO, SZ_PML = (size_t)384 * 64 * 2 * 4;
constexpr size_t WS_HB8 = WS_XN;
constexpr size_t WS_PO16 = WS_PML + SZ_PML, SZ_PO16 = (size_t)128 * 256 * 128 * 2, WS_PML16 = WS_PO16 + SZ_PO16, SZ_PML16 = (size_t)128 * 256 * 2 * 4;
constexpr size_t WS_END = WS_PML16 + SZ_PML16;
static_assert(WS_HID + SZ_HID <= WS_KN, "hidden overlay must stay below KN / VT (the past keys are expanded during FFN1)");
static_assert(WS_END <= 1160000000ull, "workspace");
constexpr int CW_TMO = 0, CW_CODE = 1;
constexpr int CW_BAR = 4096;
constexpr int CW_QUEUE = 16384;

constexpr int RING_BYTES = 131072;
constexpr int LDS_BYTES = 147456;
constexpr int MISC_OFF = LDS_BYTES - 256;

#define GAS __attribute__((address_space(1)))
#define LAS __attribute__((address_space(3)))
typedef unsigned short bf16;
typedef unsigned v4u __attribute__((ext_vector_type(4)));
typedef float f32x4 __attribute__((ext_vector_type(4)));
typedef short bf16x8 __attribute__((ext_vector_type(8)));
typedef GAS unsigned gu32;
typedef GAS unsigned long long gu64;
#define RLX_AGENT __ATOMIC_RELAXED, __HIP_MEMORY_SCOPE_AGENT
#define LDS_WAIT() asm volatile("s_waitcnt lgkmcnt(0)" ::: "memory")
#define VM_WAIT() asm volatile("s_waitcnt vmcnt(0)" ::: "memory")
__device__ __forceinline__ unsigned long long rt() { return __builtin_amdgcn_s_memrealtime(); }
__device__ __forceinline__ unsigned f2bf(float f) { unsigned u = __builtin_bit_cast(unsigned, f); return (u + 0x7fffu + ((u >> 16) & 1u)) >> 16; }
__device__ __forceinline__ unsigned pk2(float lo, float hi) { return f2bf(lo) | (f2bf(hi) << 16); }

#define XB_TMO      128
#define XB_XCNT(j)  (256  + 64 * (j))
#define XB_XSUB(j)  (1280 + 64 * (j))
#define XB_XGEN(j)  (2304 + 64 * (j))
#define XB_TOP      3328
#define XB_TOPGEN   3392
#define XCD_BAR_WORDS 3456
#define XB_SPIN_CAP (1u << 18)

__device__ __forceinline__ unsigned xb_ld(unsigned* p)              { return __hip_atomic_load(p, __ATOMIC_RELAXED, __HIP_MEMORY_SCOPE_AGENT); }
__device__ __forceinline__ unsigned xb_add(unsigned* p, unsigned v) { return __hip_atomic_fetch_add(p, v, __ATOMIC_RELAXED, __HIP_MEMORY_SCOPE_AGENT); }
__device__ __forceinline__ unsigned xb_xcc_id() { return (unsigned)__builtin_amdgcn_s_getreg((3 << 11) | 20) & 0xFu; }
#define XB_SPIN(cond, bar) do { unsigned _sp = 0; while (cond) { __builtin_amdgcn_s_sleep(1); \
    if ((++_sp & 255u) == 0u) { if (xb_ld(&(bar)[XB_TMO])) break; if (_sp > XB_SPIN_CAP) { atomicAdd(&(bar)[XB_TMO], 1u); break; } } } } while (0)

struct XcdBarrier {
    unsigned* bar; unsigned x;
    volatile LAS unsigned* st;
};

__device__ __forceinline__ XcdBarrier xcd_barrier_post(unsigned* bar, volatile LAS unsigned* st) {
    XcdBarrier b; b.bar = bar; b.x = xb_xcc_id(); b.st = st;
    if (threadIdx.x == 0) (void)xb_add(&bar[XB_XCNT(b.x)], 1u);
    return b;
}
__device__ __forceinline__ void xcd_barrier_complete(unsigned* bar, unsigned x, unsigned& nloc, unsigned& nx) {
    const unsigned G = gridDim.x * gridDim.y * gridDim.z;
    unsigned sum, cnt, mine, sp = 0u;
    for (;;) {
        sum = 0u; cnt = 0u; mine = 0u;
#pragma unroll 1
        for (unsigned j = 0; j < 16; ++j) { const unsigned c = xb_ld(&bar[XB_XCNT(j)]); sum += c; cnt += (c > 0u) ? 1u : 0u; mine = (j == x) ? c : mine; }
        if (sum == G) break;
        __builtin_amdgcn_s_sleep(1);
        if ((++sp & 255u) == 0u) { if (xb_ld(&bar[XB_TMO])) break; if (sp > XB_SPIN_CAP) { atomicAdd(&bar[XB_TMO], 1u); break; } }
    }
    nloc = mine > 0u ? mine : 1u; nx = cnt > 0u ? cnt : 1u;
}

__device__ __forceinline__ void xcd_barrier(const XcdBarrier& b) {
    asm volatile("s_waitcnt vmcnt(0)" ::: "memory");
    __syncthreads();
    if (threadIdx.x == 0) {
        unsigned* bar = b.bar;
        __builtin_amdgcn_s_waitcnt(0);
        unsigned nloc = b.st[0], nx = b.st[1];
        if (nloc == 0u) { xcd_barrier_complete(bar, b.x, nloc, nx); b.st[0] = nloc; b.st[1] = nx; }
        const unsigned old = xb_add(&bar[XB_XSUB(b.x)], 1u);
        const unsigned gen = old / nloc;
        if (old + 1u == (gen + 1u) * nloc) {
            __builtin_amdgcn_fence(__ATOMIC_RELEASE, "agent");
            asm volatile("s_waitcnt vmcnt(0)" ::: "memory");
            const unsigned og = xb_add(&bar[XB_TOP], 1u);
            const unsigned tg = og / nx;
            if (og + 1u == (tg + 1u) * nx) xb_add(&bar[XB_TOPGEN], 1u);
            else XB_SPIN(xb_ld(&bar[XB_TOPGEN]) == tg, bar);
            __builtin_amdgcn_fence(__ATOMIC_ACQUIRE, "agent");
            xb_add(&bar[XB_XGEN(b.x)], 1u);
            asm volatile("s_waitcnt vmcnt(0)" ::: "memory");
        } else {
            XB_SPIN(xb_ld(&bar[XB_XGEN(b.x)]) == gen, bar);
            __builtin_amdgcn_fence(__ATOMIC_ACQUIRE, "agent");
            asm volatile("s_waitcnt vmcnt(0)" ::: "memory");
        }
    }
    __syncthreads();
}

typedef unsigned u32x2v __attribute__((ext_vector_type(2)));
typedef float f32x16 __attribute__((ext_vector_type(16)));
struct Args { const float* in[30]; float* out; unsigned char* ws; int ph_lo, ph_hi; };
struct Frame {
    LAS unsigned char* lds;
    volatile LAS unsigned* MISC;
    gu32* ctl;
    int tid, lane, wave;
    int gw, ngw;
};
constexpr int PARAM_OFF = MISC_OFF - 512;
__device__ __forceinline__ unsigned long long ldparam(LAS unsigned char* lds, int k) {
    volatile LAS unsigned* p = (volatile LAS unsigned*)(lds + PARAM_OFF) + 2 * k;
    const unsigned lo = __builtin_amdgcn_readfirstlane(p[0]), hi = __builtin_amdgcn_readfirstlane(p[1]);
    return ((unsigned long long)hi << 32) | lo;
}
#define PIN(k) ((const float*)(const GAS float*)ldparam(F.lds, (k)))
#define POUT() ((float*)(GAS float*)ldparam(F.lds, 30))
#define PWS() ((unsigned char*)(GAS unsigned char*)ldparam(F.lds, 31))
__device__ __forceinline__ float wave_sum(float v) {
#pragma unroll
    for (int o = 1; o < 64; o <<= 1) v += __shfl_xor(v, o);
    return v;
}
__device__ __forceinline__ unsigned pkbf(float lo, float hi) { return pg8::cvt_pk_bf16(lo, hi); }
__device__ __forceinline__ float bflo(unsigned w) { return __uint_as_float(w << 16); }
__device__ __forceinline__ float bfhi(unsigned w) { return __uint_as_float(w & 0xffff0000u); }
__device__ __forceinline__ void unpack8(const v4u w, float (&f)[8]) { f[0] = bflo(w.x); f[1] = bfhi(w.x); f[2] = bflo(w.y); f[3] = bfhi(w.y); f[4] = bflo(w.z); f[5] = bfhi(w.z); f[6] = bflo(w.w); f[7] = bfhi(w.w); }
__device__ __forceinline__ v4u pack8(const float (&f)[8]) { v4u w; w.x = pkbf(f[0], f[1]); w.y = pkbf(f[2], f[3]); w.z = pkbf(f[4], f[5]); w.w = pkbf(f[6], f[7]); return w; }
__device__ __forceinline__ void ld8f(const float* p, float (&f)[8]) { const f32x4 a = *(const f32x4*)p, b = *(const f32x4*)(p + 4); f[0] = a.x; f[1] = a.y; f[2] = a.z; f[3] = a.w; f[4] = b.x; f[5] = b.y; f[6] = b.z; f[7] = b.w; }
__device__ __forceinline__ void st8f(float* p, const float (&f)[8]) { *(f32x4*)p = (f32x4){f[0], f[1], f[2], f[3]}; *(f32x4*)(p + 4) = (f32x4){f[4], f[5], f[6], f[7]}; }

__device__ __forceinline__ void transpose_item(const float* W, int K, int N, bf16* WT, int k0, int n0, int drow, float scale0, const float* gk, LAS float* scr, int lane) {
    const int kr = lane >> 4, nc = (lane & 15) * 4;
    f32x4 tv[16]; float tg[16];
#pragma unroll
    for (int i = 0; i < 16; ++i) { const int kk = 4 * i + kr; tv[i] = *(const f32x4*)(W + (size_t)(k0 + kk) * N + n0 + nc); tg[i] = gk ? scale0 * gk[k0 + kk] : scale0; }
#pragma unroll
    for (int i = 0; i < 16; ++i) { const int kk = 4 * i + kr; const f32x4 v = tv[i]; const float scale = tg[i];
        LAS float* s = scr + kk * 65 + nc; s[0] = v.x * scale; s[1] = v.y * scale; s[2] = v.z * scale; s[3] = v.w * scale; }
    LDS_WAIT(); asm volatile("" ::: "memory");
    const int c = lane & 7;
#pragma unroll
    for (int j = 0; j < 8; ++j) { const int n = (lane >> 3) + 8 * j; const LAS float* s = scr + (8 * c) * 65 + n;
        v4u o; o.x = pkbf(s[0 * 65], s[1 * 65]); o.y = pkbf(s[2 * 65], s[3 * 65]); o.z = pkbf(s[4 * 65], s[5 * 65]); o.w = pkbf(s[6 * 65], s[7 * 65]);
        *(v4u*)(WT + (size_t)(drow + n) * K + k0 + 8 * c) = o; }
    LDS_WAIT(); asm volatile("" ::: "memory");
}
__device__ __forceinline__ int gu_row(int n, int up) { return 256 * (n >> 7) + (n & 127) + 128 * up; }
__device__ __forceinline__ unsigned q8x4(float a, float b, float c, float d, float inv) {
    const unsigned ua = __float_as_uint(fmaf(a, inv, 12582912.0f)), ub = __float_as_uint(fmaf(b, inv, 12582912.0f)), uc = __float_as_uint(fmaf(c, inv, 12582912.0f)), ud = __float_as_uint(fmaf(d, inv, 12582912.0f));
    const unsigned lo = __builtin_amdgcn_perm(ub, ua, 0x0c0c0400u), hi = __builtin_amdgcn_perm(ud, uc, 0x0c0c0400u);
    return __builtin_amdgcn_perm(hi, lo, 0x05040100u);
}
template <class RowMap>
__device__ __forceinline__ void transpose_matrix(Frame& F, const float* W, int K, int N, bf16* WT, float scale_lo, int sc_n0, int sc_n1, float scale_in, RowMap rm, int& base, const float* gk = nullptr) {
    LAS float* scr = (LAS float*)(F.lds + F.wave * 16640);
    const int nkb = K / 64, nnb = N / 64, nit = nkb * nnb;
    int it = (F.gw - base % F.ngw + F.ngw) % F.ngw;
    for (; it < nit; it += F.ngw) { const int kb = it / nnb, nb = it % nnb, n0 = nb * 64;
        const float sc = (n0 >= sc_n0 && n0 < sc_n1) ? scale_in : scale_lo;
        transpose_item(W, K, N, WT, kb * 64, n0, rm(n0), sc, gk, scr, F.lane); }
    base += nit;
}
struct RmIdent { __device__ __forceinline__ int operator()(int n0) const { return n0; } };
struct RmOff { int off; __device__ __forceinline__ int operator()(int n0) const { return n0 + off; } };
struct RmGU { int up; __device__ __forceinline__ int operator()(int n0) const { return 256 * (n0 >> 7) + (n0 & 127) + 128 * up; } };

__device__ __forceinline__ float wave_max(float v) {
#pragma unroll
    for (int o = 1; o < 64; o <<= 1) v = fmaxf(v, __shfl_xor(v, o));
    return v;
}
__device__ __forceinline__ float quant_row_i8(const f32x4 (&v)[8], unsigned char* o8, int lane) {
    float mx = 0.f;
#pragma unroll
    for (int j = 0; j < 8; ++j) mx = fmaxf(mx, fmaxf(fmaxf(fabsf(v[j].x), fabsf(v[j].y)), fmaxf(fabsf(v[j].z), fabsf(v[j].w))));
    mx = wave_max(mx); const float inv = mx > 0.f ? 127.0f / mx : 0.f;
#pragma unroll
    for (int j = 0; j < 8; ++j) *((unsigned*)o8 + lane + 64 * j) = q8x4(v[j].x, v[j].y, v[j].z, v[j].w, inv);
    return mx * (1.0f / 127.0f);
}
__device__ __forceinline__ void row_to_bf16_rs(Frame& F, const float* xrow, bf16* orow, float* rs, unsigned char* o8) {
    f32x4 v[8]; float s = 0.f;
#pragma unroll
    for (int j = 0; j < 8; ++j) { v[j] = *((const f32x4*)xrow + F.lane + 64 * j); s += (v[j].x * v[j].x + v[j].y * v[j].y) + (v[j].z * v[j].z + v[j].w * v[j].w); }
    const float rstd = 1.0f / sqrtf(wave_sum(s) * (1.0f / DM) + EPS);
#pragma unroll
    for (int j = 0; j < 8; ++j) { u32x2v w; w.x = pkbf(v[j].x, v[j].y); w.y = pkbf(v[j].z, v[j].w); *((u32x2v*)orow + F.lane + 64 * j) = w; }
    const float step = quant_row_i8(v, o8, F.lane);
    if (F.lane == 0) *rs = rstd * step;
}

constexpr int QS_PITCH = 2056;
__device__ __forceinline__ void quant_strips(Frame& F) {
    unsigned char* ws = PWS(); LAS bf16* T = (LAS bf16*)F.lds; LAS float* red = (LAS float*)(F.lds + 32 * QS_PITCH * 2);
    const int G = F.ngw >> 3, vcu = F.gw >> 3, tid = F.tid;
    const int r = tid >> 3, c4 = (tid & 7) * 4;
    constexpr int NSTRIP = 8 * (DFF / 32);
    f32x4 v[2][8]; float gv[2][8];
#define QS_SRC(sI_, W_, gk_) const int mat_##W_ = (sI_) / (DFF / 32), n0_##W_ = ((sI_) - mat_##W_ * (DFF / 32)) * 32, l_##W_ = mat_##W_ >> 2, f_##W_ = (mat_##W_ >> 1) & 1, up_##W_ = mat_##W_ & 1; \
        const float* W_ = PIN(f_##W_ ? 26 + up_##W_ : 8 + up_##W_) + (size_t)l_##W_ * DM * DFF + n0_##W_; const float* gk_ = PIN(f_##W_ ? 25 : 7) + l_##W_ * DM
#define QS_LOAD(b_, W_, gk_) do { int rl_ = r; asm volatile("" : "+v"(rl_));   _Pragma("unroll") for (int it = 0; it < 8; ++it) { const int k = ((b_) * 8 + it) * 64 + rl_; v[(b_) & 1][it] = __builtin_nontemporal_load((const f32x4*)((W_) + (size_t)k * DFF + c4)); gv[(b_) & 1][it] = (gk_)[k]; } } while (0)
#define QS_WRITE(b_) do { _Pragma("unroll") for (int it = 0; it < 8; ++it) { const int k = ((b_) * 8 + it) * 64 + r; const f32x4 w = v[(b_) & 1][it] * gv[(b_) & 1][it]; const unsigned p0 = pkbf(w.x, w.y), p1 = pkbf(w.z, w.w); \
              LAS bf16* t_ = T + c4 * QS_PITCH + k; t_[0] = (bf16)p0; t_[QS_PITCH] = (bf16)(p0 >> 16); t_[2 * QS_PITCH] = (bf16)p1; t_[3 * QS_PITCH] = (bf16)(p1 >> 16); } } while (0)
#define QS_BAR() do { LDS_WAIT(); __builtin_amdgcn_s_barrier(); asm volatile("" ::: "memory"); } while (0)
    if (vcu < NSTRIP) { QS_SRC(vcu, W0, gk0); QS_LOAD(0, W0, gk0); }
    for (int sI = vcu; sI < NSTRIP; sI += G) {
        const int mat = sI / (DFF / 32), n0 = (sI - mat * (DFF / 32)) * 32, l = mat >> 2, f = (mat >> 1) & 1, up = mat & 1;
        unsigned char* WT = ws + WS_W + (size_t)l * W_LAYER + (f ? W_GU2 : W_GU1); float* cmax = (float*)(ws + WS_CS) + (size_t)(l * 2 + f) * 2 * DFF;
        { QS_SRC(sI, W, gk);
          QS_LOAD(1, W, gk); __builtin_amdgcn_sched_barrier(0);
          QS_WRITE(0); QS_LOAD(2, W, gk); __builtin_amdgcn_sched_barrier(0);
          QS_WRITE(1); QS_LOAD(3, W, gk); __builtin_amdgcn_sched_barrier(0);
          QS_WRITE(2); QS_WRITE(3); __builtin_amdgcn_sched_barrier(0); }
        if (sI + G < NSTRIP) { QS_SRC(sI + G, Wn, gkn); QS_LOAD(0, Wn, gkn); }
        QS_BAR();
        v4u q[8][2]; float mx[8];
#pragma unroll
        for (int j = 0; j < 8; ++j) { const LAS v4u* p_ = (const LAS v4u*)(T + (4 * j + (tid >> 7)) * QS_PITCH + 16 * (tid & 127)); float m = 0.f;
#pragma unroll
            for (int e = 0; e < 2; ++e) { q[j][e] = p_[e]; float x[8]; unpack8(q[j][e], x);
#pragma unroll
                for (int i = 0; i < 8; ++i) m = fmaxf(m, fabsf(x[i])); }
            mx[j] = wave_max(m); }
        if (F.lane == 0) {
#pragma unroll
            for (int j = 0; j < 8; ++j) red[(4 * j + (tid >> 7)) * 2 + (F.wave & 1)] = mx[j]; }
        QS_BAR();
#pragma unroll
        for (int j = 0; j < 8; ++j) { const int c = 4 * j + (tid >> 7), row = gu_row(n0 + c, up); const float cm = fmaxf(red[2 * c], red[2 * c + 1]), inv = cm > 0.f ? 127.0f / cm : 0.f;
            float x[8], y[8]; unpack8(q[j][0], x); unpack8(q[j][1], y);
            v4u o; o.x = q8x4(x[0], x[1], x[2], x[3], inv); o.y = q8x4(x[4], x[5], x[6], x[7], inv); o.z = q8x4(y[0], y[1], y[2], y[3], inv); o.w = q8x4(y[4], y[5], y[6], y[7], inv);
            *(v4u*)(WT + (size_t)row * DM + 16 * (tid & 127)) = o;
            if ((tid & 127) == 0) cmax[row] = cm; }
        QS_BAR();
    }
#undef QS_SRC
#undef QS_LOAD
#undef QS_WRITE
#undef QS_BAR
}

__device__ __forceinline__ void p0_prologue(Frame& F) {
    unsigned char* ws = PWS();
    int base = 0;
    for (int l = 0; l < DEPTH; ++l) {
        unsigned char* wl = ws + WS_W + (size_t)l * W_LAYER;
        if (l == 0 || F.ngw != 2048) {
        transpose_matrix(F, PIN(10) + (size_t)l * DFF * DM, DFF, DM, (bf16*)(wl + W_D1), 1.f, 0, 0, 1.f, RmIdent{}, base);
        transpose_matrix(F, PIN(28) + (size_t)l * DFF * DM, DFF, DM, (bf16*)(wl + W_D2), 1.f, 0, 0, 1.f, RmIdent{}, base); }
        transpose_matrix(F, PIN(13) + (size_t)l * DM * DIN, DM, DIN, (bf16*)(wl + W_IN), 1.f, ZC_QSB, ZC_KSB, SB_QSCALE, RmIdent{}, base, PIN(12) + l * DM);
        transpose_matrix(F, PIN(16) + (size_t)l * 512 * 1536, 512, 1536, (bf16*)(wl + W_UQ), MLA_QSCALE, 0, 0, 1.f, RmIdent{}, base);
        transpose_matrix(F, PIN(17) + (size_t)l * 512 * 1024, 512, 1024, (bf16*)(wl + W_UKV), 1.f, 0, 0, 1.f, RmIdent{}, base);
        transpose_matrix(F, PIN(18) + (size_t)l * 512 * 1024, 512, 1024, (bf16*)(wl + W_UKV), 1.f, 0, 0, 1.f, RmOff{1024}, base);
        transpose_matrix(F, PIN(23) + (size_t)l * DM * DM, DM, DM, (bf16*)(wl + W_O), 1.f, 0, 0, 1.f, RmIdent{}, base);
        { v4u* p = (v4u*)(wl + W_IN + (size_t)DIN * DM * 2); const int n16 = (DINP - DIN) * DM * 2 / 16;
          for (int i = F.gw * 64 + F.lane; i < n16; i += F.ngw * 64) p[i] = (v4u){0u, 0u, 0u, 0u}; }
    }
    { float* ct = (float*)(ws + WS_ROPE); float* st = ct + 4096 * 32;
      for (int i = F.gw * 64 + F.lane; i < 4096 * 32; i += F.ngw * 64) { const int pos = i >> 5, k = i & 31;
          const float inv = powf(10000.0f, -(float)k * (1.0f / 32.0f)); const float ang = (float)pos * inv; ct[i] = cosf(ang); st[i] = sinf(ang); } }
    for (int l = 0; l < DEPTH; ++l) {
        unsigned char* cl = ws + WS_C + (size_t)l * C_LAYER;
        { const float* src = PIN(2) + (size_t)l * 16 * 2048 * 512; bf16* dst = (bf16*)(cl + C_CKV);
          const bool skew = (F.ngw == 2048); const int ntrip = skew ? (F.gw < 1024 ? 1 : 3) : (4096 - F.gw + F.ngw - 1) / F.ngw;
          for (int ti = 0; ti < ntrip; ++ti) { const int r0 = 8 * (skew ? (F.gw < 1024 ? F.gw : 1024 + 3 * (F.gw - 1024) + ti) : F.gw + ti * F.ngw); float f[8][8];
#pragma unroll
              for (int u = 0; u < 8; ++u) ld8f(src + (size_t)(r0 + u) * 512 + 8 * F.lane, f[u]);
#pragma unroll
              for (int u = 0; u < 8; ++u) { const int r = r0 + u, s = r >> 11, p = r & 2047; *(v4u*)(dst + (size_t)(8192 + s * 2112 + p) * 512 + 8 * F.lane) = pack8(f[u]); } } }
        { const float* src = PIN(3) + (size_t)l * 16 * 2048 * 64; unsigned char* dst = cl + C_KR;
          for (int it = F.gw; it < 16 * 32; it += F.ngw) { const int s = it >> 5, t = it & 31, tile = 128 + 33 * s + t; const float* rp = src + ((size_t)s * 2048 + t * 64 + F.lane) * 64;
              float f[8][8];
#pragma unroll
              for (int c = 0; c < 8; ++c) ld8f(rp + 8 * c, f[c]);
#pragma unroll
              for (int c = 0; c < 8; ++c) *(v4u*)(dst + ((size_t)(tile * 8 + c) * 64 + F.lane) * 16) = pack8(f[c]); } }
    }
    { bf16* hb = (bf16*)(ws + WS_HB); float* rs = (float*)(ws + WS_RS);
      for (int m = (F.gw + F.ngw / 2) % F.ngw; m < MT; m += F.ngw) {   const float* xr = m < TP ? PIN(0) + (size_t)m * DM : PIN(1) + (size_t)(m - TP) * DM; row_to_bf16_rs(F, xr, hb + (size_t)m * DM, rs + m, ws + WS_HB8 + (size_t)m * DM); } }
}

__device__ __forceinline__ void deferred_down_weights(Frame& F) {
    const int bid = (int)blockIdx.x; if (bid < 48 || F.ngw != 2048) return;
    Frame F2 = F; F2.gw = (bid - 48) * NWAVES + F.wave; F2.ngw = ((int)gridDim.x - 48) * NWAVES;
    unsigned char* wl = PWS() + WS_W + (size_t)1 * W_LAYER; int base = 0;
    transpose_matrix(F2, PIN(10) + (size_t)1 * DFF * DM, DFF, DM, (bf16*)(wl + W_D1), 1.f, 0, 0, 1.f, RmIdent{}, base);
    transpose_matrix(F2, PIN(28) + (size_t)1 * DFF * DM, DFF, DM, (bf16*)(wl + W_D2), 1.f, 0, 0, 1.f, RmIdent{}, base);
}

template <bool IN32> struct NormHRaw;
template <> struct NormHRaw<true> { typedef f32x4 T; static __device__ __forceinline__ T ld(const void* p, int i) { return *((const f32x4*)p + i); } static __device__ __forceinline__ f32x4 cvt(const T& w) { return w; } };
template <> struct NormHRaw<false> { typedef u32x2v T; static __device__ __forceinline__ T ld(const void* p, int i) { return *((const u32x2v*)p + i); } static __device__ __forceinline__ f32x4 cvt(const T& w) { return (f32x4){bflo(w.x), bfhi(w.x), bflo(w.y), bfhi(w.y)}; } };
template <bool IN32, bool OUT32>
__device__ __forceinline__ void norm_phase(Frame& F, const bf16* f, const bf16* f1, const void* hin_p, const void* hin_s, float coef, const float* g1, float* rs, void* hout, unsigned char* h8 = nullptr) {
    const bool deal = (F.ngw == 2048);
    const int nrow = deal ? (F.gw < 1024 ? 4 : 5) : (MT - F.gw + F.ngw - 1) / F.ngw;
#define NP_ROW(it_) (deal ? (F.gw < 1024 ? ((it_) == 0 ? TP + F.gw : 3 * F.gw + (it_) - 1) : 3072 + 5 * (F.gw - 1024) + (it_)) : F.gw + (it_) * F.ngw)
    typedef typename NormHRaw<IN32>::T HRaw;
    f32x4 gv[8]; u32x2v nf[8]; HRaw nh[8];
#pragma unroll
    for (int j = 0; j < 8; ++j) gv[j] = *((const f32x4*)g1 + F.lane + 64 * j);
#define NP_ISSUE(m_) do { const bf16* fr_ = f + (size_t)(m_) * DM; _Pragma("unroll") for (int j = 0; j < 8; ++j) nf[j] = *((const u32x2v*)fr_ + F.lane + 64 * j); \
        if (IN32) { const float* hr_ = (m_) < TP ? (const float*)hin_p + (size_t)(m_) * DM : (const float*)hin_s + (size_t)((m_) - TP) * DM; _Pragma("unroll") for (int j = 0; j < 8; ++j) nh[j] = NormHRaw<IN32>::ld(hr_, F.lane + 64 * j); } \
        else { const bf16* hr_ = (const bf16*)hin_p + (size_t)(m_) * DM; _Pragma("unroll") for (int j = 0; j < 8; ++j) nh[j] = NormHRaw<IN32>::ld(hr_, F.lane + 64 * j); } } while (0)
    if (nrow > 0) { const int m0_ = NP_ROW(0); NP_ISSUE(m0_); }
    for (int it = 0; it < nrow; ++it) {
        const int m = NP_ROW(it);
        f32x4 v[8], hv[8]; float s = 0.f;
#pragma unroll
        for (int j = 0; j < 8; ++j) { const u32x2v w = nf[j]; v[j] = (f32x4){bflo(w.x), bfhi(w.x), bflo(w.y), bfhi(w.y)}; hv[j] = NormHRaw<IN32>::cvt(nh[j]); }
        if (it + 1 < nrow) { const int mn_ = NP_ROW(it + 1); NP_ISSUE(mn_); }
        if (m >= TP) { const bf16* pr = f1 + (size_t)(m - TP) * DM;
            u32x2v pw[4][8];
#pragma unroll
            for (int p = 0; p < 4; ++p)
#pragma unroll
                for (int j = 0; j < 8; ++j) pw[p][j] = *((const u32x2v*)(pr + (size_t)p * 1024 * DM) + F.lane + 64 * j);
#pragma unroll
            for (int p = 0; p < 4; ++p)
#pragma unroll
                for (int j = 0; j < 8; ++j) v[j] = v[j] + (f32x4){bflo(pw[p][j].x), bfhi(pw[p][j].x), bflo(pw[p][j].y), bfhi(pw[p][j].y)};
#pragma unroll
            for (int p = 0; p < 3; ++p)
#pragma unroll
                for (int j = 0; j < 8; ++j) pw[p][j] = *((const u32x2v*)(pr + (size_t)(4 + p) * 1024 * DM) + F.lane + 64 * j);
#pragma unroll
            for (int p = 0; p < 3; ++p)
#pragma unroll
                for (int j = 0; j < 8; ++j) v[j] = v[j] + (f32x4){bflo(pw[p][j].x), bfhi(pw[p][j].x), bflo(pw[p][j].y), bfhi(pw[p][j].y)}; }
#pragma unroll
        for (int j = 0; j < 8; ++j) s += (v[j].x * v[j].x + v[j].y * v[j].y) + (v[j].z * v[j].z + v[j].w * v[j].w);
        const float rstd = coef / sqrtf(wave_sum(s) * (1.0f / DM) + EPS); float s2 = 0.f;
#pragma unroll
        for (int j = 0; j < 8; ++j) { const f32x4 gg = gv[j]; hv[j] = hv[j] + v[j] * gg * rstd;
            if (OUT32) *((f32x4*)((float*)hout + (size_t)m * DM) + F.lane + 64 * j) = hv[j];
            else { u32x2v w; w.x = pkbf(hv[j].x, hv[j].y); w.y = pkbf(hv[j].z, hv[j].w); *((u32x2v*)((bf16*)hout + (size_t)m * DM) + F.lane + 64 * j) = w; }
            s2 += (hv[j].x * hv[j].x + hv[j].y * hv[j].y) + (hv[j].z * hv[j].z + hv[j].w * hv[j].w); }
        if (rs) { float r2 = 1.0f / sqrtf(wave_sum(s2) * (1.0f / DM) + EPS); if (h8) r2 *= quant_row_i8(hv, h8 + (size_t)m * DM, F.lane); if (F.lane == 0) rs[m] = r2; }
    }
}
#undef NP_ROW
#undef NP_ISSUE

__device__ __forceinline__ void postz_phase(Frame& F, int l) {
    unsigned char* ws = PWS(); const bf16* Z = (const bf16*)(ws + WS_Z); bf16* CQN = (bf16*)(ws + WS_CQN); bf16* MRG = (bf16*)(ws + WS_XN);
    unsigned char* cl = ws + WS_C + (size_t)l * C_LAYER; bf16* CKV = (bf16*)(cl + C_CKV);
    const float* ctab = (const float*)(ws + WS_ROPE); const float* stab = ctab + 4096 * 32;
    const float* gq = PIN(14) + l * 512; const float* gkv = PIN(15) + l * 512; const float* cw = PIN(19) + l * 3 * 512; const float* gcv = PIN(21) + l * 512;
    float* out = POUT(); const int L8 = 8 * F.lane;
    float gq8[8], gkv8[8], gcv8[8], w0[8], w1[8], w2[8];
    ld8f(gq + L8, gq8); ld8f(gkv + L8, gkv8); ld8f(gcv + L8, gcv8); ld8f(cw + L8, w0); ld8f(cw + 512 + L8, w1); ld8f(cw + 1024 + L8, w2);
    for (int r = F.gw; r < MT; r += F.ngw) {
        const bool smp = r >= TP; const int b = smp ? (r - TP) >> 6 : r >> 12, t = smp ? (r - TP) & 63 : r & 4095, pos = smp ? 2048 + t : t;
        const int g = smp ? 8192 + b * 2112 + 2048 + t : r, tile = g >> 6, kap = g & 63;
        const bf16* zr = Z + (size_t)r * DINP;
        const v4u zq = *(const v4u*)(zr + ZC_CQ + L8), zkv = *(const v4u*)(zr + ZC_CKV + L8), zkr = *(const v4u*)(zr + ZC_KR + 8 * (F.lane & 7));
        const v4u zgc2 = *(const v4u*)(zr + ZC_GC + L8), zxc2 = *(const v4u*)(zr + ZC_XC + L8), zgb = *(const v4u*)(zr + ZC_GB + L8), zks = *(const v4u*)(zr + ZC_KSB + L8), zvs = *(const v4u*)(zr + ZC_VSB + L8);
        v4u zgc1 = (v4u){0u, 0u, 0u, 0u}, zxc1 = zgc1, zgc0 = zgc1, zxc0 = zgc1;
        float rc8[8], rs8[8]; ld8f(ctab + pos * 32 + 8 * (F.lane & 3), rc8); ld8f(stab + pos * 32 + 8 * (F.lane & 3), rs8);
        if (t >= 1) { zgc1 = *(const v4u*)(zr - DINP + ZC_GC + L8); zxc1 = *(const v4u*)(zr - DINP + ZC_XC + L8); }
        if (t >= 2) { zgc0 = *(const v4u*)(zr - 2 * DINP + ZC_GC + L8); zxc0 = *(const v4u*)(zr - 2 * DINP + ZC_XC + L8); }
        { float f[8]; unpack8(zq, f); float s = 0.f;
#pragma unroll
          for (int i = 0; i < 8; ++i) s += f[i] * f[i];
          const float rs = 1.0f / sqrtf(wave_sum(s) * (1.0f / 512) + EPS);
#pragma unroll
          for (int i = 0; i < 8; ++i) f[i] = f[i] * rs * gq8[i];
          *(v4u*)(CQN + (size_t)r * 512 + L8) = pack8(f); }
        { float f[8]; unpack8(zkv, f); float s = 0.f;
#pragma unroll
          for (int i = 0; i < 8; ++i) s += f[i] * f[i];
          const float rs = 1.0f / sqrtf(wave_sum(s) * (1.0f / 512) + EPS);
#pragma unroll
          for (int i = 0; i < 8; ++i) f[i] = f[i] * rs * gkv8[i];
          float* op = smp ? out + O_CKV_S + ((size_t)(l * 16 + b) * 64 + t) * 512 : out + O_CKV_P + ((size_t)(l * 2 + b) * 4096 + t) * 512;
          st8f(op + L8, f); *(v4u*)(CKV + (size_t)g * 512 + L8) = pack8(f); }
        { float f[8], p[8]; const int lz = F.lane & 7; unpack8(zkr, f);
#pragma unroll
          for (int i = 0; i < 8; ++i) p[i] = __shfl_xor(f[i], 4);
#pragma unroll
          for (int i = 0; i < 8; ++i) f[i] = (lz < 4) ? f[i] * rc8[i] - p[i] * rs8[i] : f[i] * rc8[i] + p[i] * rs8[i];
          if (F.lane < 8) { float* op = smp ? out + O_KR_S + ((size_t)(l * 16 + b) * 64 + t) * 64 : out + O_KR_P + ((size_t)(l * 2 + b) * 4096 + t) * 64;
              st8f(op + 8 * F.lane, f); *(v4u*)(cl + C_KR + ((size_t)(tile * 8 + F.lane) * 64 + kap) * 16) = pack8(f); } }
        { float uc0[8], uc1[8], uc2[8];
          { float a[8], x[8]; unpack8(zgc2, a); unpack8(zxc2, x);
#pragma unroll
            for (int i = 0; i < 8; ++i) uc2[i] = a[i] * x[i]; }
          if (t >= 1) { float a[8], x[8]; unpack8(zgc1, a); unpack8(zxc1, x);
#pragma unroll
            for (int i = 0; i < 8; ++i) uc1[i] = a[i] * x[i]; }
          else if (smp) ld8f(PIN(6) + ((size_t)(l * 16 + b) * 2 + 1) * 512 + L8, uc1);
          else {
#pragma unroll
            for (int i = 0; i < 8; ++i) uc1[i] = 0.f; }
          if (t >= 2) { float a[8], x[8]; unpack8(zgc0, a); unpack8(zxc0, x);
#pragma unroll
            for (int i = 0; i < 8; ++i) uc0[i] = a[i] * x[i]; }
          else if (smp) ld8f(PIN(6) + ((size_t)(l * 16 + b) * 2 + t) * 512 + L8, uc0);
          else {
#pragma unroll
            for (int i = 0; i < 8; ++i) uc0[i] = 0.f; }
          float gb[8], y[8]; unpack8(zgb, gb); float s = 0.f;
#pragma unroll
          for (int i = 0; i < 8; ++i) { y[i] = gb[i] * ((w0[i] * uc0[i] + w1[i] * uc1[i]) + w2[i] * uc2[i]); s += y[i] * y[i]; }
          const float rs = 1.0f / sqrtf(wave_sum(s) * (1.0f / 512) + EPS);
#pragma unroll
          for (int i = 0; i < 8; ++i) y[i] = y[i] * rs * gcv8[i];
          *(v4u*)(MRG + (size_t)r * DM + 1024 + L8) = pack8(y);
          const int S = smp ? 64 : 4096;
          if (t >= S - 2) { float* op = smp ? out + O_CONV_S + ((size_t)(l * 16 + b) * 2 + (t - (S - 2))) * 512 : out + O_CONV_P + ((size_t)(l * 2 + b) * 2 + (t - (S - 2))) * 512; st8f(op + L8, uc2); } }
        { float f[8]; const v4u kw = zks; unpack8(kw, f);
          float* op = smp ? out + O_SBK_S + ((size_t)(l * 16 + b) * 64 + t) * 512 : out + O_SBK_P + ((size_t)(l * 2 + b) * 4096 + t) * 512; st8f(op + L8, f);
          *(v4u*)(cl + C_KSB + ((size_t)((tile * 4 + (F.lane >> 4)) * 16 + (F.lane & 15)) * 64 + kap) * 16) = kw;
          unpack8(zvs, f);
          op = smp ? out + O_SBV_S + ((size_t)(l * 16 + b) * 64 + t) * 512 : out + O_SBV_P + ((size_t)(l * 2 + b) * 4096 + t) * 512; st8f(op + L8, f); }
    }
    { LAS unsigned char* tl = F.lds + F.wave * 17408;
      for (int it = (F.gw + F.ngw / 2) % F.ngw; it < 144 * 4; it += F.ngw) {   const int h = it & 3, ti = it >> 2; const int r0 = ti < 128 ? ti * 64 : TP + (ti - 128) * 64, tile = ti < 128 ? ti : 128 + 33 * (ti - 128) + 32;
          const bf16* zp = Z + (size_t)r0 * DINP + ZC_VSB + h * 128; const int kr = F.lane >> 4, c16 = F.lane & 15;
          v4u tw[16];
#pragma unroll
          for (int i = 0; i < 16; ++i) tw[i] = *(const v4u*)(zp + (size_t)(4 * i + kr) * DINP + 8 * c16);
#pragma unroll
          for (int i = 0; i < 16; ++i) { const int key = 4 * i + kr; *(LAS v4u*)(tl + key * 272 + c16 * 16) = tw[i]; }
          LDS_WAIT(); asm volatile("" ::: "memory");
#pragma unroll
          for (int dh = 0; dh < 2; ++dh) { const int d = dh * 64 + F.lane;
#pragma unroll
              for (int P = 0; P < 8; ++P) { unsigned e[8];
#pragma unroll
                  for (int j = 0; j < 8; ++j) { const int key = 16 * (P >> 1) + 4 * (P & 1) + (j < 4 ? j : j + 4); e[j] = *(const LAS unsigned short*)(tl + key * 272 + d * 2); }
                  v4u o; o.x = e[0] | (e[1] << 16); o.y = e[2] | (e[3] << 16); o.z = e[4] | (e[5] << 16); o.w = e[6] | (e[7] << 16);
                  *(v4u*)(cl + C_VTSB + ((size_t)((tile * 4 + h) * 8 + P) * 128 + d) * 16) = o; } }
          LDS_WAIT(); asm volatile("" ::: "memory"); } }
}

__device__ __forceinline__ void postattn_phase(Frame& F, int l) {
    const bf16* Y = (const bf16*)(PWS() + WS_YATT); bf16* MRG = (bf16*)(PWS() + WS_XN); const float* PO = (const float*)(PWS() + WS_PO); const float* PML = (const float*)(PWS() + WS_PML);
    const float* gm = PIN(20) + l * 1024; const float* gs = PIN(22) + l * 512; const int L8 = 8 * F.lane;
    float g0[8], g1[8], g2[8]; ld8f(gm + L8, g0); ld8f(gm + 512 + L8, g1); ld8f(gs + L8, g2);
    for (int r = F.gw; r < MT; r += F.ngw) {
        const bf16* yr = Y + (size_t)r * YW; float a[8], b[8], c[8];
        if (r >= TP) {
            const int sI = (r - TP) >> 6, rr = (r - TP) & 63;
#pragma unroll
            for (int hh = 0; hh < 2; ++hh) { const int h = 4 * hh + (F.lane >> 4); const size_t pu = (size_t)((sI * 8 + h) * 3);
                float mp[3], lp[3], mm = -INFINITY;
#pragma unroll
                for (int p = 0; p < 3; ++p) { mp[p] = PML[((pu + p) * 64 + rr) * 2]; lp[p] = PML[((pu + p) * 64 + rr) * 2 + 1]; mm = fmaxf(mm, mp[p]); }
                float acc[8], den = 0.f;
#pragma unroll
                for (int i = 0; i < 8; ++i) acc[i] = 0.f;
#pragma unroll
                for (int p = 0; p < 3; ++p) { const float w = __builtin_amdgcn_exp2f(mp[p] - mm); den += lp[p] * w; float x[8]; ld8f(PO + ((pu + p) * 64 + rr) * 128 + 8 * (F.lane & 15), x);
#pragma unroll
                    for (int i = 0; i < 8; ++i) acc[i] += x[i] * w; }
                const float inv = 1.0f / den;
#pragma unroll
                for (int i = 0; i < 8; ++i) { if (hh) b[i] = acc[i] * inv; else a[i] = acc[i] * inv; } }
        } else if (((r & 4095) >> 8) >= 12) {
            const int qb = (r & 4095) >> 8, bI = r >> 12, rr = r & 255;
            const bf16* PO16 = (const bf16*)(PWS() + WS_PO16); const float* PML16 = (const float*)(PWS() + WS_PML16);
#pragma unroll
            for (int hh = 0; hh < 2; ++hh) { const int h = 4 * hh + (F.lane >> 4); const size_t pu = (size_t)((bI * 8 + h) * 8 + 2 * (qb - 12));
                const float m0 = PML16[(pu * 256 + rr) * 2], l0 = PML16[(pu * 256 + rr) * 2 + 1], m1 = PML16[((pu + 1) * 256 + rr) * 2], l1 = PML16[((pu + 1) * 256 + rr) * 2 + 1];
                const float mm = fmaxf(m0, m1), w0 = __builtin_amdgcn_exp2f(m0 - mm), w1 = __builtin_amdgcn_exp2f(m1 - mm), inv = 1.0f / (l0 * w0 + l1 * w1);
                float x0[8], x1[8]; unpack8(*(const v4u*)(PO16 + (pu * 256 + rr) * 128 + 8 * (F.lane & 15)), x0); unpack8(*(const v4u*)(PO16 + ((pu + 1) * 256 + rr) * 128 + 8 * (F.lane & 15)), x1);
#pragma unroll
                for (int i = 0; i < 8; ++i) { const float v = (x0[i] * w0 + x1[i] * w1) * inv; if (hh) b[i] = v; else a[i] = v; } }
        } else { unpack8(*(const v4u*)(yr + L8), a); unpack8(*(const v4u*)(yr + 512 + L8), b); }
        unpack8(*(const v4u*)(yr + 1024 + L8), c);
        float s1 = 0.f, s2 = 0.f;
#pragma unroll
        for (int i = 0; i < 8; ++i) { s1 += a[i] * a[i] + b[i] * b[i]; s2 += c[i] * c[i]; }
        const float r1 = 1.0f / sqrtf(wave_sum(s1) * (1.0f / 1024) + EPS), r2 = 1.0f / sqrtf(wave_sum(s2) * (1.0f / 512) + EPS);
#pragma unroll
        for (int i = 0; i < 8; ++i) { a[i] = a[i] * r1 * g0[i]; b[i] = b[i] * r1 * g1[i]; c[i] = c[i] * r2 * g2[i]; }
        bf16* mr = MRG + (size_t)r * DM; *(v4u*)(mr + L8) = pack8(a); *(v4u*)(mr + 512 + L8) = pack8(b); *(v4u*)(mr + 1536 + L8) = pack8(c);
    }
}

struct AttnJob {
    const bf16* q; int qpitch; int nrows; int pos0;
    const unsigned char* kA; int kA_ts; const unsigned char* kB; int kB_ts; const unsigned char* vt; int vt_ts;
    int ntiles; bf16* out; int opitch;
    int t0; bf16* po; float* pml;
    const float* kc; const float* vc; int ncache;
};
constexpr int ATT_BUF = 40960, ATT_K = 0, ATT_KB = 16384, ATT_V = 24576, ATT_FLAGS = 139264, ATT_QWORD = ATT_FLAGS + 64;
constexpr int S4_KR = 65536, S4_V = 73728;
#define ATT_GLDS(gp, loff) __builtin_amdgcn_global_load_lds((const unsigned*)(gp), (LAS unsigned*)(lds + (loff)), 16, 0, 0)
#define ATT_MFMA(a, b, c) __builtin_amdgcn_mfma_f32_32x32x16_bf16((a), (b), (c), 0, 0, 0)

template <bool SB>
__device__ __forceinline__ void attn_issue(LAS unsigned char* lds, const AttnJob& J, int t, int buf, int wid, int lane) {
    const int lb = buf * ATT_BUF;
    const unsigned char* ka = J.kA + (size_t)t * J.kA_ts + wid * 2048 + lane * 16;
    ATT_GLDS(ka, lb + ATT_K + wid * 2048); ATT_GLDS(ka + 1024, lb + ATT_K + wid * 2048 + 1024);
    if (!SB) { const unsigned char* kb = J.kB + (size_t)t * J.kB_ts + wid * 1024 + lane * 16; ATT_GLDS(kb, lb + ATT_KB + wid * 1024); }
    const unsigned char* vp = J.vt + (size_t)t * J.vt_ts + wid * 2048 + lane * 16;
    ATT_GLDS(vp, lb + ATT_V + wid * 2048); ATT_GLDS(vp + 1024, lb + ATT_V + wid * 2048 + 1024);
}

__device__ __forceinline__ void attn_stage_cache(LAS unsigned char* lds, const AttnJob& J, int t, int buf, int tid) {
    const int lb = buf * ATT_BUF;
    { const int key = tid & 63, cg = tid >> 6; const float* kp = J.kc + (size_t)(64 * t + key) * 512;
#pragma unroll
      for (int i = 0; i < 2; ++i) { const int c = cg + 8 * i; float f[8]; ld8f(kp + 8 * c, f); *(LAS v4u*)(lds + lb + ATT_K + (c * 64 + key) * 16) = pack8(f); } }
    { const int d = tid & 127, pq = tid >> 7; const float* vp = J.vc + (size_t)(64 * t) * 512 + d;
#pragma unroll
      for (int i = 0; i < 2; ++i) { const int P = pq + 4 * i; float f[8];
#pragma unroll
          for (int j = 0; j < 8; ++j) { const int key = 16 * (P >> 1) + 4 * (P & 1) + (j < 4 ? j : j + 4); f[j] = vp[(size_t)key * 512]; }
          *(LAS v4u*)(lds + lb + ATT_V + (P * 128 + d) * 16) = pack8(f); } }
}

template <bool SB>
__device__ __forceinline__ void attn_unit(LAS unsigned char* lds, const AttnJob& J, const float* ctab, const float* stab, int wid, int lane) {
    constexpr int NQ = SB ? 8 : 12;
    const int r32 = lane & 31, hi = lane >> 5, r0 = wid * 32;
    const bool active = r0 < J.nrows;
    const int nt = J.ntiles;
    const int ncache = SB ? J.ncache : 0;
    if (!SB || nt - 1 >= ncache) attn_issue<SB>(lds, J, SB ? nt - 1 : 0, 0, wid, lane);
    bf16x8 qf[NQ];
    const int qpos = J.pos0 + r0 + r32;
    if (active) {
        const bf16* qp = J.q + (size_t)(r0 + r32) * J.qpitch + 8 * hi;
#pragma unroll
        for (int d0 = 0; d0 < NQ; ++d0) qf[d0] = *(const bf16x8*)(qp + 16 * d0);
        if (!SB) {
#pragma unroll
            for (int fi = 0; fi < 2; ++fi) {
                float x1[8], x2[8], c[8], s[8]; unpack8(__builtin_bit_cast(v4u, qf[8 + fi]), x1); unpack8(__builtin_bit_cast(v4u, qf[10 + fi]), x2);
                ld8f(ctab + qpos * 32 + 16 * fi + 8 * hi, c); ld8f(stab + qpos * 32 + 16 * fi + 8 * hi, s);
                float o1[8], o2[8];
#pragma unroll
                for (int j = 0; j < 8; ++j) { o1[j] = x1[j] * c[j] - x2[j] * s[j]; o2[j] = x2[j] * c[j] + x1[j] * s[j]; }
                qf[8 + fi] = __builtin_bit_cast(bf16x8, pack8(o1)); qf[10 + fi] = __builtin_bit_cast(bf16x8, pack8(o2));
            }
        }
    } else {
#pragma unroll
        for (int d0 = 0; d0 < NQ; ++d0) qf[d0] = (bf16x8){0, 0, 0, 0, 0, 0, 0, 0};
    }
    f32x16 o[4];
#pragma unroll
    for (int db = 0; db < 4; ++db)
#pragma unroll
        for (int r = 0; r < 16; ++r) o[db][r] = 0.f;
    float m_run = -INFINITY, l_run = 0.f, R = 0.f;
    const int wave_lim = SB ? 0 : ((J.pos0 + r0) >> 6);
    const int max_qp = J.pos0 + r0 + 31;
    for (int i = 0; i < nt; ++i) {
        const int t = SB ? nt - 1 - i : i;
        if (SB) {
            const bool nxt_dma = (i + 1 < nt) && (t - 1 >= ncache);
            if (nxt_dma) attn_issue<SB>(lds, J, t - 1, (i + 1) & 1, wid, lane);
            if (t >= ncache) { if (nxt_dma) asm volatile("s_waitcnt vmcnt(4)" ::: "memory"); else asm volatile("s_waitcnt vmcnt(0)" ::: "memory"); }
            else { attn_stage_cache(lds, J, t, i & 1, (int)threadIdx.x); asm volatile("s_waitcnt vmcnt(0) lgkmcnt(0)" ::: "memory"); }
        } else {
            if (i + 1 < nt) { attn_issue<SB>(lds, J, t + 1, (i + 1) & 1, wid, lane); asm volatile("s_waitcnt vmcnt(5)" ::: "memory"); }
            else asm volatile("s_waitcnt vmcnt(0)" ::: "memory");
        }
        __builtin_amdgcn_s_barrier(); asm volatile("" ::: "memory");
        const bool work = active && (SB ? (64 * t < max_qp) : (t + J.t0 <= wave_lim));
        if (work) {
            LAS unsigned char* kbuf = lds + (i & 1) * ATT_BUF + hi * 1024 + r32 * 16;
            LAS unsigned char* vbuf = lds + (i & 1) * ATT_BUF + ATT_V + hi * 2048 + r32 * 16;
            f32x16 s0, s1;
#pragma unroll
            for (int r = 0; r < 16; ++r) { s0[r] = 0.f; s1[r] = 0.f; }
            bf16x8 ka[2][4];
#define ATT_RDK(buf, dbase) do { _Pragma("unroll") for (int j_ = 0; j_ < 2; ++j_) { ka[buf][2 * j_] = *(const LAS bf16x8*)(kbuf + ((dbase) + j_) * 2048); ka[buf][2 * j_ + 1] = *(const LAS bf16x8*)(kbuf + ((dbase) + j_) * 2048 + 512); } } while (0)
#define ATT_MMK(buf, dbase) do { _Pragma("unroll") for (int j_ = 0; j_ < 2; ++j_) { s0 = ATT_MFMA(ka[buf][2 * j_], qf[(dbase) + j_], s0); s1 = ATT_MFMA(ka[buf][2 * j_ + 1], qf[(dbase) + j_], s1); } } while (0)
#define ATT_RDV(buf, g) do { _Pragma("unroll") for (int db_ = 0; db_ < 4; ++db_) ka[buf][db_] = *(const LAS bf16x8*)(vbuf + (g) * 4096 + db_ * 512); } while (0)
#define ATT_MMV(buf, g) do { _Pragma("unroll") for (int db_ = 0; db_ < 4; ++db_) o[db_] = ATT_MFMA(ka[buf][db_], pb[g], o[db_]); } while (0)
#define ATT_SB0 __builtin_amdgcn_sched_barrier(0)
            ATT_RDK(0, 0); ATT_SB0;
            ATT_RDK(1, 2); ATT_MMK(0, 0); ATT_SB0;
            ATT_RDK(0, 4); ATT_MMK(1, 2); ATT_SB0;
            ATT_RDK(1, 6); ATT_MMK(0, 4); ATT_SB0;
            if (NQ == 12) { ATT_RDK(0, 8); ATT_MMK(1, 6); ATT_SB0;
                            ATT_RDK(1, 10); ATT_MMK(0, 8); ATT_SB0;
                            ATT_RDV(0, 0); ATT_MMK(1, 10); ATT_SB0; }
            else          { ATT_MMK(1, 6); ATT_SB0; }
            if (!SB) {
                float mx = s0[0];
#pragma unroll
                for (int r = 1; r < 16; ++r) mx = fmaxf(mx, s0[r]);
#pragma unroll
                for (int r = 0; r < 16; ++r) mx = fmaxf(mx, s1[r]);
                mx = fmaxf(mx, __shfl_xor(mx, 32));
                const float mn = fmaxf(m_run, mx), alpha = __builtin_amdgcn_exp2f(m_run - mn); m_run = mn;
                float ls = 0.f;
#pragma unroll
                for (int r = 0; r < 16; ++r) { s0[r] = __builtin_amdgcn_exp2f(s0[r] - mn); s1[r] = __builtin_amdgcn_exp2f(s1[r] - mn); ls += s0[r] + s1[r]; }
                l_run = l_run * alpha + ls;
#pragma unroll
                for (int db = 0; db < 4; ++db)
#pragma unroll
                    for (int r = 0; r < 16; ++r) o[db][r] *= alpha;
            } else {
                const int kbase = 64 * t + 4 * hi;
                float gs[8], L0[16], L1[16];
#pragma unroll
                for (int kb = 0; kb < 2; ++kb)
#pragma unroll
                    for (int gq = 0; gq < 4; ++gq) { float acc = 0.f;
#pragma unroll
                        for (int e = 0; e < 4; ++e) { const int r = 4 * gq + e; const float x = kb ? s1[r] : s0[r];
                            const float sp = fmaxf(x, 0.f) + LN2 * __builtin_amdgcn_logf(1.0f + __builtin_amdgcn_exp2f(-fabsf(x) * LOG2E));
                            const bool earlier = (kbase + 32 * kb + e + 8 * gq) < qpos;
                            const float lk = earlier ? -sp : 0.f; acc += lk;
                            if (kb) { L1[r] = lk; s1[r] = x - sp; } else { L0[r] = lk; s0[r] = x - sp; } }
                        gs[4 * kb + gq] = acc; }
                float pgs[8];
#pragma unroll
                for (int j = 0; j < 8; ++j) pgs[j] = __shfl_xor(gs[j], 32);
                float T = 0.f;
#pragma unroll
                for (int j = 7; j >= 0; --j) { const int kb = j >> 2, gq = j & 3;
                    float W = T + (hi == 0 ? pgs[j] : 0.f) + R;
#pragma unroll
                    for (int e = 3; e >= 0; --e) { const int r = 4 * gq + e; const float lb = kb ? s1[r] : s0[r];
                        const bool earlier = (kbase + 32 * kb + e + 8 * gq) < qpos;
                        const float w = earlier ? __builtin_amdgcn_exp2f((lb + W) * LOG2E) : 0.f;
                        W += kb ? L1[r] : L0[r];
                        if (kb) s1[r] = w; else s0[r] = w; }
                    T += gs[j] + pgs[j]; }
                R += T;
            }
            bf16x8 pb[4];
            { v4u w;
              w.x = pkbf(s0[0], s0[1]); w.y = pkbf(s0[2], s0[3]); w.z = pkbf(s0[4], s0[5]); w.w = pkbf(s0[6], s0[7]); pb[0] = __builtin_bit_cast(bf16x8, w);
              w.x = pkbf(s0[8], s0[9]); w.y = pkbf(s0[10], s0[11]); w.z = pkbf(s0[12], s0[13]); w.w = pkbf(s0[14], s0[15]); pb[1] = __builtin_bit_cast(bf16x8, w);
              w.x = pkbf(s1[0], s1[1]); w.y = pkbf(s1[2], s1[3]); w.z = pkbf(s1[4], s1[5]); w.w = pkbf(s1[6], s1[7]); pb[2] = __builtin_bit_cast(bf16x8, w);
              w.x = pkbf(s1[8], s1[9]); w.y = pkbf(s1[10], s1[11]); w.z = pkbf(s1[12], s1[13]); w.w = pkbf(s1[14], s1[15]); pb[3] = __builtin_bit_cast(bf16x8, w); }
            ATT_SB0;
            if (SB) { ATT_RDV(0, 0); ATT_RDV(1, 1); ATT_SB0; } else { ATT_RDV(1, 1); ATT_SB0; }
            ATT_MMV(0, 0); ATT_RDV(0, 2); ATT_SB0;
            ATT_MMV(1, 1); ATT_RDV(1, 3); ATT_SB0;
            ATT_MMV(0, 2); ATT_SB0;
            ATT_MMV(1, 3);
#undef ATT_SB0
#undef ATT_RDK
#undef ATT_MMK
#undef ATT_RDV
#undef ATT_MMV
        }
        if (SB) { const bool done = !active || __all(R < SB_EXIT); if (lane == 0) *(volatile LAS unsigned*)(lds + ATT_FLAGS + (i & 1) * 32 + wid * 4) = done ? 1u : 0u; }
        asm volatile("s_waitcnt lgkmcnt(0)" ::: "memory"); __builtin_amdgcn_s_barrier(); asm volatile("" ::: "memory");
        if (SB) { const volatile LAS unsigned* fl = (const volatile LAS unsigned*)(lds + ATT_FLAGS + (i & 1) * 32);
            unsigned all = fl[0] & fl[1] & fl[2] & fl[3] & fl[4] & fl[5] & fl[6] & fl[7];
            if (__builtin_amdgcn_readfirstlane(all)) break; }
    }
    asm volatile("s_waitcnt vmcnt(0)" ::: "memory");
    if (active) {
        float inv = 1.f; bf16* op = J.out + (size_t)(r0 + r32) * J.opitch + 4 * hi;
        if (!SB) { const float lt = l_run + __shfl_xor(l_run, 32); inv = 1.0f / lt;
            if (J.po) { inv = 1.0f; op = J.po + (size_t)(r0 + r32) * 128 + 4 * hi; if (hi == 0) { float* ml = J.pml + (size_t)(r0 + r32) * 2; ml[0] = m_run; ml[1] = lt; } } }
#pragma unroll
        for (int db = 0; db < 4; ++db)
#pragma unroll
            for (int gq = 0; gq < 4; ++gq) { u32x2v w; w.x = pkbf(o[db][4 * gq] * inv, o[db][4 * gq + 1] * inv); w.y = pkbf(o[db][4 * gq + 2] * inv, o[db][4 * gq + 3] * inv);
                *(u32x2v*)(op + 32 * db + 8 * gq) = w; }
    }
    __builtin_amdgcn_s_barrier();
}

__device__ __forceinline__ void attn_unit_pp(LAS unsigned char* lds, const AttnJob& J, const float* ctab, const float* stab, int wid, int lane) {
    constexpr int NQ = 12, PPK = 24576, PPV0 = 49152, PPV = 16384;
    const int r32 = lane & 31, hi = lane >> 5, r0 = wid * 32;
    const bool late = wid >= 4;
    const int nt = J.ntiles;
#define PP_ISSUE(t, kb, vb) do { const unsigned char* ka_ = J.kA + (size_t)(t) * J.kA_ts + wid * 2048 + lane * 16; \
        ATT_GLDS(ka_, (kb) * PPK + wid * 2048); ATT_GLDS(ka_ + 1024, (kb) * PPK + wid * 2048 + 1024); \
        const unsigned char* kr_ = J.kB + (size_t)(t) * J.kB_ts + wid * 1024 + lane * 16; ATT_GLDS(kr_, (kb) * PPK + 16384 + wid * 1024); \
        const unsigned char* vp_ = J.vt + (size_t)(t) * J.vt_ts + wid * 2048 + lane * 16; \
        ATT_GLDS(vp_, PPV0 + (vb) * PPV + wid * 2048); ATT_GLDS(vp_ + 1024, PPV0 + (vb) * PPV + wid * 2048 + 1024); } while (0)
    PP_ISSUE(0, 0, 0);
    if (wid == 0 && lane == 0) { volatile LAS unsigned long long* st = (volatile LAS unsigned long long*)(lds + ATT_FLAGS + 256); st[0] = (unsigned long long)J.out; st[1] = (unsigned long long)J.po; st[2] = (unsigned long long)J.pml; }
    const int opitch_ = J.opitch;
    bf16x8 qf[NQ];
    const int qpos = J.pos0 + r0 + r32;
    { const bf16* qp = J.q + (size_t)(r0 + r32) * J.qpitch + 8 * hi;
#pragma unroll
      for (int d0 = 0; d0 < NQ; ++d0) qf[d0] = *(const bf16x8*)(qp + 16 * d0);
#pragma unroll
      for (int fi = 0; fi < 2; ++fi) {
          float x1[8], x2[8], c[8], sn[8]; unpack8(__builtin_bit_cast(v4u, qf[8 + fi]), x1); unpack8(__builtin_bit_cast(v4u, qf[10 + fi]), x2);
          ld8f(ctab + qpos * 32 + 16 * fi + 8 * hi, c); ld8f(stab + qpos * 32 + 16 * fi + 8 * hi, sn);
          float o1[8], o2[8];
#pragma unroll
          for (int j = 0; j < 8; ++j) { o1[j] = x1[j] * c[j] - x2[j] * sn[j]; o2[j] = x2[j] * c[j] + x1[j] * sn[j]; }
          qf[8 + fi] = __builtin_bit_cast(bf16x8, pack8(o1)); qf[10 + fi] = __builtin_bit_cast(bf16x8, pack8(o2)); } }
    f32x16 o[4];
#pragma unroll
    for (int db = 0; db < 4; ++db)
#pragma unroll
        for (int r = 0; r < 16; ++r) o[db][r] = 0.f;
    float m_run = -INFINITY, l_run = 0.f;
    const int wave_lim = (J.pos0 + r0) >> 6;
    bf16x8 pb[4]; bool pend = false;
    int vb = 0;
#define PP_SB0 __builtin_amdgcn_sched_barrier(0)
#define PP_RDK(buf, d0_) do { kq[buf][0] = *(const LAS bf16x8*)(kbuf + (d0_) * 2048); kq[buf][1] = *(const LAS bf16x8*)(kbuf + (d0_) * 2048 + 512); } while (0)
#define PP_MMK(buf, d0_) do { s0 = ATT_MFMA(kq[buf][0], qf[d0_], s0); s1 = ATT_MFMA(kq[buf][1], qf[d0_], s1); } while (0)
#define PP_RDV(buf, g, vbuf_) do { _Pragma("unroll") for (int db_ = 0; db_ < 4; ++db_) ka[buf][db_] = *(const LAS bf16x8*)((vbuf_) + (g) * 4096 + db_ * 512); } while (0)
#define PP_MMV(buf, g) do { _Pragma("unroll") for (int db_ = 0; db_ < 4; ++db_) o[db_] = ATT_MFMA(ka[buf][db_], pb[g], o[db_]); } while (0)
#define PP_PV(vbuf_) do { bf16x8 ka[2][4]; PP_SB0; PP_RDV(0, 0, vbuf_); PP_RDV(1, 1, vbuf_); PP_SB0; PP_MMV(0, 0); PP_RDV(0, 2, vbuf_); PP_SB0; PP_MMV(1, 1); PP_RDV(1, 3, vbuf_); PP_SB0; PP_MMV(0, 2); PP_SB0; PP_MMV(1, 3); PP_SB0; } while (0)
    for (int i = 0; i < nt; ++i) {
        asm volatile("s_waitcnt vmcnt(0) lgkmcnt(0)" ::: "memory"); __builtin_amdgcn_s_barrier(); asm volatile("" ::: "memory");
        const int vn = (vb == 2) ? 0 : vb + 1, vp = (vb == 0) ? 2 : vb - 1;
        if (i + 1 < nt) PP_ISSUE(i + 1, (i + 1) & 1, vn);
        LAS unsigned char* kbuf = lds + (i & 1) * PPK + hi * 1024 + r32 * 16;
        LAS unsigned char* vcur = lds + PPV0 + vb * PPV + hi * 2048 + r32 * 16;
        LAS unsigned char* vprv = lds + PPV0 + vp * PPV + hi * 2048 + r32 * 16;
        if (pend) { PP_PV(vprv); pend = false; }
        if (i + J.t0 <= wave_lim) {
            f32x16 s0, s1;
#pragma unroll
            for (int r = 0; r < 16; ++r) { s0[r] = 0.f; s1[r] = 0.f; }
            bf16x8 kq[2][2];
            PP_RDK(0, 0); PP_SB0;
#pragma unroll
            for (int d0 = 0; d0 < NQ; ++d0) { if (d0 + 1 < NQ) PP_RDK((d0 + 1) & 1, d0 + 1); PP_MMK(d0 & 1, d0); PP_SB0; }
            float mx = s0[0];
#pragma unroll
            for (int r = 1; r < 16; ++r) mx = fmaxf(mx, s0[r]);
#pragma unroll
            for (int r = 0; r < 16; ++r) mx = fmaxf(mx, s1[r]);
            mx = fmaxf(mx, __shfl_xor(mx, 32));
            const float mn = fmaxf(m_run, mx), alpha = __builtin_amdgcn_exp2f(m_run - mn); m_run = mn;
            float ls = 0.f;
#pragma unroll
            for (int r = 0; r < 16; ++r) { s0[r] = __builtin_amdgcn_exp2f(s0[r] - mn); s1[r] = __builtin_amdgcn_exp2f(s1[r] - mn); ls += s0[r] + s1[r]; }
            l_run = l_run * alpha + ls;
#pragma unroll
            for (int db = 0; db < 4; ++db)
#pragma unroll
                for (int r = 0; r < 16; ++r) o[db][r] *= alpha;
            { v4u w;
              w.x = pkbf(s0[0], s0[1]); w.y = pkbf(s0[2], s0[3]); w.z = pkbf(s0[4], s0[5]); w.w = pkbf(s0[6], s0[7]); pb[0] = __builtin_bit_cast(bf16x8, w);
              w.x = pkbf(s0[8], s0[9]); w.y = pkbf(s0[10], s0[11]); w.z = pkbf(s0[12], s0[13]); w.w = pkbf(s0[14], s0[15]); pb[1] = __builtin_bit_cast(bf16x8, w);
              w.x = pkbf(s1[0], s1[1]); w.y = pkbf(s1[2], s1[3]); w.z = pkbf(s1[4], s1[5]); w.w = pkbf(s1[6], s1[7]); pb[2] = __builtin_bit_cast(bf16x8, w);
              w.x = pkbf(s1[8], s1[9]); w.y = pkbf(s1[10], s1[11]); w.z = pkbf(s1[12], s1[13]); w.w = pkbf(s1[14], s1[15]); pb[3] = __builtin_bit_cast(bf16x8, w); }
            if (late) pend = true; else { PP_PV(vcur); }
        }
        vb = vn;
    }
    if (pend) { const int vl = (vb == 0) ? 2 : vb - 1; LAS unsigned char* vlast = lds + PPV0 + vl * PPV + hi * 2048 + r32 * 16; PP_PV(vlast); }
    asm volatile("s_waitcnt vmcnt(0) lgkmcnt(0)" ::: "memory");
    { const int r32e = r32, hie = hi;
      const volatile LAS unsigned long long* st = (const volatile LAS unsigned long long*)(lds + ATT_FLAGS + 256);
      bf16* out_ = (bf16*)st[0]; bf16* po_ = (bf16*)st[1]; float* pml_ = (float*)st[2];
      float inv = 1.f; bf16* op = out_ + (size_t)(r0 + r32e) * opitch_ + 4 * hie;
      const float lt = l_run + __shfl_xor(l_run, 32); inv = 1.0f / lt;
      if (po_) { inv = 1.0f; op = po_ + (size_t)(r0 + r32e) * 128 + 4 * hie; if (hie == 0) { float* ml = pml_ + (size_t)(r0 + r32e) * 2; ml[0] = m_run; ml[1] = lt; } }
#pragma unroll
      for (int db = 0; db < 4; ++db)
#pragma unroll
          for (int gq = 0; gq < 4; ++gq) { u32x2v w; w.x = pkbf(o[db][4 * gq] * inv, o[db][4 * gq + 1] * inv); w.y = pkbf(o[db][4 * gq + 2] * inv, o[db][4 * gq + 3] * inv);
              *(u32x2v*)(op + 32 * db + 8 * gq) = w; } }
    __builtin_amdgcn_s_barrier();
#undef PP_ISSUE
#undef PP_SB0
#undef PP_RDK
#undef PP_MMK
#undef PP_RDV
#undef PP_MMV
#undef PP_PV
}

__device__ __forceinline__ void attn_unit_s4(LAS unsigned char* lds, const bf16* qrow0, const unsigned char* kn, const unsigned char* kr, const unsigned char* vt, int nt, float* po, float* pml,
                                             const float* ctab, const float* stab, int wid, int lane) {
    const int r32 = lane & 31, hi = lane >> 5, hs = wid >> 1, r0 = (wid & 1) * 32;
#define S4_ISSUE_K(t) do { const unsigned char* g_ = kn + (size_t)(t) * (8 * 16384) + wid * 8192 + lane * 16; \
        _Pragma("unroll") for (int p_ = 0; p_ < 8; ++p_) ATT_GLDS(g_ + p_ * 1024, wid * 8192 + p_ * 1024); \
        ATT_GLDS(kr + (size_t)(t) * 8192 + wid * 1024 + lane * 16, S4_KR + wid * 1024); } while (0)
#define S4_ISSUE_V(t) do { const unsigned char* g_ = vt + (size_t)(t) * (8 * 16384) + wid * 8192 + lane * 16; \
        _Pragma("unroll") for (int p_ = 0; p_ < 8; ++p_) ATT_GLDS(g_ + p_ * 1024, S4_V + wid * 8192 + p_ * 1024); } while (0)
    S4_ISSUE_K(0);
    bf16x8 qf[12];
    const int qpos = 2048 + r0 + r32;
    { const bf16* qp = qrow0 + (size_t)(r0 + r32) * QW + hs * 192 + 8 * hi;
#pragma unroll
      for (int d0 = 0; d0 < 12; ++d0) qf[d0] = *(const bf16x8*)(qp + 16 * d0);
#pragma unroll
      for (int fi = 0; fi < 2; ++fi) {
          float x1[8], x2[8], c[8], sn[8]; unpack8(__builtin_bit_cast(v4u, qf[8 + fi]), x1); unpack8(__builtin_bit_cast(v4u, qf[10 + fi]), x2);
          ld8f(ctab + qpos * 32 + 16 * fi + 8 * hi, c); ld8f(stab + qpos * 32 + 16 * fi + 8 * hi, sn);
          float o1[8], o2[8];
#pragma unroll
          for (int j = 0; j < 8; ++j) { o1[j] = x1[j] * c[j] - x2[j] * sn[j]; o2[j] = x2[j] * c[j] + x1[j] * sn[j]; }
          qf[8 + fi] = __builtin_bit_cast(bf16x8, pack8(o1)); qf[10 + fi] = __builtin_bit_cast(bf16x8, pack8(o2)); } }
    f32x16 o[4];
#pragma unroll
    for (int db = 0; db < 4; ++db)
#pragma unroll
        for (int r = 0; r < 16; ++r) o[db][r] = 0.f;
    float m_run = -INFINITY, l_run = 0.f;
    LAS unsigned char* kbuf = lds + hs * 16384 + hi * 1024 + r32 * 16;
    LAS unsigned char* krbuf = lds + S4_KR + hi * 1024 + r32 * 16;
    LAS unsigned char* vbuf = lds + S4_V + hs * 16384 + hi * 2048 + r32 * 16;
    for (int i = 0; i < nt; ++i) {
        asm volatile("s_waitcnt vmcnt(0) lgkmcnt(0)" ::: "memory"); __builtin_amdgcn_s_barrier(); asm volatile("" ::: "memory");
        S4_ISSUE_V(i);
        f32x16 s0, s1;
#pragma unroll
        for (int r = 0; r < 16; ++r) { s0[r] = 0.f; s1[r] = 0.f; }
        bf16x8 ka[2][4];
#define S4_RDK(buf, dbase) do { _Pragma("unroll") for (int j_ = 0; j_ < 2; ++j_) { LAS unsigned char* kb_ = ((dbase) + j_) < 8 ? kbuf + ((dbase) + j_) * 2048 : krbuf + ((dbase) + j_ - 8) * 2048; \
            ka[buf][2 * j_] = *(const LAS bf16x8*)(kb_); ka[buf][2 * j_ + 1] = *(const LAS bf16x8*)(kb_ + 512); } } while (0)
#define S4_MMK(buf, dbase) do { _Pragma("unroll") for (int j_ = 0; j_ < 2; ++j_) { s0 = ATT_MFMA(ka[buf][2 * j_], qf[(dbase) + j_], s0); s1 = ATT_MFMA(ka[buf][2 * j_ + 1], qf[(dbase) + j_], s1); } } while (0)
#define S4_RDV(buf, g) do { _Pragma("unroll") for (int db_ = 0; db_ < 4; ++db_) ka[buf][db_] = *(const LAS bf16x8*)(vbuf + (g) * 4096 + db_ * 512); } while (0)
#define S4_MMV(buf, g) do { _Pragma("unroll") for (int db_ = 0; db_ < 4; ++db_) o[db_] = ATT_MFMA(ka[buf][db_], pb[g], o[db_]); } while (0)
#define S4_SB0 __builtin_amdgcn_sched_barrier(0)
        S4_RDK(0, 0); S4_SB0;
        S4_RDK(1, 2); S4_MMK(0, 0); S4_SB0;
        S4_RDK(0, 4); S4_MMK(1, 2); S4_SB0;
        S4_RDK(1, 6); S4_MMK(0, 4); S4_SB0;
        S4_RDK(0, 8); S4_MMK(1, 6); S4_SB0;
        S4_RDK(1, 10); S4_MMK(0, 8); S4_SB0;
        S4_MMK(1, 10); S4_SB0;
        float mx = s0[0];
#pragma unroll
        for (int r = 1; r < 16; ++r) mx = fmaxf(mx, s0[r]);
#pragma unroll
        for (int r = 0; r < 16; ++r) mx = fmaxf(mx, s1[r]);
        mx = fmaxf(mx, __shfl_xor(mx, 32));
        const float mn = fmaxf(m_run, mx), alpha = __builtin_amdgcn_exp2f(m_run - mn); m_run = mn;
        float ls = 0.f;
#pragma unroll
        for (int r = 0; r < 16; ++r) { s0[r] = __builtin_amdgcn_exp2f(s0[r] - mn); s1[r] = __builtin_amdgcn_exp2f(s1[r] - mn); ls += s0[r] + s1[r]; }
        l_run = l_run * alpha + ls;
#pragma unroll
        for (int db = 0; db < 4; ++db)
#pragma unroll
            for (int r = 0; r < 16; ++r) o[db][r] *= alpha;
        bf16x8 pb[4];
        { v4u w;
          w.x = pkbf(s0[0], s0[1]); w.y = pkbf(s0[2], s0[3]); w.z = pkbf(s0[4], s0[5]); w.w = pkbf(s0[6], s0[7]); pb[0] = __builtin_bit_cast(bf16x8, w);
          w.x = pkbf(s0[8], s0[9]); w.y = pkbf(s0[10], s0[11]); w.z = pkbf(s0[12], s0[13]); w.w = pkbf(s0[14], s0[15]); pb[1] = __builtin_bit_cast(bf16x8, w);
          w.x = pkbf(s1[0], s1[1]); w.y = pkbf(s1[2], s1[3]); w.z = pkbf(s1[4], s1[5]); w.w = pkbf(s1[6], s1[7]); pb[2] = __builtin_bit_cast(bf16x8, w);
          w.x = pkbf(s1[8], s1[9]); w.y = pkbf(s1[10], s1[11]); w.z = pkbf(s1[12], s1[13]); w.w = pkbf(s1[14], s1[15]); pb[3] = __builtin_bit_cast(bf16x8, w); }
        asm volatile("s_waitcnt vmcnt(0) lgkmcnt(0)" ::: "memory"); __builtin_amdgcn_s_barrier(); asm volatile("" ::: "memory");
        if (i + 1 < nt) S4_ISSUE_K(i + 1);
        S4_SB0;
        S4_RDV(0, 0); S4_RDV(1, 1); S4_SB0;
        S4_MMV(0, 0); S4_RDV(0, 2); S4_SB0;
        S4_MMV(1, 1); S4_RDV(1, 3); S4_SB0;
        S4_MMV(0, 2); S4_SB0;
        S4_MMV(1, 3);
#undef S4_RDK
#undef S4_MMK
#undef S4_RDV
#undef S4_MMV
#undef S4_SB0
    }
    asm volatile("s_waitcnt vmcnt(0) lgkmcnt(0)" ::: "memory");
    { const float lt = l_run + __shfl_xor(l_run, 32);
      float* pp = po + ((size_t)hs * 3 * 64 + (r0 + r32)) * 128 + 4 * hi;
#pragma unroll
      for (int db = 0; db < 4; ++db)
#pragma unroll
          for (int gq = 0; gq < 4; ++gq) *(f32x4*)(pp + 32 * db + 8 * gq) = (f32x4){o[db][4 * gq], o[db][4 * gq + 1], o[db][4 * gq + 2], o[db][4 * gq + 3]};
      if (hi == 0) { float* ml = pml + ((size_t)hs * 3 * 64 + (r0 + r32)) * 2; ml[0] = m_run; ml[1] = lt; } }
    __builtin_amdgcn_s_barrier();
#undef S4_ISSUE_K
#undef S4_ISSUE_V
}

__device__ __forceinline__ int queue_next(Frame& F, gu32* head) {
    volatile LAS unsigned* w = (volatile LAS unsigned*)(F.lds + ATT_QWORD);
    if (F.tid == 0) *w = __hip_atomic_fetch_add(head, 1u, RLX_AGENT);
    LDS_WAIT(); __syncthreads();
    const int v = (int)*w;
    LDS_WAIT(); __syncthreads();
    return v;
}

constexpr int MLA_NITEMS = 416;
__constant__ unsigned mla_items[MLA_NITEMS][2] = {
{0x6002c0u, 0xffffu}, {0x6002c2u, 0xffffu}, {0x6002c4u, 0xffffu}, {0x6002c6u, 0xffffu}, {0x6002c8u, 0xffffu}, {0x6002cau, 0xffffu}, {0x6002ccu, 0xffffu}, {0x6002ceu, 0xffffu},
{0x6002d0u, 0xffffu}, {0x6002d2u, 0xffffu}, {0x6002d4u, 0xffffu}, {0x6002d6u, 0xffffu}, {0x6002d8u, 0xffffu}, {0x6002dau, 0xffffu}, {0x6002dcu, 0xffffu}, {0x6002deu, 0xffffu},
{0x580280u, 0xffffu}, {0x580282u, 0xffffu}, {0x580284u, 0xffffu}, {0x580286u, 0xffffu}, {0x580288u, 0xffffu}, {0x58028au, 0xffffu}, {0x58028cu, 0xffffu}, {0x58028eu, 0xffffu},
{0x580290u, 0xffffu}, {0x580292u, 0xffffu}, {0x580294u, 0xffffu}, {0x580296u, 0xffffu}, {0x580298u, 0xffffu}, {0x58029au, 0xffffu}, {0x58029cu, 0xffffu}, {0x58029eu, 0xffffu},
{0x500240u, 0xffffu}, {0x500242u, 0xffffu}, {0x500244u, 0xffffu}, {0x500246u, 0xffffu}, {0x500248u, 0xffffu}, {0x50024au, 0xffffu}, {0x50024cu, 0xffffu}, {0x50024eu, 0xffffu},
{0x500250u, 0xffffu}, {0x500252u, 0xffffu}, {0x500254u, 0xffffu}, {0x500256u, 0xffffu}, {0x500258u, 0xffffu}, {0x50025au, 0xffffu}, {0x50025cu, 0xffffu}, {0x50025eu, 0xffffu},
{0x480200u, 0xffffu}, {0x480202u, 0xffffu}, {0x480204u, 0xffffu}, {0x480206u, 0xffffu}, {0x480208u, 0xffffu}, {0x48020au, 0xffffu}, {0x48020cu, 0xffffu}, {0x48020eu, 0xffffu},
{0x480210u, 0xffffu}, {0x480212u, 0xffffu}, {0x480214u, 0xffffu}, {0x480216u, 0xffffu}, {0x480218u, 0xffffu}, {0x48021au, 0xffffu}, {0x48021cu, 0xffffu}, {0x48021eu, 0xffffu},
{0x4001c0u, 0xffffu}, {0x4001c2u, 0xffffu}, {0x4001c4u, 0xffffu}, {0x4001c6u, 0xffffu}, {0x4001c8u, 0xffffu}, {0x4001cau, 0xffffu}, {0x4001ccu, 0xffffu}, {0x4001ceu, 0xffffu},
{0x4001d0u, 0xffffu}, {0x4001d2u, 0xffffu}, {0x4001d4u, 0xffffu}, {0x4001d6u, 0xffffu}, {0x4001d8u, 0xffffu}, {0x4001dau, 0xffffu}, {0x4001dcu, 0xffffu}, {0x4001deu, 0xffffu},
{0x4003c0u, 0x6u}, {0x4083c0u, 0x7u}, {0x4003c2u, 0xeu}, {0x4083c2u, 0xfu}, {0x4003c4u, 0x16u}, {0x4083c4u, 0x17u}, {0x4003c6u, 0x1eu}, {0x4083c6u, 0x1fu},
{0x4003c8u, 0x26u}, {0x4083c8u, 0x27u}, {0x4003cau, 0x2eu}, {0x4083cau, 0x2fu}, {0x4003ccu, 0x36u}, {0x4083ccu, 0x37u}, {0x4003ceu, 0x3eu}, {0x4083ceu, 0x3fu},
{0x4003d0u, 0x46u}, {0x4083d0u, 0x47u}, {0x4003d2u, 0x4eu}, {0x4083d2u, 0x4fu}, {0x4003d4u, 0x56u}, {0x4083d4u, 0x57u}, {0x4003d6u, 0x5eu}, {0x4083d6u, 0x5fu},
{0x4003d8u, 0x66u}, {0x4083d8u, 0x67u}, {0x4003dau, 0x6eu}, {0x4083dau, 0x6fu}, {0x4003dcu, 0x76u}, {0x4083dcu, 0x77u}, {0x4003deu, 0x7eu}, {0x4083deu, 0x7fu},
{0x3c0380u, 0x4u}, {0x3c7b80u, 0x5u}, {0x3c0382u, 0xcu}, {0x3c7b82u, 0xdu}, {0x3c0384u, 0x14u}, {0x3c7b84u, 0x15u}, {0x3c0386u, 0x1cu}, {0x3c7b86u, 0x1du},
{0x3c0388u, 0x24u}, {0x3c7b88u, 0x25u}, {0x3c038au, 0x2cu}, {0x3c7b8au, 0x2du}, {0x3c038cu, 0x34u}, {0x3c7b8cu, 0x35u}, {0x3c038eu, 0x3cu}, {0x3c7b8eu, 0x3du},
{0x3c0390u, 0x44u}, {0x3c7b90u, 0x45u}, {0x3c0392u, 0x4cu}, {0x3c7b92u, 0x4du}, {0x3c0394u, 0x54u}, {0x3c7b94u, 0x55u}, {0x3c0396u, 0x5cu}, {0x3c7b96u, 0x5du},
{0x3c0398u, 0x64u}, {0x3c7b98u, 0x65u}, {0x3c039au, 0x6cu}, {0x3c7b9au, 0x6du}, {0x3c039cu, 0x74u}, {0x3c7b9cu, 0x75u}, {0x3c039eu, 0x7cu}, {0x3c7b9eu, 0x7du},
{0x380180u, 0xffffu}, {0x380182u, 0xffffu}, {0x380184u, 0xffffu}, {0x380186u, 0xffffu}, {0x380188u, 0xffffu}, {0x38018au, 0xffffu}, {0x38018cu, 0xffffu}, {0x38018eu, 0xffffu},
{0x380190u, 0xffffu}, {0x380192u, 0xffffu}, {0x380194u, 0xffffu}, {0x380196u, 0xffffu}, {0x380198u, 0xffffu}, {0x38019au, 0xffffu}, {0x38019cu, 0xffffu}, {0x38019eu, 0xffffu},
{0x380340u, 0x2u}, {0x387340u, 0x3u}, {0x380342u, 0xau}, {0x387342u, 0xbu}, {0x380344u, 0x12u}, {0x387344u, 0x13u}, {0x380346u, 0x1au}, {0x387346u, 0x1bu},
{0x380348u, 0x22u}, {0x387348u, 0x23u}, {0x38034au, 0x2au}, {0x38734au, 0x2bu}, {0x38034cu, 0x32u}, {0x38734cu, 0x33u}, {0x38034eu, 0x3au}, {0x38734eu, 0x3bu},
{0x380350u, 0x42u}, {0x387350u, 0x43u}, {0x380352u, 0x4au}, {0x387352u, 0x4bu}, {0x380354u, 0x52u}, {0x387354u, 0x53u}, {0x380356u, 0x5au}, {0x387356u, 0x5bu},
{0x380358u, 0x62u}, {0x387358u, 0x63u}, {0x38035au, 0x6au}, {0x38735au, 0x6bu}, {0x38035cu, 0x72u}, {0x38735cu, 0x73u}, {0x38035eu, 0x7au}, {0x38735eu, 0x7bu},
{0x340300u, 0x0u}, {0x346b00u, 0x1u}, {0x340302u, 0x8u}, {0x346b02u, 0x9u}, {0x340304u, 0x10u}, {0x346b04u, 0x11u}, {0x340306u, 0x18u}, {0x346b06u, 0x19u},
{0x340308u, 0x20u}, {0x346b08u, 0x21u}, {0x34030au, 0x28u}, {0x346b0au, 0x29u}, {0x34030cu, 0x30u}, {0x346b0cu, 0x31u}, {0x34030eu, 0x38u}, {0x346b0eu, 0x39u},
{0x340310u, 0x40u}, {0x346b10u, 0x41u}, {0x340312u, 0x48u}, {0x346b12u, 0x49u}, {0x340314u, 0x50u}, {0x346b14u, 0x51u}, {0x340316u, 0x58u}, {0x346b16u, 0x59u},
{0x340318u, 0x60u}, {0x346b18u, 0x61u}, {0x34031au, 0x68u}, {0x346b1au, 0x69u}, {0x34031cu, 0x70u}, {0x346b1cu, 0x71u}, {0x34031eu, 0x78u}, {0x346b1eu, 0x79u},
{0x300140u, 0xffffu}, {0x300142u, 0xffffu}, {0x300144u, 0xffffu}, {0x300146u, 0xffffu}, {0x300148u, 0xffffu}, {0x30014au, 0xffffu}, {0x30014cu, 0xffffu}, {0x30014eu, 0xffffu},
{0x300150u, 0xffffu}, {0x300152u, 0xffffu}, {0x300154u, 0xffffu}, {0x300156u, 0xffffu}, {0x300158u, 0xffffu}, {0x30015au, 0xffffu}, {0x30015cu, 0xffffu}, {0x30015eu, 0xffffu},
{0x280100u, 0xffffu}, {0x280102u, 0xffffu}, {0x280104u, 0xffffu}, {0x280106u, 0xffffu}, {0x280108u, 0xffffu}, {0x28010au, 0xffffu}, {0x28010cu, 0xffffu}, {0x28010eu, 0xffffu},
{0x280110u, 0xffffu}, {0x280112u, 0xffffu}, {0x280114u, 0xffffu}, {0x280116u, 0xffffu}, {0x280118u, 0xffffu}, {0x28011au, 0xffffu}, {0x28011cu, 0xffffu}, {0x28011eu, 0xffffu},
{0x2000c0u, 0xffffu}, {0x2000c2u, 0xffffu}, {0x2000c4u, 0xffffu}, {0x2000c6u, 0xffffu}, {0x2000c8u, 0xffffu}, {0x2000cau, 0xffffu}, {0x2000ccu, 0xffffu}, {0x2000ceu, 0xffffu},
{0x2000d0u, 0xffffu}, {0x2000d2u, 0xffffu}, {0x2000d4u, 0xffffu}, {0x2000d6u, 0xffffu}, {0x2000d8u, 0xffffu}, {0x2000dau, 0xffffu}, {0x2000dcu, 0xffffu}, {0x2000deu, 0xffffu},
{0x180080u, 0xffffu}, {0x180082u, 0xffffu}, {0x180084u, 0xffffu}, {0x180086u, 0xffffu}, {0x180088u, 0xffffu}, {0x18008au, 0xffffu}, {0x18008cu, 0xffffu}, {0x18008eu, 0xffffu},
{0x180090u, 0xffffu}, {0x180092u, 0xffffu}, {0x180094u, 0xffffu}, {0x180096u, 0xffffu}, {0x180098u, 0xffffu}, {0x18009au, 0xffffu}, {0x18009cu, 0xffffu}, {0x18009eu, 0xffffu},
{0x160001u, 0x0u}, {0x160041u, 0x0u}, {0x160081u, 0x0u}, {0x160003u, 0x0u}, {0x160043u, 0x0u}, {0x160083u, 0x0u}, {0x160005u, 0x0u}, {0x160045u, 0x0u},
{0x160085u, 0x0u}, {0x160007u, 0x0u}, {0x160047u, 0x0u}, {0x160087u, 0x0u}, {0x160009u, 0x0u}, {0x160049u, 0x0u}, {0x160089u, 0x0u}, {0x16000bu, 0x0u},
{0x16004bu, 0x0u}, {0x16008bu, 0x0u}, {0x16000du, 0x0u}, {0x16004du, 0x0u}, {0x16008du, 0x0u}, {0x16000fu, 0x0u}, {0x16004fu, 0x0u}, {0x16008fu, 0x0u},
{0x160011u, 0x0u}, {0x160051u, 0x0u}, {0x160091u, 0x0u}, {0x160013u, 0x0u}, {0x160053u, 0x0u}, {0x160093u, 0x0u}, {0x160015u, 0x0u}, {0x160055u, 0x0u},
{0x160095u, 0x0u}, {0x160017u, 0x0u}, {0x160057u, 0x0u}, {0x160097u, 0x0u}, {0x160019u, 0x0u}, {0x160059u, 0x0u}, {0x160099u, 0x0u}, {0x16001bu, 0x0u},
{0x16005bu, 0x0u}, {0x16009bu, 0x0u}, {0x16001du, 0x0u}, {0x16005du, 0x0u}, {0x16009du, 0x0u}, {0x16001fu, 0x0u}, {0x16005fu, 0x0u}, {0x16009fu, 0x0u},
{0x160021u, 0x0u}, {0x160061u, 0x0u}, {0x1600a1u, 0x0u}, {0x160023u, 0x0u}, {0x160063u, 0x0u}, {0x1600a3u, 0x0u}, {0x160025u, 0x0u}, {0x160065u, 0x0u},
{0x1600a5u, 0x0u}, {0x160027u, 0x0u}, {0x160067u, 0x0u}, {0x1600a7u, 0x0u}, {0x160029u, 0x0u}, {0x160069u, 0x0u}, {0x1600a9u, 0x0u}, {0x16002bu, 0x0u},
{0x16006bu, 0x0u}, {0x1600abu, 0x0u}, {0x16002du, 0x0u}, {0x16006du, 0x0u}, {0x1600adu, 0x0u}, {0x16002fu, 0x0u}, {0x16006fu, 0x0u}, {0x1600afu, 0x0u},
{0x160031u, 0x0u}, {0x160071u, 0x0u}, {0x1600b1u, 0x0u}, {0x160033u, 0x0u}, {0x160073u, 0x0u}, {0x1600b3u, 0x0u}, {0x160035u, 0x0u}, {0x160075u, 0x0u},
{0x1600b5u, 0x0u}, {0x160037u, 0x0u}, {0x160077u, 0x0u}, {0x1600b7u, 0x0u}, {0x160039u, 0x0u}, {0x160079u, 0x0u}, {0x1600b9u, 0x0u}, {0x16003bu, 0x0u},
{0x16007bu, 0x0u}, {0x1600bbu, 0x0u}, {0x16003du, 0x0u}, {0x16007du, 0x0u}, {0x1600bdu, 0x0u}, {0x16003fu, 0x0u}, {0x16007fu, 0x0u}, {0x1600bfu, 0x0u},
{0x100040u, 0xffffu}, {0x100042u, 0xffffu}, {0x100044u, 0xffffu}, {0x100046u, 0xffffu}, {0x100048u, 0xffffu}, {0x10004au, 0xffffu}, {0x10004cu, 0xffffu}, {0x10004eu, 0xffffu},
{0x100050u, 0xffffu}, {0x100052u, 0xffffu}, {0x100054u, 0xffffu}, {0x100056u, 0xffffu}, {0x100058u, 0xffffu}, {0x10005au, 0xffffu}, {0x10005cu, 0xffffu}, {0x10005eu, 0xffffu},
{0x80000u, 0xffffu}, {0x80002u, 0xffffu}, {0x80004u, 0xffffu}, {0x80006u, 0xffffu}, {0x80008u, 0xffffu}, {0x8000au, 0xffffu}, {0x8000cu, 0xffffu}, {0x8000eu, 0xffffu},
{0x80010u, 0xffffu}, {0x80012u, 0xffffu}, {0x80014u, 0xffffu}, {0x80016u, 0xffffu}, {0x80018u, 0xffffu}, {0x8001au, 0xffffu}, {0x8001cu, 0xffffu}, {0x8001eu, 0xffffu} };
__device__ __forceinline__ void attention_phase(Frame& F, int l, int rep) {
    unsigned char* ws = PWS(); unsigned char* cl = ws + WS_C + (size_t)l * C_LAYER;
    const float* ctab = (const float*)(ws + WS_ROPE); const float* stab = ctab + 4096 * 32;
    const bf16* Q = (const bf16*)(ws + WS_Q); const bf16* Z = (const bf16*)(ws + WS_Z); bf16* Y = (bf16*)(ws + WS_YATT);
    const unsigned char* KN = ws + WS_KN; const unsigned char* VT = ws + WS_VT; const unsigned char* KR = cl + C_KR; const unsigned char* KSB = cl + C_KSB; const unsigned char* VTSB = cl + C_VTSB;
    if (rep == 0 || ((DUPM >> 14) & 1u))
    { gu32* head = F.ctl + CW_QUEUE + 64 * (2 * l + 4 * rep);
      float* PO = (float*)(ws + WS_PO); float* PML = (float*)(ws + WS_PML);
      bf16* PO16 = (bf16*)(ws + WS_PO16); float* PML16 = (float*)(ws + WS_PML16);
      for (;;) { const int id = queue_next(F, head); if (id >= MLA_NITEMS) break;
          const unsigned w0 = mla_items[id][0], w1 = mla_items[id][1];
          if ((w0 & 1u) == 0u) { AttnJob J; J.kc = nullptr; J.vc = nullptr; J.ncache = 0;
              const int bh = (w0 >> 1) & 31, qb = (w0 >> 6) & 15, t0 = (w0 >> 10) & 127, ntl = (w0 >> 17) & 127, b = bh >> 3, h = bh & 7, row0 = b * 4096 + 256 * qb, tile0 = b * 64 + t0;
              J.nrows = 256; J.pos0 = 256 * qb; J.ntiles = ntl; J.t0 = t0; J.po = nullptr; J.pml = nullptr;
              if (w1 != 0xffffu) { J.po = PO16 + (size_t)w1 * 256 * 128; J.pml = PML16 + (size_t)w1 * 256 * 2; }
              J.q = Q + (size_t)row0 * QW + h * 192; J.qpitch = QW;
              J.kA = KN + ((size_t)tile0 * 8 + h) * 16384; J.kA_ts = 8 * 16384; J.kB = KR + (size_t)tile0 * 8192; J.kB_ts = 8192; J.vt = VT + ((size_t)tile0 * 8 + h) * 16384; J.vt_ts = 8 * 16384;
              J.out = Y + (size_t)row0 * YW + h * 128; J.opitch = YW;
              int ln_ = F.lane; asm volatile("" : "+v"(ln_));
              attn_unit_pp(F.lds, J, ctab, stab, F.wave, ln_); }
          else { const int sg = (w0 >> 1) & 31, part = (w0 >> 6) & 15, sI = sg >> 1, hg = sg & 1, tile0 = 128 + 33 * sI + 11 * part;
              const size_t pu = (size_t)((sI * 8 + 4 * hg) * 3 + part);
              int ln_ = F.lane; asm volatile("" : "+v"(ln_));
              attn_unit_s4(F.lds, Q + (size_t)(TP + 64 * sI) * QW + 4 * hg * 192, KN + ((size_t)tile0 * 8 + 4 * hg) * 16384, KR + (size_t)tile0 * 8192, VT + ((size_t)tile0 * 8 + 4 * hg) * 16384, 11,
                           PO + pu * 64 * 128, PML + pu * 64 * 2, ctab, stab, F.wave, ln_); } } }
    if (rep == 0 || ((DUPM >> 15) & 1u))
    { gu32* head = F.ctl + CW_QUEUE + 64 * (2 * l + 1 + 4 * rep);
      for (;;) { const int id = queue_next(F, head); if (id >= 192) break;
          AttnJob J; int row0, tile0, h; J.kc = nullptr; J.vc = nullptr; J.ncache = 0; J.t0 = 0; J.po = nullptr; J.pml = nullptr;
          if (id < 128) { const int qb = 15 - (id >> 3), b = (id >> 2) & 1; h = id & 3; row0 = b * 4096 + 256 * qb; tile0 = b * 64; J.nrows = 256; J.pos0 = 256 * qb; J.ntiles = 4 * qb + 4; }
          else { const int u = id - 128, s = u >> 2; h = u & 3; row0 = TP + 64 * s; tile0 = 128 + 33 * s; J.nrows = 64; J.pos0 = 2048; J.ntiles = 33;
              J.kc = PIN(4) + ((size_t)(l * 16 + s) * 2048) * 512 + h * 128; J.vc = PIN(5) + ((size_t)(l * 16 + s) * 2048) * 512 + h * 128; J.ncache = 32; }
          J.q = Z + (size_t)row0 * DINP + ZC_QSB + h * 128; J.qpitch = DINP;
          J.kA = KSB + ((size_t)tile0 * 4 + h) * 16384; J.kA_ts = 4 * 16384; J.kB = nullptr; J.kB_ts = 0; J.vt = VTSB + ((size_t)tile0 * 4 + h) * 16384; J.vt_ts = 4 * 16384;
          J.out = Y + (size_t)row0 * YW + 1024 + h * 128; J.opitch = YW;
          int ln_ = F.lane; asm volatile("" : "+v"(ln_));
          attn_unit<true>(F.lds, J, ctab, stab, F.wave, ln_); } }
}

#ifndef MK_SPLIT
#define MK_SPLIT 0
#endif
constexpr int NPH = 1 + 13 * DEPTH;
using EVtSb = pg8::EpiVtBlk<true, 4>; using EVtMla = pg8::EpiVtBlk<false, 8>; using EKnMla = pg8::EpiKBlk<8>;
__global__ void __launch_bounds__(NWAVES * 64, 2) fwd_kernel(Args args) {
    extern __shared__ __attribute__((aligned(16))) unsigned char lds_raw[];
    Frame F;
    F.lds = (LAS unsigned char*)lds_raw;
    F.MISC = (volatile LAS unsigned*)(F.lds + MISC_OFF);
    F.tid = threadIdx.x; F.lane = F.tid & 63; F.wave = __builtin_amdgcn_readfirstlane(F.tid >> 6);
    const int G = gridDim.x; const int vcu = (G % 8 == 0) ? ((int)blockIdx.x % 8) * (G / 8) + (int)blockIdx.x / 8 : (int)blockIdx.x;
    F.gw = vcu * NWAVES + F.wave; F.ngw = G * NWAVES;
    F.ctl = (gu32*)(args.ws + WS_CTL);
    { LAS unsigned long long* pp = (LAS unsigned long long*)(F.lds + PARAM_OFF);
      if (F.tid == 0) {
#pragma unroll
          for (int k = 0; k < 30; ++k) pp[k] = (unsigned long long)args.in[k];
          pp[30] = (unsigned long long)args.out; pp[31] = (unsigned long long)args.ws; } }
    for (int u = F.tid; u < 64; u += NWAVES * 64) ((LAS unsigned*)(F.lds + MISC_OFF))[u] = 0u;
    __syncthreads();
    XcdBarrier bar; bar.bar = (unsigned*)(F.ctl + CW_BAR); bar.x = 0; bar.st = nullptr;
    if (!MK_SPLIT) bar = xcd_barrier_post((unsigned*)(F.ctl + CW_BAR), F.MISC + 8);
    const int lo = args.ph_lo, hi = args.ph_hi;
#ifndef PHM
#define PHM 0xFFFFFFFFu
#endif
#define EN(j) ((PHM >> (j)) & 1u)
#define NREP(j) (((DUPM >> (j)) & 1u) ? 3 : 1)
#define IN(k) (lo <= (k) && (k) < hi)
#define SEAM(k) do { if (IN((k) + 1)) xcd_barrier(bar); } while (0)
#define LAUNDER() asm volatile("" : "+v"(F.tid), "+v"(F.lane), "+s"(F.wave), "+s"(F.gw))
#define WL() (PWS() + WS_W + (size_t)l * W_LAYER)
#define CL() (PWS() + WS_C + (size_t)l * C_LAYER)
#define GEMM_CALL(EPI, AP, BP, MM, NN, KK, EOBJ) do { int bid_ = (int)blockIdx.x; asm volatile("" : "+s"(bid_)); pg8::Gemm g{(const bf16*)(AP), (const bf16*)(BP), (MM), (NN), (KK)}; pg8::StaticOrder S; S.init((MM), (NN), (KK), (int)gridDim.x, bid_); \
        pg8::gemm_phase<EPI, pg8::StaticOrder, true, true>(F.lds, g, S, (EOBJ)); } while (0)
#define GEMM_CALL_I8(EPI, AP, BP, MM, NN, KK, EOBJ) do { int bid_ = (int)blockIdx.x; asm volatile("" : "+s"(bid_)); pg8::Gemm g{(const bf16*)(AP), (const bf16*)(BP), (MM), (NN), (KK)}; pg8::StaticOrder S; S.init((MM), (NN), (KK), (int)gridDim.x, bid_); \
        pg8::gemm_phase<EPI, pg8::StaticOrder, true, true, true>(F.lds, g, S, (EOBJ)); } while (0)
#define GEMM_CALL_SUB(EPI, AP, BP, MM, NN, KK, EOBJ, C0, CIDX, I0, I1) do { int bid_ = (int)blockIdx.x; asm volatile("" : "+s"(bid_)); pg8::Gemm g{(const bf16*)(AP), (const bf16*)(BP), (MM), (NN), (KK)}; pg8::SubsetOrder S; \
        S.init((MM), (NN), (KK), (int)gridDim.x, (CIDX), (C0), (I0), (I1)); pg8::gemm_phase<EPI, pg8::SubsetOrder, true, true>(F.lds, g, S, (EOBJ)); } while (0)
#define GEMM_CALL_NEW(EPI, ROWS, AP, BP, MM, NN, KK, EOBJ, ROT) do { int bid_ = (int)blockIdx.x; asm volatile("" : "+s"(bid_)); bid_ = (bid_ + (int)gridDim.x - (ROT)) % (int)gridDim.x; pg8::Gemm g{(const bf16*)(AP), (const bf16*)(BP), (MM), (NN), (KK)}; pg8::NewKeyOrder<ROWS> S; S.init((MM), (NN), (KK), (int)gridDim.x, bid_); \
        pg8::gemm_phase<EPI, pg8::NewKeyOrder<ROWS>, true, true>(F.lds, g, S, (EOBJ)); } while (0)
#define GEMM_CALL_SK(EPI, AP, BP, MM, NN, KK, EOBJ) do { pg8::Gemm g{(const bf16*)(AP), (const bf16*)(BP), (MM), (NN), (KK)}; int bid_ = (int)blockIdx.x; asm volatile("" : "+s"(bid_)); pg8::TailSplitOrder S; S.init((MM), (NN), (KK), (int)gridDim.x, bid_); \
        pg8::gemm_phase<EPI, pg8::TailSplitOrder, true, true>(F.lds, g, S, (EOBJ)); } while (0)
    if (EN(13) && IN(0)) for (int rep = 0; rep < NREP(13); ++rep) { LAUNDER(); p0_prologue(F); LAUNDER(); __syncthreads(); quant_strips(F); SEAM(0); }
    for (int l = 0; l < DEPTH; ++l) {
        const int pb = 1 + 13 * l;
        if (EN(0) && IN(pb + 0)) for (int rep = 0; rep < NREP(0); ++rep) { LAUNDER();
            { unsigned char* ws = PWS(); pg8::EpiSwiGLUi8 E{(bf16*)(ws + WS_HID), DFF, (const float*)(ws + WS_RS), (const float*)(ws + WS_CS) + (size_t)(l * 2) * 2 * DFF};
              GEMM_CALL_I8(pg8::EpiSwiGLUi8, ws + WS_HB8, WL() + W_GU1, MT, 2 * DFF, DM / 2, E); }
            { unsigned char* ws = PWS(); EKnMla E{ws + WS_KN, 32}; GEMM_CALL_SUB(EKnMla, CL() + C_CKV + (size_t)8192 * 512 * 2, WL() + W_UKV, NKEY - 8192, 1024, 512, E, 48, bid_, 0, 2); }
            SEAM(pb + 0); }
        if (EN(1) && IN(pb + 1)) for (int rep = 0; rep < NREP(1); ++rep) { LAUNDER(); unsigned char* ws = PWS(); pg8::EpiFmix E{(bf16*)(ws + WS_F), (bf16*)(ws + WS_F1), DM, DFF / 64}; GEMM_CALL_SK(pg8::EpiFmix, ws + WS_HID, WL() + W_D1, MT, DM, DFF, E); SEAM(pb + 1); }
        if (EN(2) && IN(pb + 2)) { LAUNDER(); unsigned char* ws = PWS(); bf16* HB = (bf16*)(ws + WS_HB);
            if (l == 0) norm_phase<true, false>(F, (const bf16*)(ws + WS_F), (const bf16*)(ws + WS_F1), PIN(0), PIN(1), 0.5f, PIN(11) + l * DM, (float*)(ws + WS_RS), HB);
            else norm_phase<false, false>(F, (const bf16*)(ws + WS_F), (const bf16*)(ws + WS_F1), HB, nullptr, 0.5f, PIN(11) + l * DM, (float*)(ws + WS_RS), HB);
            SEAM(pb + 2); }
        if (EN(3) && IN(pb + 3)) for (int rep = 0; rep < NREP(3); ++rep) { LAUNDER();
            { unsigned char* ws = PWS(); pg8::EpiBf16 E{(bf16*)(ws + WS_Z), DINP, (const float*)(ws + WS_RS)}; GEMM_CALL(pg8::EpiBf16, ws + WS_HB, WL() + W_IN, MT, DINP, DM, E); }
            { unsigned char* ws = PWS(); EVtMla E{ws + WS_VT, 32}; int bid_ = (int)blockIdx.x; asm volatile("" : "+s"(bid_));
              pg8::Gemm g{(const bf16*)(WL() + W_UKV + (size_t)1024 * 512 * 2), (const bf16*)(CL() + C_CKV + (size_t)8192 * 512 * 2), 1024, NKEY - 8192, 512};
              pg8::PastPanelOrder S; S.init(1024, 116 * 256, 512, (int)gridDim.x, bid_, 100); pg8::gemm_phase<EVtMla, pg8::PastPanelOrder, true, true>(F.lds, g, S, E); }
            SEAM(pb + 3); }
        if (EN(4) && IN(pb + 4)) for (int rep = 0; rep < NREP(4); ++rep) { LAUNDER(); postz_phase(F, l); SEAM(pb + 4); }
        if (EN(5) && IN(pb + 5)) for (int rep = 0; rep < NREP(5); ++rep) { LAUNDER();
            { unsigned char* ws = PWS(); pg8::EpiBf16 E{(bf16*)(ws + WS_Q), QW, nullptr}; GEMM_CALL(pg8::EpiBf16, ws + WS_CQN, WL() + W_UQ, MT, QW, 512, E); }
            { unsigned char* ws = PWS(); EKnMla E{ws + WS_KN, 0}; GEMM_CALL_NEW(EKnMla, true, CL() + C_CKV, WL() + W_UKV, 48 * 256, 1024, 512, E, 64); }
            { unsigned char* ws = PWS(); EVtMla E{ws + WS_VT, 0}; GEMM_CALL_NEW(EVtMla, false, WL() + W_UKV + (size_t)1024 * 512 * 2, CL() + C_CKV, 1024, 48 * 256, 512, E, 128); }
            { unsigned char* ws = PWS(); EKnMla E{ws + WS_KN, 32}; GEMM_CALL_SUB(EKnMla, CL() + C_CKV + (size_t)8192 * 512 * 2, WL() + W_UKV, NKEY - 8192, 1024, 512, E, 48, bid_ + 48, 2, 3); }
            SEAM(pb + 5); }
        if (EN(6) && IN(pb + 6)) for (int rep = 0; rep < NREP(6); ++rep) { LAUNDER(); attention_phase(F, l, rep); SEAM(pb + 6); }
        if (EN(7) && IN(pb + 7)) for (int rep = 0; rep < NREP(7); ++rep) { LAUNDER(); postattn_phase(F, l); SEAM(pb + 7); }
        if (EN(8) && IN(pb + 8)) for (int rep = 0; rep < NREP(8); ++rep) { LAUNDER(); unsigned char* ws = PWS(); pg8::EpiFmix E{(bf16*)(ws + WS_F), (bf16*)(ws + WS_F1), DM, DM / 64}; GEMM_CALL_SK(pg8::EpiFmix, ws + WS_XN, WL() + W_O, MT, DM, DM, E); SEAM(pb + 8); }
        if (EN(9) && IN(pb + 9)) { LAUNDER(); unsigned char* ws = PWS(); bf16* HB = (bf16*)(ws + WS_HB);
            norm_phase<false, false>(F, (const bf16*)(ws + WS_F), (const bf16*)(ws + WS_F1), HB, nullptr, 1.0f, PIN(24) + l * DM, (float*)(ws + WS_RS), HB, ws + WS_HB8); SEAM(pb + 9); }
        if (EN(10) && IN(pb + 10)) for (int rep = 0; rep < NREP(10); ++rep) { LAUNDER(); unsigned char* ws = PWS();
            pg8::EpiSwiGLUi8 E{(bf16*)(ws + WS_HID), DFF, (const float*)(ws + WS_RS), (const float*)(ws + WS_CS) + (size_t)(l * 2 + 1) * 2 * DFF};
            GEMM_CALL_I8(pg8::EpiSwiGLUi8, ws + WS_HB8, WL() + W_GU2, MT, 2 * DFF, DM / 2, E);
            if (l == 0 && DEPTH == 2) { LAUNDER(); __syncthreads(); deferred_down_weights(F); }
            SEAM(pb + 10); }
        if (EN(11) && IN(pb + 11)) for (int rep = 0; rep < NREP(11); ++rep) { LAUNDER(); unsigned char* ws = PWS(); pg8::EpiFmix E{(bf16*)(ws + WS_F), (bf16*)(ws + WS_F1), DM, DFF / 64}; GEMM_CALL_SK(pg8::EpiFmix, ws + WS_HID, WL() + W_D2, MT, DM, DFF, E); SEAM(pb + 11); }
        if (EN(12) && IN(pb + 12)) { LAUNDER(); unsigned char* ws = PWS(); bf16* HB = (bf16*)(ws + WS_HB);
            if (l + 1 < DEPTH) norm_phase<false, false>(F, (const bf16*)(ws + WS_F), (const bf16*)(ws + WS_F1), HB, nullptr, 0.5f, PIN(29) + l * DM, (float*)(ws + WS_RS), HB, ws + WS_HB8);
            else norm_phase<false, true>(F, (const bf16*)(ws + WS_F), (const bf16*)(ws + WS_F1), HB, nullptr, 0.5f, PIN(29) + l * DM, nullptr, POUT());
            SEAM(pb + 12); }
    }
#undef IN
#undef SEAM
}

extern "C" void kernel_launch(void* const* d_in, const int* in_sizes, int n_in, void* d_out, int out_size, void* d_ws, size_t ws_size, hipStream_t stream) {
    static int grid = 0;
    if (grid == 0) {
        if (n_in != 30 || out_size != (int)O_END || ws_size < WS_END) { fprintf(stderr, "kernel_launch: unexpected shapes: n_in %d out %d ws %zu (need %zu)\n", n_in, out_size, ws_size, (size_t)WS_END); grid = -1; return; }
        int dev = 0, cus = 0, per_cu = 0;
        if (hipGetDevice(&dev) != hipSuccess || hipDeviceGetAttribute(&cus, hipDeviceAttributeMultiprocessorCount, dev) != hipSuccess) { grid = -1; return; }
        if (hipFuncSetAttribute((const void*)fwd_kernel, hipFuncAttributeMaxDynamicSharedMemorySize, LDS_BYTES) != hipSuccess) { fprintf(stderr, "kernel_launch: hipFuncSetAttribute failed\n"); grid = -1; return; }
        if (hipOccupancyMaxActiveBlocksPerMultiprocessor(&per_cu, (const void*)fwd_kernel, NWAVES * 64, LDS_BYTES) != hipSuccess || per_cu < 1) { fprintf(stderr, "kernel_launch: occupancy query says %d\n", per_cu); (void)hipGetLastError(); grid = -1; return; }
        grid = cus;
    }
    if (grid < 0) return;
    (void)hipMemsetAsync((char*)d_ws + WS_CTL, 0, CTL_ZERO_BYTES, stream);
    Args a{};
    for (int i = 0; i < 30; ++i) a.in[i] = (const float*)d_in[i];
    a.out = (float*)d_out; a.ws = (unsigned char*)d_ws;
#if MK_SPLIT
    for (int p = 0; p < NPH; ++p) { a.ph_lo = p; a.ph_hi = p + 1; hipLaunchKernelGGL(fwd_kernel, dim3(grid), dim3(NWAVES * 64), LDS_BYTES, stream, a); }
#else
    a.ph_lo = 0; a.ph_hi = NPH;
    hipLaunchKernelGGL(fwd_kernel, dim3(grid), dim3(NWAVES * 64), LDS_BYTES, stream, a);
#endif
}
```

```cpp
#include <hip/hip_runtime.h>
#include <cstdio>
#include <cstdint>
#ifndef DUPM
#define DUPM 0u
#endif
namespace pg8 {
#define PG8_LAS __attribute__((address_space(3)))
typedef unsigned short bf16_t;
typedef short bf16x8 __attribute__((ext_vector_type(8)));
typedef float f32x4 __attribute__((ext_vector_type(4)));
typedef unsigned u32x4 __attribute__((ext_vector_type(4)));
constexpr int BM = 256, BK = 64, HALF = 128, HTB = HALF * BK * 2  , STAGE_BYTES = 8 * HTB, NXCD = 8, WGM = 4;

__host__ __device__ __forceinline__ int lds_byte(int r, int c) { const int st = (r >> 4) * 2 + (c >> 5), rr = r & 15, cc = c & 31, ob = rr * 64 + cc * 2; return st * 1024 + (ob ^ (((ob >> 9) & 1) << 5)); }
__host__ __device__ __forceinline__ void stage_rc(int b, int& R, int& C) { const int st = b / 1024, sb = b % 1024, swz = sb ^ (((sb >> 9) & 1) << 5); R = (st >> 1) * 16 + swz / 64; C = (st & 1) * 32 + (swz % 64) / 2; }
__host__ __device__ __forceinline__ int perm32(int rho) { const int n = rho >> 4, i = rho & 15; return 8 * (i >> 2) + 4 * n + (i & 3); }

struct Unit { int pm, pn, k0, nk; };
struct Gemm { const bf16_t* A; const bf16_t* Bt; int M, N, K; };

struct StaticOrder {
    int nM, nN, nwg, G, c, nkt;
    __host__ __device__ void init(int M, int N, int K, int G_, int c_) { nM = M / BM; nN = N / BM; nwg = nM * nN; G = G_; c = c_; nkt = K / BK; }
    __host__ __device__ bool next(int i, Unit& u) const {
        const long L = (long)i * G + c; if (L >= nwg) return false;
        int wgid = (int)L; { const int q = nwg / NXCD, r = nwg % NXCD, xcd = wgid % NXCD, off = wgid / NXCD; wgid = (xcd < r ? xcd * (q + 1) : r * (q + 1) + (xcd - r) * q) + off; }
        const int nig = WGM * nN, gid = wgid / nig, fm = gid * WGM, gsz = (nM - fm) < WGM ? (nM - fm) : WGM;
        u.pm = fm + ((wgid % nig) % gsz); u.pn = (wgid % nig) / gsz; u.k0 = 0; u.nk = nkt; return true;
    }
    __device__ __forceinline__ void a_ready(const Unit&) const {}
    __device__ __forceinline__ void done(const Unit&) const {}
};
struct TailSplitOrder {
    StaticOrder S0; int nkt, c, nN;
    __host__ __device__ static int slice_len(int nkt, int s) { const int q = nkt / 8; return (q & 1) ? (s < 4 ? q + 1 : q - 1) : q; }
    __host__ __device__ static int slice_start(int nkt, int s) { const int q = nkt / 8; return (q & 1) ? (s < 4 ? s * (q + 1) : 4 * (q + 1) + (s - 4) * (q - 1)) : s * q; }
    __host__ __device__ static int slice_of(int nkt, int k0) { const int q = nkt / 8; return (q & 1) ? (k0 < 4 * (q + 1) ? k0 / (q + 1) : 4 + (k0 - 4 * (q + 1)) / (q - 1)) : k0 / q; }
    __host__ __device__ void init(int M, int N, int K, int G_, int c_) { S0.init(M - 4 * BM, N, K, G_, c_); nkt = K / BK; c = c_; nN = N / BM; }
    __host__ __device__ bool next(int i, Unit& u) const {
        if (i == 0) return S0.next(0, u);
        if (i > 1) return false;
        const int r = c >> 3, sl = c & 7; u.pm = S0.nM + r / nN; u.pn = r % nN; u.k0 = slice_start(nkt, sl); u.nk = slice_len(nkt, sl); return true;
    }
    __device__ __forceinline__ void a_ready(const Unit&) const {}
    __device__ __forceinline__ void done(const Unit&) const {}
};
struct SubsetOrder {
    StaticOrder S0; bool on; int i0, i1;
    __host__ __device__ void init(int M, int N, int K, int G_, int c_, int c0, int i0_ = 0, int i1_ = 1 << 30) { on = c_ >= c0; S0.init(M, N, K, G_ - c0, on ? c_ - c0 : 0); i0 = i0_; i1 = i1_; }
    __host__ __device__ bool next(int i, Unit& u) const { return on && (i + i0) < i1 && S0.next(i + i0, u); }
    __device__ __forceinline__ void a_ready(const Unit&) const {}
    __device__ __forceinline__ void done(const Unit&) const {}
};
template <bool ROWS> struct NewKeyOrder {
    StaticOrder S0;
    __host__ __device__ static int panel(int p) { return p < 32 ? p : 40 + (33 * (p - 32)) / 4; }
    __host__ __device__ void init(int M, int N, int K, int G_, int c_) { S0.init(M, N, K, G_, c_); }
    __host__ __device__ bool next(int i, Unit& u) const { if (!S0.next(i, u)) return false; if (ROWS) u.pm = panel(u.pm); else u.pn = panel(u.pn); return true; }
    __device__ __forceinline__ void a_ready(const Unit&) const {}
    __device__ __forceinline__ void done(const Unit&) const {}
};

template <bool ROWS> struct PastPanelOrder {
    SubsetOrder S;
    __host__ __device__ static __forceinline__ int past_panel(int j) { int s = 0;
#pragma unroll
        for (int k = 0; k < 16; ++k) s = (8 + (33 * k) / 4 - k <= j) ? k + 1 : s;
        return j + s; }
    __host__ __device__ __forceinline__ void init(int M, int N, int K, int G_, int c_, int c0, int i0 = 0, int i1 = 1 << 30) { S.init(M, N, K, G_, c_, c0, i0, i1); }
    __host__ __device__ __forceinline__ bool next(int i, Unit& u) const { if (!S.next(i, u)) return false; if (ROWS) u.pm = past_panel(u.pm); else u.pn = past_panel(u.pn); return true; }
    __device__ __forceinline__ void a_ready(const Unit&) const {}
    __device__ __forceinline__ void done(const Unit&) const {}
};


__device__ __forceinline__ unsigned cvt_pk_bf16(float lo, float hi) { unsigned r; asm volatile("v_cvt_pk_bf16_f32 %0, %1, %2" : "=v"(r) : "v"(lo), "v"(hi)); return r; }
typedef unsigned u32x2 __attribute__((ext_vector_type(2)));

struct EpiFmix {
    static constexpr bool PERM = true, AFTER_DRAIN = false;
    bf16_t* C; bf16_t* C1; int ldc; int nkt;
    __device__ __forceinline__ void operator()(const f32x4 (&acc)[2][2][4][2], const Unit& u, int wr, int wc, int fr, int fq) const {
        const int row0 = u.pm * BM + wr * 64 + fr, col0 = u.pn * BM + wc * 32 + 8 * fq;
        bf16_t* Cb = u.k0 == 0 ? C : C1 + (size_t)(TailSplitOrder::slice_of(nkt, u.k0) - 1) * 1024 * ldc - (size_t)8192 * ldc;
#pragma unroll
        for (int ai = 0; ai < 2; ++ai)
#pragma unroll
            for (int m = 0; m < 4; ++m) { bf16_t* rowp = Cb + (size_t)(row0 + ai * HALF + m * 16) * ldc + col0;
#pragma unroll
                for (int bj = 0; bj < 2; ++bj) { const f32x4 v0 = acc[ai][bj][m][0], v1 = acc[ai][bj][m][1];
                    u32x4 w; w.x = cvt_pk_bf16(v0[0], v0[1]); w.y = cvt_pk_bf16(v0[2], v0[3]); w.z = cvt_pk_bf16(v1[0], v1[1]); w.w = cvt_pk_bf16(v1[2], v1[3]);
                    *(u32x4*)(rowp + bj * HALF) = w; } }
    }
};
struct EpiBf16 {
    static constexpr bool PERM = true, AFTER_DRAIN = false;
    bf16_t* O; int ldc; const float* rs;
    __device__ __forceinline__ void operator()(const f32x4 (&acc)[2][2][4][2], const Unit& u, int wr, int wc, int fr, int fq) const {
        const int row0 = u.pm * BM + wr * 64 + fr, col0 = u.pn * BM + wc * 32 + 8 * fq;
        float rv[2][4];
#pragma unroll
        for (int ai = 0; ai < 2; ++ai)
#pragma unroll
            for (int m = 0; m < 4; ++m) rv[ai][m] = rs ? rs[row0 + ai * HALF + m * 16] : 1.0f;
#pragma unroll
        for (int ai = 0; ai < 2; ++ai)
#pragma unroll
            for (int m = 0; m < 4; ++m) { const int row = row0 + ai * HALF + m * 16; bf16_t* rowp = O + (size_t)row * ldc + col0; const float r = rv[ai][m];
#pragma unroll
                for (int bj = 0; bj < 2; ++bj) { const f32x4 v0 = acc[ai][bj][m][0] * r, v1 = acc[ai][bj][m][1] * r;
                    u32x4 w; w.x = cvt_pk_bf16(v0[0], v0[1]); w.y = cvt_pk_bf16(v0[2], v0[3]); w.z = cvt_pk_bf16(v1[0], v1[1]); w.w = cvt_pk_bf16(v1[2], v1[3]);
                    *(u32x4*)(rowp + bj * HALF) = w; } }
    }
};
struct EpiSwiGLU {
    static constexpr bool PERM = true, AFTER_DRAIN = false;
    bf16_t* O; int ldc; const float* rs;
    __device__ __forceinline__ static float silu_mul(float g, float u) { const float e = __builtin_amdgcn_exp2f(-g * 1.4426950408889634f); return g * u * __builtin_amdgcn_rcpf(1.0f + e); }
    __device__ __forceinline__ void operator()(const f32x4 (&acc)[2][2][4][2], const Unit& u, int wr, int wc, int fr, int fq) const {
        const int row0 = u.pm * BM + wr * 64 + fr, col0 = u.pn * HALF + wc * 32 + 8 * fq;
#pragma unroll
        for (int ai = 0; ai < 2; ++ai)
#pragma unroll
            for (int m = 0; m < 4; ++m) { const int row = row0 + ai * HALF + m * 16; bf16_t* rowp = O + (size_t)row * ldc + col0; const float r = rs[row];
                const f32x4 g0 = acc[ai][0][m][0] * r, g1 = acc[ai][0][m][1] * r, u0 = acc[ai][1][m][0] * r, u1 = acc[ai][1][m][1] * r;
                u32x4 w; w.x = cvt_pk_bf16(silu_mul(g0[0], u0[0]), silu_mul(g0[1], u0[1])); w.y = cvt_pk_bf16(silu_mul(g0[2], u0[2]), silu_mul(g0[3], u0[3]));
                w.z = cvt_pk_bf16(silu_mul(g1[0], u1[0]), silu_mul(g1[1], u1[1])); w.w = cvt_pk_bf16(silu_mul(g1[2], u1[2]), silu_mul(g1[3], u1[3]));
                *(u32x4*)rowp = w; }
    }
};
struct EpiSwiGLUi8 {
    static constexpr bool PERM = true, AFTER_DRAIN = false;
    bf16_t* O; int ldc; const float* rs; const float* cs;
    __device__ __forceinline__ void operator()(const f32x4 (&acc)[2][2][4][2], const Unit& u, int wr, int wc, int fr, int fq) const {
        typedef int i32x4e __attribute__((ext_vector_type(4)));
        const int row0 = u.pm * BM + wr * 64 + fr, col0 = u.pn * HALF + wc * 32 + 8 * fq; const float* cg = cs + u.pn * BM + wc * 32 + 8 * fq;
        const f32x4 cg0 = *(const f32x4*)cg * (1.0f / 127.0f), cg1 = *(const f32x4*)(cg + 4) * (1.0f / 127.0f), cu0 = *(const f32x4*)(cg + HALF) * (1.0f / 127.0f), cu1 = *(const f32x4*)(cg + HALF + 4) * (1.0f / 127.0f);
        float rv[2][4];
#pragma unroll
        for (int ai = 0; ai < 2; ++ai)
#pragma unroll
            for (int m = 0; m < 4; ++m) rv[ai][m] = rs[row0 + ai * HALF + m * 16];
#pragma unroll
        for (int ai = 0; ai < 2; ++ai)
#pragma unroll
            for (int m = 0; m < 4; ++m) { const int row = row0 + ai * HALF + m * 16; bf16_t* rowp = O + (size_t)row * ldc + col0; const float r = rv[ai][m];
                const f32x4 g0 = __builtin_convertvector(__builtin_bit_cast(i32x4e, acc[ai][0][m][0]), f32x4) * cg0 * r, g1 = __builtin_convertvector(__builtin_bit_cast(i32x4e, acc[ai][0][m][1]), f32x4) * cg1 * r;
                const f32x4 u0 = __builtin_convertvector(__builtin_bit_cast(i32x4e, acc[ai][1][m][0]), f32x4) * cu0 * r, u1 = __builtin_convertvector(__builtin_bit_cast(i32x4e, acc[ai][1][m][1]), f32x4) * cu1 * r;
                u32x4 w; w.x = cvt_pk_bf16(EpiSwiGLU::silu_mul(g0[0], u0[0]), EpiSwiGLU::silu_mul(g0[1], u0[1])); w.y = cvt_pk_bf16(EpiSwiGLU::silu_mul(g0[2], u0[2]), EpiSwiGLU::silu_mul(g0[3], u0[3]));
                w.z = cvt_pk_bf16(EpiSwiGLU::silu_mul(g1[0], u1[0]), EpiSwiGLU::silu_mul(g1[1], u1[1])); w.w = cvt_pk_bf16(EpiSwiGLU::silu_mul(g1[2], u1[2]), EpiSwiGLU::silu_mul(g1[3], u1[3]));
                *(u32x4*)rowp = w; }
    }
};
template <int NH> struct EpiKBlk {
    static constexpr bool PERM = true, AFTER_DRAIN = false;
    unsigned char* O; int pm0;
    __device__ __forceinline__ void operator()(const f32x4 (&acc)[2][2][4][2], const Unit& u, int wr, int wc, int fr, int fq) const {
        unsigned char* base = O + ((size_t)((4 * (u.pm + pm0) + wr) * NH + 2 * u.pn)) * 16384 + (4 * wc + fq) * 1024 + fr * 16;
#pragma unroll
        for (int ai = 0; ai < 2; ++ai)
#pragma unroll
            for (int m = 0; m < 4; ++m)
#pragma unroll
                for (int bj = 0; bj < 2; ++bj) { const f32x4 v0 = acc[ai][bj][m][0], v1 = acc[ai][bj][m][1];
                    u32x4 w; w.x = cvt_pk_bf16(v0[0], v0[1]); w.y = cvt_pk_bf16(v0[2], v0[3]); w.z = cvt_pk_bf16(v1[0], v1[1]); w.w = cvt_pk_bf16(v1[2], v1[3]);
                    *(u32x4*)(base + ai * (2 * NH * 16384) + bj * 16384 + m * 256) = w; }
    }
};
template <bool TOK, int NH> struct EpiVtBlk {
    static constexpr bool PERM = false, AFTER_DRAIN = false;
    unsigned char* O; int pn0;
    __device__ __forceinline__ void operator()(const f32x4 (&acc)[2][2][4][2], const Unit& u, int wr, int wc, int fr, int fq) const {
        const bool smp = TOK && u.pn >= 32;
        const int tile0 = smp ? 160 + 33 * (4 * (u.pn - 32) + (wc >> 1)) : 4 * (u.pn + pn0) + (wc >> 1);
        const unsigned bjs = smp ? 66u * NH * 16384u : 2u * NH * 16384u;
        unsigned char* base = O + ((size_t)(tile0 * NH + 2 * u.pm)) * 16384 + (4 * (wc & 1) + (fq & 1)) * 2048 + (wr * 64 + fr) * 16 + 8 * (fq >> 1);
#pragma unroll
        for (int bj = 0; bj < 2; ++bj) { unsigned char* bb = base + (size_t)bj * bjs;
#pragma unroll
            for (int ai = 0; ai < 2; ++ai)
#pragma unroll
                for (int m = 0; m < 4; ++m)
#pragma unroll
                    for (int n = 0; n < 2; ++n) { const f32x4 v = acc[ai][bj][m][n];
                        u32x2 w; w.x = cvt_pk_bf16(v[0], v[1]); w.y = cvt_pk_bf16(v[2], v[3]);
                        *(u32x2*)(bb + ai * 16384 + m * 256 + n * 4096) = w; } }
    }
};

template <class Epi, class Sched, bool ALIGN_EPI = false, bool SP2 = false, bool I8 = false>
__device__ __forceinline__ void gemm_phase(PG8_LAS unsigned char* lds, const Gemm g, const Sched& S, const Epi& E) {
    int tid_ = threadIdx.x; asm volatile("" : "+v"(tid_));
    const int tid = tid_, wid = __builtin_amdgcn_readfirstlane(tid >> 6), lane = tid & 63, wr = wid >> 2, wc = wid & 3, fr = lane & 15, fq = lane >> 4;
    const int K = g.K;
    unsigned voffA[2], voffB[2];
#pragma unroll
    for (int i = 0; i < 2; ++i) { int R, C; stage_rc(tid * 16 + i * 8192, R, C); const int Rb = Epi::PERM ? ((R & ~31) + perm32(R & 31)) : R;
        voffA[i] = (unsigned)(R * K + C) * 2u; voffB[i] = (unsigned)(Rb * K + C) * 2u; }
    const size_t kstep = (size_t)(BK * 2);
    const size_t hstep = (size_t)HALF * K * 2;
    const size_t tstep = 2 * hstep;
    const unsigned ldsw = (unsigned)wid * 1024u;
    const int aoff = lds_byte(wr * 64 + fr, fq * 8), boff = lds_byte(wc * 32 + fr, fq * 8);
#define PG8_SA(b, h) (((b) * 2 + (h)) * HTB)
#define PG8_SB(b, h) ((4 + (b) * 2 + (h)) * HTB)
#define PG8_STAGE(bufoff, gbase, voff) do { _Pragma("unroll") for (int _i = 0; _i < 2; ++_i) \
        __builtin_amdgcn_global_load_lds((const unsigned*)((const char*)(gbase) + (voff)[_i]), (PG8_LAS unsigned*)(lds + (bufoff) + ldsw + _i * 8192), 16, 0, 0); } while (0)
#define PG8_LDA(dst, b, h) do { _Pragma("unroll") for (int m = 0; m < 4; ++m) _Pragma("unroll") for (int k = 0; k < 2; ++k) dst[m][k] = *(const PG8_LAS bf16x8*)(lds + PG8_SA(b, h) + aoff + m * 2048 + k * 1024); } while (0)
#define PG8_LDB(dst, b, h) do { _Pragma("unroll") for (int n = 0; n < 2; ++n) _Pragma("unroll") for (int k = 0; k < 2; ++k) dst[n][k] = *(const PG8_LAS bf16x8*)(lds + PG8_SB(b, h) + boff + n * 2048 + k * 1024); } while (0)
#define PG8_MMA(ai, bj, At, Bt) do { __builtin_amdgcn_s_setprio(1); _Pragma("unroll") for (int m = 0; m < 4; ++m) _Pragma("unroll") for (int n = 0; n < 2; ++n) _Pragma("unroll") for (int k = 0; k < 2; ++k) { \
        if constexpr (I8) acc[ai][bj][m][n] = __builtin_bit_cast(f32x4, __builtin_amdgcn_mfma_i32_16x16x64_i8(__builtin_bit_cast(i32x4_, Bt[n][k]), __builtin_bit_cast(i32x4_, At[m][k]), __builtin_bit_cast(i32x4_, acc[ai][bj][m][n]), 0, 0, 0)); \
        else acc[ai][bj][m][n] = __builtin_amdgcn_mfma_f32_16x16x32_bf16(Bt[n][k], At[m][k], acc[ai][bj][m][n], 0, 0, 0); } \
        __builtin_amdgcn_s_setprio(0); } while (0)
#define PG8_WAIT_V(n) asm volatile("s_waitcnt vmcnt(" #n ")" ::: "memory")
#define PG8_WAIT_L(n) asm volatile("s_waitcnt lgkmcnt(" #n ")" ::: "memory")
#define PG8_BAR __builtin_amdgcn_s_barrier()
#define PG8_SCHED __builtin_amdgcn_sched_barrier(0)
    Unit cur, nxt; int ui = 0;
    if (!S.next(0, cur)) return;
    f32x4 acc[2][2][4][2];
#pragma unroll
    for (int a = 0; a < 2; ++a)
#pragma unroll
        for (int b = 0; b < 2; ++b)
#pragma unroll
            for (int m = 0; m < 4; ++m)
#pragma unroll
                for (int n = 0; n < 2; ++n) acc[a][b][m][n] = (f32x4){0.f, 0.f, 0.f, 0.f};
    typedef int i32x4_ __attribute__((ext_vector_type(4)));
    bf16x8 At[4][2], B0[2][2], B1[2][2];
    const char* cA = (const char*)g.A + (size_t)cur.pm * tstep + (size_t)cur.k0 * kstep; const char* cB = (const char*)g.Bt + (size_t)cur.pn * tstep + (size_t)cur.k0 * kstep;
    S.a_ready(cur);
    if constexpr (SP2) {
        PG8_STAGE(PG8_SB(0, 0), cB, voffB); PG8_STAGE(PG8_SB(0, 1), cB + hstep, voffB); PG8_STAGE(PG8_SA(0, 0), cA, voffA); PG8_STAGE(PG8_SA(0, 1), cA + hstep, voffA);
        if (wr == 1) PG8_BAR;
        PG8_WAIT_V(2); PG8_BAR;
        PG8_STAGE(PG8_SB(1, 0), cB + kstep, voffB); PG8_STAGE(PG8_SA(1, 0), cA + kstep, voffA); PG8_STAGE(PG8_SB(1, 1), cB + hstep + kstep, voffB);
        PG8_WAIT_V(6); PG8_BAR;
    } else {
        PG8_STAGE(PG8_SB(0, 0), cB, voffB); PG8_STAGE(PG8_SA(0, 0), cA, voffA); PG8_STAGE(PG8_SB(0, 1), cB + hstep, voffB); PG8_STAGE(PG8_SA(0, 1), cA + hstep, voffA);
        if (wr == 1) PG8_BAR;
        PG8_WAIT_V(4); PG8_BAR;
        PG8_STAGE(PG8_SB(1, 0), cB + kstep, voffB); PG8_STAGE(PG8_SA(1, 0), cA + kstep, voffA); PG8_STAGE(PG8_SB(1, 1), cB + hstep + kstep, voffB);
        PG8_WAIT_V(6); PG8_BAR;
    }
    for (;;) {
        const bool has_next = S.next(ui + 1, nxt);
        const char* nA = has_next ? (const char*)g.A + (size_t)nxt.pm * tstep + (size_t)nxt.k0 * kstep : cA; const char* nB = has_next ? (const char*)g.Bt + (size_t)nxt.pn * tstep + (size_t)nxt.k0 * kstep : cB;
        const int nt = cur.nk;
        for (int t = 0; t < nt; t += 2) {
            const bool last = (t == nt - 2);
            const char* a1 = cA + (size_t)(t + 1) * kstep;
            const char* a2 = last ? nA : cA + (size_t)(t + 2) * kstep; const char* b2 = last ? nB : cB + (size_t)(t + 2) * kstep;
            const char* a3 = a2 + kstep; const char* b3 = b2 + kstep;
            if (last && has_next) S.a_ready(nxt);
            if constexpr (SP2) {
            PG8_LDB(B0, 0, 0); PG8_LDB(B1, 0, 1); PG8_SCHED; PG8_LDA(At, 0, 0); PG8_STAGE(PG8_SA(1, 1), a1 + hstep, voffA);
            PG8_WAIT_V(8); PG8_WAIT_L(0); PG8_BAR; PG8_MMA(0, 0, At, B0); PG8_MMA(0, 1, At, B1); PG8_BAR; PG8_SCHED;
            PG8_LDA(At, 0, 1); PG8_STAGE(PG8_SB(0, 0), b2, voffB); PG8_STAGE(PG8_SB(0, 1), b2 + hstep, voffB); PG8_STAGE(PG8_SA(0, 0), a2, voffA);
            PG8_WAIT_V(8); PG8_WAIT_L(0); PG8_BAR; PG8_MMA(1, 0, At, B0); PG8_MMA(1, 1, At, B1); PG8_BAR; PG8_SCHED;
            PG8_LDB(B0, 1, 0); PG8_LDB(B1, 1, 1); PG8_SCHED; PG8_LDA(At, 1, 0); PG8_STAGE(PG8_SA(0, 1), a2 + hstep, voffA);
            PG8_WAIT_V(8); PG8_WAIT_L(0); PG8_BAR; PG8_MMA(0, 0, At, B0); PG8_MMA(0, 1, At, B1); PG8_BAR; PG8_SCHED;
            PG8_LDA(At, 1, 1); PG8_STAGE(PG8_SB(1, 0), b3, voffB); PG8_STAGE(PG8_SB(1, 1), b3 + hstep, voffB); PG8_STAGE(PG8_SA(1, 0), a3, voffA);
            PG8_WAIT_V(8); PG8_WAIT_L(0); PG8_BAR; PG8_MMA(1, 0, At, B0); PG8_MMA(1, 1, At, B1); PG8_BAR; PG8_SCHED;
            } else {
            PG8_LDB(B0, 0, 0); PG8_SCHED; PG8_LDA(At, 0, 0); PG8_STAGE(PG8_SA(1, 1), a1 + hstep, voffA);
            PG8_WAIT_L(8); PG8_BAR; PG8_WAIT_L(0); PG8_MMA(0, 0, At, B0); PG8_BAR; PG8_SCHED;
            PG8_LDB(B1, 0, 1); PG8_STAGE(PG8_SB(0, 0), b2, voffB);
            PG8_BAR; PG8_WAIT_L(0); PG8_MMA(0, 1, At, B1); PG8_BAR;
            PG8_LDA(At, 0, 1); PG8_STAGE(PG8_SA(0, 0), a2, voffA);
            PG8_BAR; PG8_WAIT_L(0); PG8_MMA(1, 0, At, B0); PG8_BAR; PG8_SCHED;
            PG8_STAGE(PG8_SB(0, 1), b2 + hstep, voffB);
            PG8_WAIT_V(6); PG8_BAR; PG8_MMA(1, 1, At, B1); PG8_BAR;
            PG8_LDB(B0, 1, 0); PG8_SCHED; PG8_LDA(At, 1, 0); PG8_STAGE(PG8_SA(0, 1), a2 + hstep, voffA);
            PG8_WAIT_L(8); PG8_BAR; PG8_WAIT_L(0); PG8_MMA(0, 0, At, B0); PG8_BAR; PG8_SCHED;
            PG8_LDB(B1, 1, 1); PG8_STAGE(PG8_SB(1, 0), b3, voffB);
            PG8_BAR; PG8_WAIT_L(0); PG8_MMA(0, 1, At, B1); PG8_BAR;
            PG8_LDA(At, 1, 1); PG8_STAGE(PG8_SA(1, 0), a3, voffA);
            PG8_BAR; PG8_WAIT_L(0); PG8_MMA(1, 0, At, B0); PG8_BAR; PG8_SCHED;
            PG8_STAGE(PG8_SB(1, 1), b3 + hstep, voffB);
            PG8_WAIT_V(6); PG8_BAR; PG8_MMA(1, 1, At, B1); PG8_BAR;
            }
        }
        if constexpr (ALIGN_EPI) { if (wr == 0) PG8_BAR; }
        if constexpr (!Epi::AFTER_DRAIN) { int te_ = threadIdx.x; asm volatile("" : "+v"(te_));
            const int we_ = __builtin_amdgcn_readfirstlane(te_ >> 6), le_ = te_ & 63; E(acc, cur, we_ >> 2, we_ & 3, le_ & 15, le_ >> 4); S.done(cur); }
        if (!has_next) break;
#pragma unroll
        for (int a = 0; a < 2; ++a)
#pragma unroll
            for (int b = 0; b < 2; ++b)
#pragma unroll
                for (int m = 0; m < 4; ++m)
#pragma unroll
                    for (int n = 0; n < 2; ++n) acc[a][b][m][n] = (f32x4){0.f, 0.f, 0.f, 0.f};
        cur = nxt; cA = nA; cB = nB; ++ui;
        if constexpr (ALIGN_EPI) { if (wr == 1) PG8_BAR; }
    }
    PG8_WAIT_V(0);
    if constexpr (!ALIGN_EPI) { if (wr == 0) PG8_BAR; }
    PG8_BAR;
    if constexpr (Epi::AFTER_DRAIN) { E.fused(acc, cur, wr, wc, fr, fq, lds, wid, lane); S.done(cur); }
#undef PG8_SA
#undef PG8_SB
#undef PG8_STAGE
#undef PG8_LDA
#undef PG8_LDB
#undef PG8_MMA
#undef PG8_WAIT_V
#undef PG8_WAIT_L
#undef PG8_BAR
#undef PG8_SCHED
}
}

constexpr int NWAVES = 8;
constexpr int DM = 2048, TP = 8192, TS = 1024, MT = TP + TS, DFF = 5632, DEPTH = 2;
constexpr int DIN = 4160, DINP = 4352;
constexpr int ZC_CQ = 0, ZC_CKV = 512, ZC_KR = 1024, ZC_GB = 1088, ZC_GC = 1600, ZC_XC = 2112, ZC_QSB = 2624, ZC_KSB = 3136, ZC_VSB = 3648;
constexpr int NKEY = 41984, NTILE = 656;
constexpr int QW = 1536;
constexpr int YW = 1536;
constexpr float EPS = 1e-6f;
constexpr float LOG2E = 1.4426950408889634f, LN2 = 0.6931471805599453f;
constexpr float MLA_QSCALE = 0.07216878364870322f * LOG2E;
constexpr float SB_QSCALE = 0.08838834764831845f;
constexpr float SB_EXIT = -104.0f;

constexpr size_t O_Y = 0;
constexpr size_t O_CKV_P = 18874368, O_KR_P = 27262976, O_SBK_P = 28311552, O_SBV_P = 36700160, O_CONV_P = 45088768;
constexpr size_t O_CKV_S = 45092864, O_KR_S = 46141440, O_SBK_S = 46272512, O_SBV_S = 47321088, O_CONV_S = 48369664, O_END = 48402432;

constexpr size_t WS_CTL = 0, CTL_ZERO_BYTES = 128u << 10;
constexpr size_t WS_RS = 512u << 10;
constexpr size_t WS_CS = 600u << 10;
constexpr size_t WS_ROPE = 1u << 20;
constexpr size_t WS_W = 2u << 20;
constexpr size_t W_GU1 = 0, SZ_GU = (size_t)2 * DFF * DM * 2, W_D1 = W_GU1 + SZ_GU, SZ_D = (size_t)DM * DFF * 2, W_GU2 = W_D1 + SZ_D, W_D2 = W_GU2 + SZ_GU;
constexpr size_t W_IN = W_D2 + SZ_D, SZ_IN = (size_t)DINP * DM * 2, W_UQ = W_IN + SZ_IN, SZ_UQ = (size_t)1536 * 512 * 2, W_UKV = W_UQ + SZ_UQ, SZ_UKV = (size_t)2048 * 512 * 2;
constexpr size_t W_O = W_UKV + SZ_UKV, SZ_O = (size_t)DM * DM * 2, W_LAYER = W_O + SZ_O;
constexpr size_t WS_C = WS_W + DEPTH * W_LAYER;
constexpr size_t C_CKV = 0, SZ_CKV = (size_t)NKEY * 512 * 2, C_KR = C_CKV + SZ_CKV, SZ_KR = (size_t)NTILE * 8192, C_KSB = C_KR + SZ_KR, SZ_KSB = (size_t)NTILE * 4 * 16384;
constexpr size_t C_VTSB = C_KSB + SZ_KSB, C_LAYER = C_VTSB + SZ_KSB;
constexpr size_t WS_XN = WS_C + DEPTH * C_LAYER, SZ_XN = (size_t)MT * DM * 2;
constexpr size_t WS_F = WS_XN + SZ_XN, SZ_F = (size_t)MT * DM * 4;
constexpr size_t WS_HB = WS_F + SZ_F / 2;
constexpr size_t WS_MIX = WS_F + SZ_F;
constexpr size_t WS_HID = WS_MIX, SZ_HID = (size_t)MT * DFF * 2;
constexpr size_t WS_F1_OLD = WS_HID + SZ_HID;
constexpr size_t WS_Z = WS_MIX, SZ_Z = (size_t)MT * DINP * 2, WS_CQN = WS_Z + SZ_Z, SZ_CQN = (size_t)MT * 512 * 2, WS_Q = WS_CQN + SZ_CQN, SZ_Q = (size_t)MT * QW * 2;
constexpr size_t WS_KN = WS_Q + SZ_Q, SZ_KN = (size_t)NTILE * 8 * 16384, WS_VT = WS_KN + SZ_KN, WS_YATT = WS_VT + SZ_KN, SZ_YATT = (size_t)MT * YW * 2;
constexpr size_t WS_F1 = WS_YATT + SZ_YATT, SZ_F1 = (size_t)7 * 1024 * DM * 4;
constexpr size_t WS_PO = WS_F1 + SZ_F1, SZ_PO = (size_t)384 * 64 * 128 * 4, WS_PML = WS_PO + SZ_PO, SZ_PML = (size_t)384 * 64 * 2 * 4;
constexpr size_t WS_HB8 = WS_XN;
constexpr size_t WS_PO16 = WS_PML + SZ_PML, SZ_PO16 = (size_t)128 * 256 * 128 * 2, WS_PML16 = WS_PO16 + SZ_PO16, SZ_PML16 = (size_t)128 * 256 * 2 * 4;
constexpr size_t WS_END = WS_PML16 + SZ_PML16;
static_assert(WS_HID + SZ_HID <= WS_KN, "hidden overlay must stay below KN / VT (the past keys are expanded during FFN1)");
static_assert(WS_END <= 1160000000ull, "workspace");
constexpr int CW_TMO = 0, CW_CODE = 1;
constexpr int CW_BAR = 4096;
constexpr int CW_QUEUE = 16384;

constexpr int RING_BYTES = 131072;
constexpr int LDS_BYTES = 147456;
constexpr int MISC_OFF = LDS_BYTES - 256;

#define GAS __attribute__((address_space(1)))
#define LAS __attribute__((address_space(3)))
typedef unsigned short bf16;
typedef unsigned v4u __attribute__((ext_vector_type(4)));
typedef float f32x4 __attribute__((ext_vector_type(4)));
typedef short bf16x8 __attribute__((ext_vector_type(8)));
typedef GAS unsigned gu32;
typedef GAS unsigned long long gu64;
#define RLX_AGENT __ATOMIC_RELAXED, __HIP_MEMORY_SCOPE_AGENT
#define LDS_WAIT() asm volatile("s_waitcnt lgkmcnt(0)" ::: "memory")
#define VM_WAIT() asm volatile("s_waitcnt vmcnt(0)" ::: "memory")
__device__ __forceinline__ unsigned long long rt() { return __builtin_amdgcn_s_memrealtime(); }
__device__ __forceinline__ unsigned f2bf(float f) { unsigned u = __builtin_bit_cast(unsigned, f); return (u + 0x7fffu + ((u >> 16) & 1u)) >> 16; }
__device__ __forceinline__ unsigned pk2(float lo, float hi) { return f2bf(lo) | (f2bf(hi) << 16); }

#define XB_TMO      128
#define XB_XCNT(j)  (256  + 64 * (j))
#define XB_XSUB(j)  (1280 + 64 * (j))
#define XB_XGEN(j)  (2304 + 64 * (j))
#define XB_TOP      3328
#define XB_TOPGEN   3392
#define XCD_BAR_WORDS 3456
#define XB_SPIN_CAP (1u << 18)

__device__ __forceinline__ unsigned xb_ld(unsigned* p)              { return __hip_atomic_load(p, __ATOMIC_RELAXED, __HIP_MEMORY_SCOPE_AGENT); }
__device__ __forceinline__ unsigned xb_add(unsigned* p, unsigned v) { return __hip_atomic_fetch_add(p, v, __ATOMIC_RELAXED, __HIP_MEMORY_SCOPE_AGENT); }
__device__ __forceinline__ unsigned xb_xcc_id() { return (unsigned)__builtin_amdgcn_s_getreg((3 << 11) | 20) & 0xFu; }
#define XB_SPIN(cond, bar) do { unsigned _sp = 0; while (cond) { __builtin_amdgcn_s_sleep(1); \
    if ((++_sp & 255u) == 0u) { if (xb_ld(&(bar)[XB_TMO])) break; if (_sp > XB_SPIN_CAP) { atomicAdd(&(bar)[XB_TMO], 1u); break; } } } } while (0)

struct XcdBarrier {
    unsigned* bar; unsigned x;
    volatile LAS unsigned* st;
};

__device__ __forceinline__ XcdBarrier xcd_barrier_post(unsigned* bar, volatile LAS unsigned* st) {
    XcdBarrier b; b.bar = bar; b.x = xb_xcc_id(); b.st = st;
    if (threadIdx.x == 0) (void)xb_add(&bar[XB_XCNT(b.x)], 1u);
    return b;
}
__device__ __forceinline__ void xcd_barrier_complete(unsigned* bar, unsigned x, unsigned& nloc, unsigned& nx) {
    const unsigned G = gridDim.x * gridDim.y * gridDim.z;
    unsigned sum, cnt, mine, sp = 0u;
    for (;;) {
        sum = 0u; cnt = 0u; mine = 0u;
#pragma unroll 1
        for (unsigned j = 0; j < 16; ++j) { const unsigned c = xb_ld(&bar[XB_XCNT(j)]); sum += c; cnt += (c > 0u) ? 1u : 0u; mine = (j == x) ? c : mine; }
        if (sum == G) break;
        __builtin_amdgcn_s_sleep(1);
        if ((++sp & 255u) == 0u) { if (xb_ld(&bar[XB_TMO])) break; if (sp > XB_SPIN_CAP) { atomicAdd(&bar[XB_TMO], 1u); break; } }
    }
    nloc = mine > 0u ? mine : 1u; nx = cnt > 0u ? cnt : 1u;
}

__device__ __forceinline__ void xcd_barrier(const XcdBarrier& b) {
    asm volatile("s_waitcnt vmcnt(0)" ::: "memory");
    __syncthreads();
    if (threadIdx.x == 0) {
        unsigned* bar = b.bar;
        __builtin_amdgcn_s_waitcnt(0);
        unsigned nloc = b.st[0], nx = b.st[1];
        if (nloc == 0u) { xcd_barrier_complete(bar, b.x, nloc, nx); b.st[0] = nloc; b.st[1] = nx; }
        const unsigned old = xb_add(&bar[XB_XSUB(b.x)], 1u);
        const unsigned gen = old / nloc;
        if (old + 1u == (gen + 1u) * nloc) {
            __builtin_amdgcn_fence(__ATOMIC_RELEASE, "agent");
            asm volatile("s_waitcnt vmcnt(0)" ::: "memory");
            const unsigned og = xb_add(&bar[XB_TOP], 1u);
            const unsigned tg = og / nx;
            if (og + 1u == (tg + 1u) * nx) xb_add(&bar[XB_TOPGEN], 1u);
            else XB_SPIN(xb_ld(&bar[XB_TOPGEN]) == tg, bar);
            __builtin_amdgcn_fence(__ATOMIC_ACQUIRE, "agent");
            xb_add(&bar[XB_XGEN(b.x)], 1u);
            asm volatile("s_waitcnt vmcnt(0)" ::: "memory");
        } else {
            XB_SPIN(xb_ld(&bar[XB_XGEN(b.x)]) == gen, bar);
            __builtin_amdgcn_fence(__ATOMIC_ACQUIRE, "agent");
            asm volatile("s_waitcnt vmcnt(0)" ::: "memory");
        }
    }
    __syncthreads();
}

typedef unsigned u32x2v __attribute__((ext_vector_type(2)));
typedef float f32x16 __attribute__((ext_vector_type(16)));
struct Args { const float* in[30]; float* out; unsigned char* ws; int ph_lo, ph_hi; };
struct Frame {
    LAS unsigned char* lds;
    volatile LAS unsigned* MISC;
    gu32* ctl;
    int tid, lane, wave;
    int gw, ngw;
};
constexpr int PARAM_OFF = MISC_OFF - 512;
__device__ __forceinline__ unsigned long long ldparam(LAS unsigned char* lds, int k) {
    volatile LAS unsigned* p = (volatile LAS unsigned*)(lds + PARAM_OFF) + 2 * k;
    const unsigned lo = __builtin_amdgcn_readfirstlane(p[0]), hi = __builtin_amdgcn_readfirstlane(p[1]);
    return ((unsigned long long)hi << 32) | lo;
}
#define PIN(k) ((const float*)(const GAS float*)ldparam(F.lds, (k)))
#define POUT() ((float*)(GAS float*)ldparam(F.lds, 30))
#define PWS() ((unsigned char*)(GAS unsigned char*)ldparam(F.lds, 31))
__device__ __forceinline__ float wave_sum(float v) {
#pragma unroll
    for (int o = 1; o < 64; o <<= 1) v += __shfl_xor(v, o);
    return v;
}
__device__ __forceinline__ unsigned pkbf(float lo, float hi) { return pg8::cvt_pk_bf16(lo, hi); }
__device__ __forceinline__ float bflo(unsigned w) { return __uint_as_float(w << 16); }
__device__ __forceinline__ float bfhi(unsigned w) { return __uint_as_float(w & 0xffff0000u); }
__device__ __forceinline__ void unpack8(const v4u w, float (&f)[8]) { f[0] = bflo(w.x); f[1] = bfhi(w.x); f[2] = bflo(w.y); f[3] = bfhi(w.y); f[4] = bflo(w.z); f[5] = bfhi(w.z); f[6] = bflo(w.w); f[7] = bfhi(w.w); }
__device__ __forceinline__ v4u pack8(const float (&f)[8]) { v4u w; w.x = pkbf(f[0], f[1]); w.y = pkbf(f[2], f[3]); w.z = pkbf(f[4], f[5]); w.w = pkbf(f[6], f[7]); return w; }
__device__ __forceinline__ void ld8f(const float* p, float (&f)[8]) { const f32x4 a = *(const f32x4*)p, b = *(const f32x4*)(p + 4); f[0] = a.x; f[1] = a.y; f[2] = a.z; f[3] = a.w; f[4] = b.x; f[5] = b.y; f[6] = b.z; f[7] = b.w; }
__device__ __forceinline__ void st8f(float* p, const float (&f)[8]) { *(f32x4*)p = (f32x4){f[0], f[1], f[2], f[3]}; *(f32x4*)(p + 4) = (f32x4){f[4], f[5], f[6], f[7]}; }

__device__ __forceinline__ void transpose_item(const float* W, int K, int N, bf16* WT, int k0, int n0, int drow, float scale0, const float* gk, LAS float* scr, int lane) {
    const int kr = lane >> 4, nc = (lane & 15) * 4;
    f32x4 tv[16]; float tg[16];
#pragma unroll
    for (int i = 0; i < 16; ++i) { const int kk = 4 * i + kr; tv[i] = *(const f32x4*)(W + (size_t)(k0 + kk) * N + n0 + nc); tg[i] = gk ? scale0 * gk[k0 + kk] : scale0; }
#pragma unroll
    for (int i = 0; i < 16; ++i) { const int kk = 4 * i + kr; const f32x4 v = tv[i]; const float scale = tg[i];
        LAS float* s = scr + kk * 65 + nc; s[0] = v.x * scale; s[1] = v.y * scale; s[2] = v.z * scale; s[3] = v.w * scale; }
    LDS_WAIT(); asm volatile("" ::: "memory");
    const int c = lane & 7;
#pragma unroll
    for (int j = 0; j < 8; ++j) { const int n = (lane >> 3) + 8 * j; const LAS float* s = scr + (8 * c) * 65 + n;
        v4u o; o.x = pkbf(s[0 * 65], s[1 * 65]); o.y = pkbf(s[2 * 65], s[3 * 65]); o.z = pkbf(s[4 * 65], s[5 * 65]); o.w = pkbf(s[6 * 65], s[7 * 65]);
        *(v4u*)(WT + (size_t)(drow + n) * K + k0 + 8 * c) = o; }
    LDS_WAIT(); asm volatile("" ::: "memory");
}
__device__ __forceinline__ int gu_row(int n, int up) { return 256 * (n >> 7) + (n & 127) + 128 * up; }
__device__ __forceinline__ unsigned q8x4(float a, float b, float c, float d, float inv) {
    const unsigned ua = __float_as_uint(fmaf(a, inv, 12582912.0f)), ub = __float_as_uint(fmaf(b, inv, 12582912.0f)), uc = __float_as_uint(fmaf(c, inv, 12582912.0f)), ud = __float_as_uint(fmaf(d, inv, 12582912.0f));
    const unsigned lo = __builtin_amdgcn_perm(ub, ua, 0x0c0c0400u), hi = __builtin_amdgcn_perm(ud, uc, 0x0c0c0400u);
    return __builtin_amdgcn_perm(hi, lo, 0x05040100u);
}
template <class RowMap>
__device__ __forceinline__ void transpose_matrix(Frame& F, const float* W, int K, int N, bf16* WT, float scale_lo, int sc_n0, int sc_n1, float scale_in, RowMap rm, int& base, const float* gk = nullptr) {
    LAS float* scr = (LAS float*)(F.lds + F.wave * 16640);
    const int nkb = K / 64, nnb = N / 64, nit = nkb * nnb;
    int it = (F.gw - base % F.ngw + F.ngw) % F.ngw;
    for (; it < nit; it += F.ngw) { const int kb = it / nnb, nb = it % nnb, n0 = nb * 64;
        const float sc = (n0 >= sc_n0 && n0 < sc_n1) ? scale_in : scale_lo;
        transpose_item(W, K, N, WT, kb * 64, n0, rm(n0), sc, gk, scr, F.lane); }
    base += nit;
}
struct RmIdent { __device__ __forceinline__ int operator()(int n0) const { return n0; } };
struct RmOff { int off; __device__ __forceinline__ int operator()(int n0) const { return n0 + off; } };
struct RmGU { int up; __device__ __forceinline__ int operator()(int n0) const { return 256 * (n0 >> 7) + (n0 & 127) + 128 * up; } };

__device__ __forceinline__ float wave_max(float v) {
#pragma unroll
    for (int o = 1; o < 64; o <<= 1) v = fmaxf(v, __shfl_xor(v, o));
    return v;
}
__device__ __forceinline__ float quant_row_i8(const f32x4 (&v)[8], unsigned char* o8, int lane) {
    float mx = 0.f;
#pragma unroll
    for (int j = 0; j < 8; ++j) mx = fmaxf(mx, fmaxf(fmaxf(fabsf(v[j].x), fabsf(v[j].y)), fmaxf(fabsf(v[j].z), fabsf(v[j].w))));
    mx = wave_max(mx); const float inv = mx > 0.f ? 127.0f / mx : 0.f;
#pragma unroll
    for (int j = 0; j < 8; ++j) *((unsigned*)o8 + lane + 64 * j) = q8x4(v[j].x, v[j].y, v[j].z, v[j].w, inv);
    return mx * (1.0f / 127.0f);
}
__device__ __forceinline__ void row_to_bf16_rs(Frame& F, const float* xrow, bf16* orow, float* rs, unsigned char* o8) {
    f32x4 v[8]; float s = 0.f;
#pragma unroll
    for (int j = 0; j < 8; ++j) { v[j] = *((const f32x4*)xrow + F.lane + 64 * j); s += (v[j].x * v[j].x + v[j].y * v[j].y) + (v[j].z * v[j].z + v[j].w * v[j].w); }
    const float rstd = 1.0f / sqrtf(wave_sum(s) * (1.0f / DM) + EPS);
#pragma unroll
    for (int j = 0; j < 8; ++j) { u32x2v w; w.x = pkbf(v[j].x, v[j].y); w.y = pkbf(v[j].z, v[j].w); *((u32x2v*)orow + F.lane + 64 * j) = w; }
    const float step = quant_row_i8(v, o8, F.lane);
    if (F.lane == 0) *rs = rstd * step;
}

constexpr int QS_PITCH = 2056;
__device__ __forceinline__ void quant_strips(Frame& F) {
    unsigned char* ws = PWS(); LAS bf16* T = (LAS bf16*)F.lds; LAS float* red = (LAS float*)(F.lds + 32 * QS_PITCH * 2);
    const int G = F.ngw >> 3, vcu = F.gw >> 3, tid = F.tid;
    const int r = tid >> 3, c4 = (tid & 7) * 4;
    constexpr int NSTRIP = 8 * (DFF / 32);
    f32x4 v[2][8]; float gv[2][8];
#define QS_SRC(sI_, W_, gk_) const int mat_##W_ = (sI_) / (DFF / 32), n0_##W_ = ((sI_) - mat_##W_ * (DFF / 32)) * 32, l_##W_ = mat_##W_ >> 2, f_##W_ = (mat_##W_ >> 1) & 1, up_##W_ = mat_##W_ & 1; \
        const float* W_ = PIN(f_##W_ ? 26 + up_##W_ : 8 + up_##W_) + (size_t)l_##W_ * DM * DFF + n0_##W_; const float* gk_ = PIN(f_##W_ ? 25 : 7) + l_##W_ * DM
#define QS_LOAD(b_, W_, gk_) do { int rl_ = r; asm volatile("" : "+v"(rl_));   _Pragma("unroll") for (int it = 0; it < 8; ++it) { const int k = ((b_) * 8 + it) * 64 + rl_; v[(b_) & 1][it] = __builtin_nontemporal_load((const f32x4*)((W_) + (size_t)k * DFF + c4)); gv[(b_) & 1][it] = (gk_)[k]; } } while (0)
#define QS_WRITE(b_) do { _Pragma("unroll") for (int it = 0; it < 8; ++it) { const int k = ((b_) * 8 + it) * 64 + r; const f32x4 w = v[(b_) & 1][it] * gv[(b_) & 1][it]; const unsigned p0 = pkbf(w.x, w.y), p1 = pkbf(w.z, w.w); \
              LAS bf16* t_ = T + c4 * QS_PITCH + k; t_[0] = (bf16)p0; t_[QS_PITCH] = (bf16)(p0 >> 16); t_[2 * QS_PITCH] = (bf16)p1; t_[3 * QS_PITCH] = (bf16)(p1 >> 16); } } while (0)
#define QS_BAR() do { LDS_WAIT(); __builtin_amdgcn_s_barrier(); asm volatile("" ::: "memory"); } while (0)
    if (vcu < NSTRIP) { QS_SRC(vcu, W0, gk0); QS_LOAD(0, W0, gk0); }
    for (int sI = vcu; sI < NSTRIP; sI += G) {
        const int mat = sI / (DFF / 32), n0 = (sI - mat * (DFF / 32)) * 32, l = mat >> 2, f = (mat >> 1) & 1, up = mat & 1;
        unsigned char* WT = ws + WS_W + (size_t)l * W_LAYER + (f ? W_GU2 : W_GU1); float* cmax = (float*)(ws + WS_CS) + (size_t)(l * 2 + f) * 2 * DFF;
        { QS_SRC(sI, W, gk);
          QS_LOAD(1, W, gk); __builtin_amdgcn_sched_barrier(0);
          QS_WRITE(0); QS_LOAD(2, W, gk); __builtin_amdgcn_sched_barrier(0);
          QS_WRITE(1); QS_LOAD(3, W, gk); __builtin_amdgcn_sched_barrier(0);
          QS_WRITE(2); QS_WRITE(3); __builtin_amdgcn_sched_barrier(0); }
        if (sI + G < NSTRIP) { QS_SRC(sI + G, Wn, gkn); QS_LOAD(0, Wn, gkn); }
        QS_BAR();
        v4u q[8][2]; float mx[8];
#pragma unroll
        for (int j = 0; j < 8; ++j) { const LAS v4u* p_ = (const LAS v4u*)(T + (4 * j + (tid >> 7)) * QS_PITCH + 16 * (tid & 127)); float m = 0.f;
#pragma unroll
            for (int e = 0; e < 2; ++e) { q[j][e] = p_[e]; float x[8]; unpack8(q[j][e], x);
#pragma unroll
                for (int i = 0; i < 8; ++i) m = fmaxf(m, fabsf(x[i])); }
            mx[j] = wave_max(m); }
        if (F.lane == 0) {
#pragma unroll
            for (int j = 0; j < 8; ++j) red[(4 * j + (tid >> 7)) * 2 + (F.wave & 1)] = mx[j]; }
        QS_BAR();
#pragma unroll
        for (int j = 0; j < 8; ++j) { const int c = 4 * j + (tid >> 7), row = gu_row(n0 + c, up); const float cm = fmaxf(red[2 * c], red[2 * c + 1]), inv = cm > 0.f ? 127.0f / cm : 0.f;
            float x[8], y[8]; unpack8(q[j][0], x); unpack8(q[j][1], y);
            v4u o; o.x = q8x4(x[0], x[1], x[2], x[3], inv); o.y = q8x4(x[4], x[5], x[6], x[7], inv); o.z = q8x4(y[0], y[1], y[2], y[3], inv); o.w = q8x4(y[4], y[5], y[6], y[7], inv);
            *(v4u*)(WT + (size_t)row * DM + 16 * (tid & 127)) = o;
            if ((tid & 127) == 0) cmax[row] = cm; }
        QS_BAR();
    }
#undef QS_SRC
#undef QS_LOAD
#undef QS_WRITE
#undef QS_BAR
}

__device__ __forceinline__ void p0_prologue(Frame& F) {
    unsigned char* ws = PWS();
    int base = 0;
    for (int l = 0; l < DEPTH; ++l) {
        unsigned char* wl = ws + WS_W + (size_t)l * W_LAYER;
        if (l == 0 || F.ngw != 2048) {
        transpose_matrix(F, PIN(10) + (size_t)l * DFF * DM, DFF, DM, (bf16*)(wl + W_D1), 1.f, 0, 0, 1.f, RmIdent{}, base);
        transpose_matrix(F, PIN(28) + (size_t)l * DFF * DM, DFF, DM, (bf16*)(wl + W_D2), 1.f, 0, 0, 1.f, RmIdent{}, base); }
        transpose_matrix(F, PIN(13) + (size_t)l * DM * DIN, DM, DIN, (bf16*)(wl + W_IN), 1.f, ZC_QSB, ZC_KSB, SB_QSCALE, RmIdent{}, base, PIN(12) + l * DM);
        transpose_matrix(F, PIN(16) + (size_t)l * 512 * 1536, 512, 1536, (bf16*)(wl + W_UQ), MLA_QSCALE, 0, 0, 1.f, RmIdent{}, base);
        transpose_matrix(F, PIN(17) + (size_t)l * 512 * 1024, 512, 1024, (bf16*)(wl + W_UKV), 1.f, 0, 0, 1.f, RmIdent{}, base);
        transpose_matrix(F, PIN(18) + (size_t)l * 512 * 1024, 512, 1024, (bf16*)(wl + W_UKV), 1.f, 0, 0, 1.f, RmOff{1024}, base);
        transpose_matrix(F, PIN(23) + (size_t)l * DM * DM, DM, DM, (bf16*)(wl + W_O), 1.f, 0, 0, 1.f, RmIdent{}, base);
        { v4u* p = (v4u*)(wl + W_IN + (size_t)DIN * DM * 2); const int n16 = (DINP - DIN) * DM * 2 / 16;
          for (int i = F.gw * 64 + F.lane; i < n16; i += F.ngw * 64) p[i] = (v4u){0u, 0u, 0u, 0u}; }
    }
    { float* ct = (float*)(ws + WS_ROPE); float* st = ct + 4096 * 32;
      for (int i = F.gw * 64 + F.lane; i < 4096 * 32; i += F.ngw * 64) { const int pos = i >> 5, k = i & 31;
          const float inv = powf(10000.0f, -(float)k * (1.0f / 32.0f)); const float ang = (float)pos * inv; ct[i] = cosf(ang); st[i] = sinf(ang); } }
    for (int l = 0; l < DEPTH; ++l) {
        unsigned char* cl = ws + WS_C + (size_t)l * C_LAYER;
        { const float* src = PIN(2) + (size_t)l * 16 * 2048 * 512; bf16* dst = (bf16*)(cl + C_CKV);
          const bool skew = (F.ngw == 2048); const int ntrip = skew ? (F.gw < 1024 ? 1 : 3) : (4096 - F.gw + F.ngw - 1) / F.ngw;
          for (int ti = 0; ti < ntrip; ++ti) { const int r0 = 8 * (skew ? (F.gw < 1024 ? F.gw : 1024 + 3 * (F.gw - 1024) + ti) : F.gw + ti * F.ngw); float f[8][8];
#pragma unroll
              for (int u = 0; u < 8; ++u) ld8f(src + (size_t)(r0 + u) * 512 + 8 * F.lane, f[u]);
#pragma unroll
              for (int u = 0; u < 8; ++u) { const int r = r0 + u, s = r >> 11, p = r & 2047; *(v4u*)(dst + (size_t)(8192 + s * 2112 + p) * 512 + 8 * F.lane) = pack8(f[u]); } } }
        { const float* src = PIN(3) + (size_t)l * 16 * 2048 * 64; unsigned char* dst = cl + C_KR;
          for (int it = F.gw; it < 16 * 32; it += F.ngw) { const int s = it >> 5, t = it & 31, tile = 128 + 33 * s + t; const float* rp = src + ((size_t)s * 2048 + t * 64 + F.lane) * 64;
              float f[8][8];
#pragma unroll
              for (int c = 0; c < 8; ++c) ld8f(rp + 8 * c, f[c]);
#pragma unroll
              for (int c = 0; c < 8; ++c) *(v4u*)(dst + ((size_t)(tile * 8 + c) * 64 + F.lane) * 16) = pack8(f[c]); } }
    }
    { bf16* hb = (bf16*)(ws + WS_HB); float* rs = (float*)(ws + WS_RS);
      for (int m = (F.gw + F.ngw / 2) % F.ngw; m < MT; m += F.ngw) {   const float* xr = m < TP ? PIN(0) + (size_t)m * DM : PIN(1) + (size_t)(m - TP) * DM; row_to_bf16_rs(F, xr, hb + (size_t)m * DM, rs + m, ws + WS_HB8 + (size_t)m * DM); } }
}

__device__ __forceinline__ void deferred_down_weights(Frame& F) {
    const int bid = (int)blockIdx.x; if (bid < 48 || F.ngw != 2048) return;
    Frame F2 = F; F2.gw = (bid - 48) * NWAVES + F.wave; F2.ngw = ((int)gridDim.x - 48) * NWAVES;
    unsigned char* wl = PWS() + WS_W + (size_t)1 * W_LAYER; int base = 0;
    transpose_matrix(F2, PIN(10) + (size_t)1 * DFF * DM, DFF, DM, (bf16*)(wl + W_D1), 1.f, 0, 0, 1.f, RmIdent{}, base);
    transpose_matrix(F2, PIN(28) + (size_t)1 * DFF * DM, DFF, DM, (bf16*)(wl + W_D2), 1.f, 0, 0, 1.f, RmIdent{}, base);
}

template <bool IN32> struct NormHRaw;
template <> struct NormHRaw<true> { typedef f32x4 T; static __device__ __forceinline__ T ld(const void* p, int i) { return *((const f32x4*)p + i); } static __device__ __forceinline__ f32x4 cvt(const T& w) { return w; } };
template <> struct NormHRaw<false> { typedef u32x2v T; static __device__ __forceinline__ T ld(const void* p, int i) { return *((const u32x2v*)p + i); } static __device__ __forceinline__ f32x4 cvt(const T& w) { return (f32x4){bflo(w.x), bfhi(w.x), bflo(w.y), bfhi(w.y)}; } };
template <bool IN32, bool OUT32>
__device__ __forceinline__ void norm_phase(Frame& F, const bf16* f, const bf16* f1, const void* hin_p, const void* hin_s, float coef, const float* g1, float* rs, void* hout, unsigned char* h8 = nullptr) {
    const bool deal = (F.ngw == 2048);
    const int nrow = deal ? (F.gw < 1024 ? 4 : 5) : (MT - F.gw + F.ngw - 1) / F.ngw;
#define NP_ROW(it_) (deal ? (F.gw < 1024 ? ((it_) == 0 ? TP + F.gw : 3 * F.gw + (it_) - 1) : 3072 + 5 * (F.gw - 1024) + (it_)) : F.gw + (it_) * F.ngw)
    typedef typename NormHRaw<IN32>::T HRaw;
    f32x4 gv[8]; u32x2v nf[8]; HRaw nh[8];
#pragma unroll
    for (int j = 0; j < 8; ++j) gv[j] = *((const f32x4*)g1 + F.lane + 64 * j);
#define NP_ISSUE(m_) do { const bf16* fr_ = f + (size_t)(m_) * DM; _Pragma("unroll") for (int j = 0; j < 8; ++j) nf[j] = *((const u32x2v*)fr_ + F.lane + 64 * j); \
        if (IN32) { const float* hr_ = (m_) < TP ? (const float*)hin_p + (size_t)(m_) * DM : (const float*)hin_s + (size_t)((m_) - TP) * DM; _Pragma("unroll") for (int j = 0; j < 8; ++j) nh[j] = NormHRaw<IN32>::ld(hr_, F.lane + 64 * j); } \
        else { const bf16* hr_ = (const bf16*)hin_p + (size_t)(m_) * DM; _Pragma("unroll") for (int j = 0; j < 8; ++j) nh[j] = NormHRaw<IN32>::ld(hr_, F.lane + 64 * j); } } while (0)
    if (nrow > 0) { const int m0_ = NP_ROW(0); NP_ISSUE(m0_); }
    for (int it = 0; it < nrow; ++it) {
        const int m = NP_ROW(it);
        f32x4 v[8], hv[8]; float s = 0.f;
#pragma unroll
        for (int j = 0; j < 8; ++j) { const u32x2v w = nf[j]; v[j] = (f32x4){bflo(w.x), bfhi(w.x), bflo(w.y), bfhi(w.y)}; hv[j] = NormHRaw<IN32>::cvt(nh[j]); }
        if (it + 1 < nrow) { const int mn_ = NP_ROW(it + 1); NP_ISSUE(mn_); }
        if (m >= TP) { const bf16* pr = f1 + (size_t)(m - TP) * DM;
            u32x2v pw[4][8];
#pragma unroll
            for (int p = 0; p < 4; ++p)
#pragma unroll
                for (int j = 0; j < 8; ++j) pw[p][j] = *((const u32x2v*)(pr + (size_t)p * 1024 * DM) + F.lane + 64 * j);
#pragma unroll
            for (int p = 0; p < 4; ++p)
#pragma unroll
                for (int j = 0; j < 8; ++j) v[j] = v[j] + (f32x4){bflo(pw[p][j].x), bfhi(pw[p][j].x), bflo(pw[p][j].y), bfhi(pw[p][j].y)};
#pragma unroll
            for (int p = 0; p < 3; ++p)
#pragma unroll
                for (int j = 0; j < 8; ++j) pw[p][j] = *((const u32x2v*)(pr + (size_t)(4 + p) * 1024 * DM) + F.lane + 64 * j);
#pragma unroll
            for (int p = 0; p < 3; ++p)
#pragma unroll
                for (int j = 0; j < 8; ++j) v[j] = v[j] + (f32x4){bflo(pw[p][j].x), bfhi(pw[p][j].x), bflo(pw[p][j].y), bfhi(pw[p][j].y)}; }
#pragma unroll
        for (int j = 0; j < 8; ++j) s += (v[j].x * v[j].x + v[j].y * v[j].y) + (v[j].z * v[j].z + v[j].w * v[j].w);
        const float rstd = coef / sqrtf(wave_sum(s) * (1.0f / DM) + EPS); float s2 = 0.f;
#pragma unroll
        for (int j = 0; j < 8; ++j) { const f32x4 gg = gv[j]; hv[j] = hv[j] + v[j] * gg * rstd;
            if (OUT32) *((f32x4*)((float*)hout + (size_t)m * DM) + F.lane + 64 * j) = hv[j];
            else { u32x2v w; w.x = pkbf(hv[j].x, hv[j].y); w.y = pkbf(hv[j].z, hv[j].w); *((u32x2v*)((bf16*)hout + (size_t)m * DM) + F.lane + 64 * j) = w; }
            s2 += (hv[j].x * hv[j].x + hv[j].y * hv[j].y) + (hv[j].z * hv[j].z + hv[j].w * hv[j].w); }
        if (rs) { float r2 = 1.0f / sqrtf(wave_sum(s2) * (1.0f / DM) + EPS); if (h8) r2 *= quant_row_i8(hv, h8 + (size_t)m * DM, F.lane); if (F.lane == 0) rs[m] = r2; }
    }
}
#undef NP_ROW
#undef NP_ISSUE

__device__ __forceinline__ void postz_phase(Frame& F, int l) {
    unsigned char* ws = PWS(); const bf16* Z = (const bf16*)(ws + WS_Z); bf16* CQN = (bf16*)(ws + WS_CQN); bf16* MRG = (bf16*)(ws + WS_XN);
    unsigned char* cl = ws + WS_C + (size_t)l * C_LAYER; bf16* CKV = (bf16*)(cl + C_CKV);
    const float* ctab = (const float*)(ws + WS_ROPE); const float* stab = ctab + 4096 * 32;
    const float* gq = PIN(14) + l * 512; const float* gkv = PIN(15) + l * 512; const float* cw = PIN(19) + l * 3 * 512; const float* gcv = PIN(21) + l * 512;
    float* out = POUT(); const int L8 = 8 * F.lane;
    float gq8[8], gkv8[8], gcv8[8], w0[8], w1[8], w2[8];
    ld8f(gq + L8, gq8); ld8f(gkv + L8, gkv8); ld8f(gcv + L8, gcv8); ld8f(cw + L8, w0); ld8f(cw + 512 + L8, w1); ld8f(cw + 1024 + L8, w2);
    for (int r = F.gw; r < MT; r += F.ngw) {
        const bool smp = r >= TP; const int b = smp ? (r - TP) >> 6 : r >> 12, t = smp ? (r - TP) & 63 : r & 4095, pos = smp ? 2048 + t : t;
        const int g = smp ? 8192 + b * 2112 + 2048 + t : r, tile = g >> 6, kap = g & 63;
        const bf16* zr = Z + (size_t)r * DINP;
        const v4u zq = *(const v4u*)(zr + ZC_CQ + L8), zkv = *(const v4u*)(zr + ZC_CKV + L8), zkr = *(const v4u*)(zr + ZC_KR + 8 * (F.lane & 7));
        const v4u zgc2 = *(const v4u*)(zr + ZC_GC + L8), zxc2 = *(const v4u*)(zr + ZC_XC + L8), zgb = *(const v4u*)(zr + ZC_GB + L8), zks = *(const v4u*)(zr + ZC_KSB + L8), zvs = *(const v4u*)(zr + ZC_VSB + L8);
        v4u zgc1 = (v4u){0u, 0u, 0u, 0u}, zxc1 = zgc1, zgc0 = zgc1, zxc0 = zgc1;
        float rc8[8], rs8[8]; ld8f(ctab + pos * 32 + 8 * (F.lane & 3), rc8); ld8f(stab + pos * 32 + 8 * (F.lane & 3), rs8);
        if (t >= 1) { zgc1 = *(const v4u*)(zr - DINP + ZC_GC + L8); zxc1 = *(const v4u*)(zr - DINP + ZC_XC + L8); }
        if (t >= 2) { zgc0 = *(const v4u*)(zr - 2 * DINP + ZC_GC + L8); zxc0 = *(const v4u*)(zr - 2 * DINP + ZC_XC + L8); }
        { float f[8]; unpack8(zq, f); float s = 0.f;
#pragma unroll
          for (int i = 0; i < 8; ++i) s += f[i] * f[i];
          const float rs = 1.0f / sqrtf(wave_sum(s) * (1.0f / 512) + EPS);
#pragma unroll
          for (int i = 0; i < 8; ++i) f[i] = f[i] * rs * gq8[i];
          *(v4u*)(CQN + (size_t)r * 512 + L8) = pack8(f); }
        { float f[8]; unpack8(zkv, f); float s = 0.f;
#pragma unroll
          for (int i = 0; i < 8; ++i) s += f[i] * f[i];
          const float rs = 1.0f / sqrtf(wave_sum(s) * (1.0f / 512) + EPS);
#pragma unroll
          for (int i = 0; i < 8; ++i) f[i] = f[i] * rs * gkv8[i];
          float* op = smp ? out + O_CKV_S + ((size_t)(l * 16 + b) * 64 + t) * 512 : out + O_CKV_P + ((size_t)(l * 2 + b) * 4096 + t) * 512;
          st8f(op + L8, f); *(v4u*)(CKV + (size_t)g * 512 + L8) = pack8(f); }
        { float f[8], p[8]; const int lz = F.lane & 7; unpack8(zkr, f);
#pragma unroll
          for (int i = 0; i < 8; ++i) p[i] = __shfl_xor(f[i], 4);
#pragma unroll
          for (int i = 0; i < 8; ++i) f[i] = (lz < 4) ? f[i] * rc8[i] - p[i] * rs8[i] : f[i] * rc8[i] + p[i] * rs8[i];
          if (F.lane < 8) { float* op = smp ? out + O_KR_S + ((size_t)(l * 16 + b) * 64 + t) * 64 : out + O_KR_P + ((size_t)(l * 2 + b) * 4096 + t) * 64;
              st8f(op + 8 * F.lane, f); *(v4u*)(cl + C_KR + ((size_t)(tile * 8 + F.lane) * 64 + kap) * 16) = pack8(f); } }
        { float uc0[8], uc1[8], uc2[8];
          { float a[8], x[8]; unpack8(zgc2, a); unpack8(zxc2, x);
#pragma unroll
            for (int i = 0; i < 8; ++i) uc2[i] = a[i] * x[i]; }
          if (t >= 1) { float a[8], x[8]; unpack8(zgc1, a); unpack8(zxc1, x);
#pragma unroll
            for (int i = 0; i < 8; ++i) uc1[i] = a[i] * x[i]; }
          else if (smp) ld8f(PIN(6) + ((size_t)(l * 16 + b) * 2 + 1) * 512 + L8, uc1);
          else {
#pragma unroll
            for (int i = 0; i < 8; ++i) uc1[i] = 0.f; }
          if (t >= 2) { float a[8], x[8]; unpack8(zgc0, a); unpack8(zxc0, x);
#pragma unroll
            for (int i = 0; i < 8; ++i) uc0[i] = a[i] * x[i]; }
          else if (smp) ld8f(PIN(6) + ((size_t)(l * 16 + b) * 2 + t) * 512 + L8, uc0);
          else {
#pragma unroll
            for (int i = 0; i < 8; ++i) uc0[i] = 0.f; }
          float gb[8], y[8]; unpack8(zgb, gb); float s = 0.f;
#pragma unroll
          for (int i = 0; i < 8; ++i) { y[i] = gb[i] * ((w0[i] * uc0[i] + w1[i] * uc1[i]) + w2[i] * uc2[i]); s += y[i] * y[i]; }
          const float rs = 1.0f / sqrtf(wave_sum(s) * (1.0f / 512) + EPS);
#pragma unroll
          for (int i = 0; i < 8; ++i) y[i] = y[i] * rs * gcv8[i];
          *(v4u*)(MRG + (size_t)r * DM + 1024 + L8) = pack8(y);
          const int S = smp ? 64 : 4096;
          if (t >= S - 2) { float* op = smp ? out + O_CONV_S + ((size_t)(l * 16 + b) * 2 + (t - (S - 2))) * 512 : out + O_CONV_P + ((size_t)(l * 2 + b) * 2 + (t - (S - 2))) * 512; st8f(op + L8, uc2); } }
        { float f[8]; const v4u kw = zks; unpack8(kw, f);
          float* op = smp ? out + O_SBK_S + ((size_t)(l * 16 + b) * 64 + t) * 512 : out + O_SBK_P + ((size_t)(l * 2 + b) * 4096 + t) * 512; st8f(op + L8, f);
          *(v4u*)(cl + C_KSB + ((size_t)((tile * 4 + (F.lane >> 4)) * 16 + (F.lane & 15)) * 64 + kap) * 16) = kw;
          unpack8(zvs, f);
          op = smp ? out + O_SBV_S + ((size_t)(l * 16 + b) * 64 + t) * 512 : out + O_SBV_P + ((size_t)(l * 2 + b) * 4096 + t) * 512; st8f(op + L8, f); }
    }
    { LAS unsigned char* tl = F.lds + F.wave * 17408;
      for (int it = (F.gw + F.ngw / 2) % F.ngw; it < 144 * 4; it += F.ngw) {   const int h = it & 3, ti = it >> 2; const int r0 = ti < 128 ? ti * 64 : TP + (ti - 128) * 64, tile = ti < 128 ? ti : 128 + 33 * (ti - 128) + 32;
          const bf16* zp = Z + (size_t)r0 * DINP + ZC_VSB + h * 128; const int kr = F.lane >> 4, c16 = F.lane & 15;
          v4u tw[16];
#pragma unroll
          for (int i = 0; i < 16; ++i) tw[i] = *(const v4u*)(zp + (size_t)(4 * i + kr) * DINP + 8 * c16);
#pragma unroll
          for (int i = 0; i < 16; ++i) { const int key = 4 * i + kr; *(LAS v4u*)(tl + key * 272 + c16 * 16) = tw[i]; }
          LDS_WAIT(); asm volatile("" ::: "memory");
#pragma unroll
          for (int dh = 0; dh < 2; ++dh) { const int d = dh * 64 + F.lane;
#pragma unroll
              for (int P = 0; P < 8; ++P) { unsigned e[8];
#pragma unroll
                  for (int j = 0; j < 8; ++j) { const int key = 16 * (P >> 1) + 4 * (P & 1) + (j < 4 ? j : j + 4); e[j] = *(const LAS unsigned short*)(tl + key * 272 + d * 2); }
                  v4u o; o.x = e[0] | (e[1] << 16); o.y = e[2] | (e[3] << 16); o.z = e[4] | (e[5] << 16); o.w = e[6] | (e[7] << 16);
                  *(v4u*)(cl + C_VTSB + ((size_t)((tile * 4 + h) * 8 + P) * 128 + d) * 16) = o; } }
          LDS_WAIT(); asm volatile("" ::: "memory"); } }
}

__device__ __forceinline__ void postattn_phase(Frame& F, int l) {
    const bf16* Y = (const bf16*)(PWS() + WS_YATT); bf16* MRG = (bf16*)(PWS() + WS_XN); const float* PO = (const float*)(PWS() + WS_PO); const float* PML = (const float*)(PWS() + WS_PML);
    const float* gm = PIN(20) + l * 1024; const float* gs = PIN(22) + l * 512; const int L8 = 8 * F.lane;
    float g0[8], g1[8], g2[8]; ld8f(gm + L8, g0); ld8f(gm + 512 + L8, g1); ld8f(gs + L8, g2);
    for (int r = F.gw; r < MT; r += F.ngw) {
        const bf16* yr = Y + (size_t)r * YW; float a[8], b[8], c[8];
        if (r >= TP) {
            const int sI = (r - TP) >> 6, rr = (r - TP) & 63;
#pragma unroll
            for (int hh = 0; hh < 2; ++hh) { const int h = 4 * hh + (F.lane >> 4); const size_t pu = (size_t)((sI * 8 + h) * 3);
                float mp[3], lp[3], mm = -INFINITY;
#pragma unroll
                for (int p = 0; p < 3; ++p) { mp[p] = PML[((pu + p) * 64 + rr) * 2]; lp[p] = PML[((pu + p) * 64 + rr) * 2 + 1]; mm = fmaxf(mm, mp[p]); }
                float acc[8], den = 0.f;
#pragma unroll
                for (int i = 0; i < 8; ++i) acc[i] = 0.f;
#pragma unroll
                for (int p = 0; p < 3; ++p) { const float w = __builtin_amdgcn_exp2f(mp[p] - mm); den += lp[p] * w; float x[8]; ld8f(PO + ((pu + p) * 64 + rr) * 128 + 8 * (F.lane & 15), x);
#pragma unroll
                    for (int i = 0; i < 8; ++i) acc[i] += x[i] * w; }
                const float inv = 1.0f / den;
#pragma unroll
                for (int i = 0; i < 8; ++i) { if (hh) b[i] = acc[i] * inv; else a[i] = acc[i] * inv; } }
        } else if (((r & 4095) >> 8) >= 12) {
            const int qb = (r & 4095) >> 8, bI = r >> 12, rr = r & 255;
            const bf16* PO16 = (const bf16*)(PWS() + WS_PO16); const float* PML16 = (const float*)(PWS() + WS_PML16);
#pragma unroll
            for (int hh = 0; hh < 2; ++hh) { const int h = 4 * hh + (F.lane >> 4); const size_t pu = (size_t)((bI * 8 + h) * 8 + 2 * (qb - 12));
                const float m0 = PML16[(pu * 256 + rr) * 2], l0 = PML16[(pu * 256 + rr) * 2 + 1], m1 = PML16[((pu + 1) * 256 + rr) * 2], l1 = PML16[((pu + 1) * 256 + rr) * 2 + 1];
                const float mm = fmaxf(m0, m1), w0 = __builtin_amdgcn_exp2f(m0 - mm), w1 = __builtin_amdgcn_exp2f(m1 - mm), inv = 1.0f / (l0 * w0 + l1 * w1);
                float x0[8], x1[8]; unpack8(*(const v4u*)(PO16 + (pu * 256 + rr) * 128 + 8 * (F.lane & 15)), x0); unpack8(*(const v4u*)(PO16 + ((pu + 1) * 256 + rr) * 128 + 8 * (F.lane & 15)), x1);
#pragma unroll
                for (int i = 0; i < 8; ++i) { const float v = (x0[i] * w0 + x1[i] * w1) * inv; if (hh) b[i] = v; else a[i] = v; } }
        } else { unpack8(*(const v4u*)(yr + L8), a); unpack8(*(const v4u*)(yr + 512 + L8), b); }
        unpack8(*(const v4u*)(yr + 1024 + L8), c);
        float s1 = 0.f, s2 = 0.f;
#pragma unroll
        for (int i = 0; i < 8; ++i) { s1 += a[i] * a[i] + b[i] * b[i]; s2 += c[i] * c[i]; }
        const float r1 = 1.0f / sqrtf(wave_sum(s1) * (1.0f / 1024) + EPS), r2 = 1.0f / sqrtf(wave_sum(s2) * (1.0f / 512) + EPS);
#pragma unroll
        for (int i = 0; i < 8; ++i) { a[i] = a[i] * r1 * g0[i]; b[i] = b[i] * r1 * g1[i]; c[i] = c[i] * r2 * g2[i]; }
        bf16* mr = MRG + (size_t)r * DM; *(v4u*)(mr + L8) = pack8(a); *(v4u*)(mr + 512 + L8) = pack8(b); *(v4u*)(mr + 1536 + L8) = pack8(c);
    }
}

struct AttnJob {
    const bf16* q; int qpitch; int nrows; int pos0;
    const unsigned char* kA; int kA_ts; const unsigned char* kB; int kB_ts; const unsigned char* vt; int vt_ts;
    int ntiles; bf16* out; int opitch;
    int t0; bf16* po; float* pml;
    const float* kc; const float* vc; int ncache;
};
constexpr int ATT_BUF = 40960, ATT_K = 0, ATT_KB = 16384, ATT_V = 24576, ATT_FLAGS = 139264, ATT_QWORD = ATT_FLAGS + 64;
constexpr int S4_KR = 65536, S4_V = 73728;
#define ATT_GLDS(gp, loff) __builtin_amdgcn_global_load_lds((const unsigned*)(gp), (LAS unsigned*)(lds + (loff)), 16, 0, 0)
#define ATT_MFMA(a, b, c) __builtin_amdgcn_mfma_f32_32x32x16_bf16((a), (b), (c), 0, 0, 0)

template <bool SB>
__device__ __forceinline__ void attn_issue(LAS unsigned char* lds, const AttnJob& J, int t, int buf, int wid, int lane) {
    const int lb = buf * ATT_BUF;
    const unsigned char* ka = J.kA + (size_t)t * J.kA_ts + wid * 2048 + lane * 16;
    ATT_GLDS(ka, lb + ATT_K + wid * 2048); ATT_GLDS(ka + 1024, lb + ATT_K + wid * 2048 + 1024);
    if (!SB) { const unsigned char* kb = J.kB + (size_t)t * J.kB_ts + wid * 1024 + lane * 16; ATT_GLDS(kb, lb + ATT_KB + wid * 1024); }
    const unsigned char* vp = J.vt + (size_t)t * J.vt_ts + wid * 2048 + lane * 16;
    ATT_GLDS(vp, lb + ATT_V + wid * 2048); ATT_GLDS(vp + 1024, lb + ATT_V + wid * 2048 + 1024);
}

__device__ __forceinline__ void attn_stage_cache(LAS unsigned char* lds, const AttnJob& J, int t, int buf, int tid) {
    const int lb = buf * ATT_BUF;
    { const int key = tid & 63, cg = tid >> 6; const float* kp = J.kc + (size_t)(64 * t + key) * 512;
#pragma unroll
      for (int i = 0; i < 2; ++i) { const int c = cg + 8 * i; float f[8]; ld8f(kp + 8 * c, f); *(LAS v4u*)(lds + lb + ATT_K + (c * 64 + key) * 16) = pack8(f); } }
    { const int d = tid & 127, pq = tid >> 7; const float* vp = J.vc + (size_t)(64 * t) * 512 + d;
#pragma unroll
      for (int i = 0; i < 2; ++i) { const int P = pq + 4 * i; float f[8];
#pragma unroll
          for (int j = 0; j < 8; ++j) { const int key = 16 * (P >> 1) + 4 * (P & 1) + (j < 4 ? j : j + 4); f[j] = vp[(size_t)key * 512]; }
          *(LAS v4u*)(lds + lb + ATT_V + (P * 128 + d) * 16) = pack8(f); } }
}

template <bool SB>
__device__ __forceinline__ void attn_unit(LAS unsigned char* lds, const AttnJob& J, const float* ctab, const float* stab, int wid, int lane) {
    constexpr int NQ = SB ? 8 : 12;
    const int r32 = lane & 31, hi = lane >> 5, r0 = wid * 32;
    const bool active = r0 < J.nrows;
    const int nt = J.ntiles;
    const int ncache = SB ? J.ncache : 0;
    if (!SB || nt - 1 >= ncache) attn_issue<SB>(lds, J, SB ? nt - 1 : 0, 0, wid, lane);
    bf16x8 qf[NQ];
    const int qpos = J.pos0 + r0 + r32;
    if (active) {
        const bf16* qp = J.q + (size_t)(r0 + r32) * J.qpitch + 8 * hi;
#pragma unroll
        for (int d0 = 0; d0 < NQ; ++d0) qf[d0] = *(const bf16x8*)(qp + 16 * d0);
        if (!SB) {
#pragma unroll
            for (int fi = 0; fi < 2; ++fi) {
                float x1[8], x2[8], c[8], s[8]; unpack8(__builtin_bit_cast(v4u, qf[8 + fi]), x1); unpack8(__builtin_bit_cast(v4u, qf[10 + fi]), x2);
                ld8f(ctab + qpos * 32 + 16 * fi + 8 * hi, c); ld8f(stab + qpos * 32 + 16 * fi + 8 * hi, s);
                float o1[8], o2[8];
#pragma unroll
                for (int j = 0; j < 8; ++j) { o1[j] = x1[j] * c[j] - x2[j] * s[j]; o2[j] = x2[j] * c[j] + x1[j] * s[j]; }
                qf[8 + fi] = __builtin_bit_cast(bf16x8, pack8(o1)); qf[10 + fi] = __builtin_bit_cast(bf16x8, pack8(o2));
            }
        }
    } else {
#pragma unroll
        for (int d0 = 0; d0 < NQ; ++d0) qf[d0] = (bf16x8){0, 0, 0, 0, 0, 0, 0, 0};
    }
    f32x16 o[4];
#pragma unroll
    for (int db = 0; db < 4; ++db)
#pragma unroll
        for (int r = 0; r < 16; ++r) o[db][r] = 0.f;
    float m_run = -INFINITY, l_run = 0.f, R = 0.f;
    const int wave_lim = SB ? 0 : ((J.pos0 + r0) >> 6);
    const int max_qp = J.pos0 + r0 + 31;
    for (int i = 0; i < nt; ++i) {
        const int t = SB ? nt - 1 - i : i;
        if (SB) {
            const bool nxt_dma = (i + 1 < nt) && (t - 1 >= ncache);
            if (nxt_dma) attn_issue<SB>(lds, J, t - 1, (i + 1) & 1, wid, lane);
            if (t >= ncache) { if (nxt_dma) asm volatile("s_waitcnt vmcnt(4)" ::: "memory"); else asm volatile("s_waitcnt vmcnt(0)" ::: "memory"); }
            else { attn_stage_cache(lds, J, t, i & 1, (int)threadIdx.x); asm volatile("s_waitcnt vmcnt(0) lgkmcnt(0)" ::: "memory"); }
        } else {
            if (i + 1 < nt) { attn_issue<SB>(lds, J, t + 1, (i + 1) & 1, wid, lane); asm volatile("s_waitcnt vmcnt(5)" ::: "memory"); }
            else asm volatile("s_waitcnt vmcnt(0)" ::: "memory");
        }
        __builtin_amdgcn_s_barrier(); asm volatile("" ::: "memory");
        const bool work = active && (SB ? (64 * t < max_qp) : (t + J.t0 <= wave_lim));
        if (work) {
            LAS unsigned char* kbuf = lds + (i & 1) * ATT_BUF + hi * 1024 + r32 * 16;
            LAS unsigned char* vbuf = lds + (i & 1) * ATT_BUF + ATT_V + hi * 2048 + r32 * 16;
            f32x16 s0, s1;
#pragma unroll
            for (int r = 0; r < 16; ++r) { s0[r] = 0.f; s1[r] = 0.f; }
            bf16x8 ka[2][4];
#define ATT_RDK(buf, dbase) do { _Pragma("unroll") for (int j_ = 0; j_ < 2; ++j_) { ka[buf][2 * j_] = *(const LAS bf16x8*)(kbuf + ((dbase) + j_) * 2048); ka[buf][2 * j_ + 1] = *(const LAS bf16x8*)(kbuf + ((dbase) + j_) * 2048 + 512); } } while (0)
#define ATT_MMK(buf, dbase) do { _Pragma("unroll") for (int j_ = 0; j_ < 2; ++j_) { s0 = ATT_MFMA(ka[buf][2 * j_], qf[(dbase) + j_], s0); s1 = ATT_MFMA(ka[buf][2 * j_ + 1], qf[(dbase) + j_], s1); } } while (0)
#define ATT_RDV(buf, g) do { _Pragma("unroll") for (int db_ = 0; db_ < 4; ++db_) ka[buf][db_] = *(const LAS bf16x8*)(vbuf + (g) * 4096 + db_ * 512); } while (0)
#define ATT_MMV(buf, g) do { _Pragma("unroll") for (int db_ = 0; db_ < 4; ++db_) o[db_] = ATT_MFMA(ka[buf][db_], pb[g], o[db_]); } while (0)
#define ATT_SB0 __builtin_amdgcn_sched_barrier(0)
            ATT_RDK(0, 0); ATT_SB0;
            ATT_RDK(1, 2); ATT_MMK(0, 0); ATT_SB0;
            ATT_RDK(0, 4); ATT_MMK(1, 2); ATT_SB0;
            ATT_RDK(1, 6); ATT_MMK(0, 4); ATT_SB0;
            if (NQ == 12) { ATT_RDK(0, 8); ATT_MMK(1, 6); ATT_SB0;
                            ATT_RDK(1, 10); ATT_MMK(0, 8); ATT_SB0;
                            ATT_RDV(0, 0); ATT_MMK(1, 10); ATT_SB0; }
            else          { ATT_MMK(1, 6); ATT_SB0; }
            if (!SB) {
                float mx = s0[0];
#pragma unroll
                for (int r = 1; r < 16; ++r) mx = fmaxf(mx, s0[r]);
#pragma unroll
                for (int r = 0; r < 16; ++r) mx = fmaxf(mx, s1[r]);
                mx = fmaxf(mx, __shfl_xor(mx, 32));
                const float mn = fmaxf(m_run, mx), alpha = __builtin_amdgcn_exp2f(m_run - mn); m_run = mn;
                float ls = 0.f;
#pragma unroll
                for (int r = 0; r < 16; ++r) { s0[r] = __builtin_amdgcn_exp2f(s0[r] - mn); s1[r] = __builtin_amdgcn_exp2f(s1[r] - mn); ls += s0[r] + s1[r]; }
                l_run = l_run * alpha + ls;
#pragma unroll
                for (int db = 0; db < 4; ++db)
#pragma unroll
                    for (int r = 0; r < 16; ++r) o[db][r] *= alpha;
            } else {
                const int kbase = 64 * t + 4 * hi;
                float gs[8], L0[16], L1[16];
#pragma unroll
                for (int kb = 0; kb < 2; ++kb)
#pragma unroll
                    for (int gq = 0; gq < 4; ++gq) { float acc = 0.f;
#pragma unroll
                        for (int e = 0; e < 4; ++e) { const int r = 4 * gq + e; const float x = kb ? s1[r] : s0[r];
                            const float sp = fmaxf(x, 0.f) + LN2 * __builtin_amdgcn_logf(1.0f + __builtin_amdgcn_exp2f(-fabsf(x) * LOG2E));
                            const bool earlier = (kbase + 32 * kb + e + 8 * gq) < qpos;
                            const float lk = earlier ? -sp : 0.f; acc += lk;
                            if (kb) { L1[r] = lk; s1[r] = x - sp; } else { L0[r] = lk; s0[r] = x - sp; } }
                        gs[4 * kb + gq] = acc; }
                float pgs[8];
#pragma unroll
                for (int j = 0; j < 8; ++j) pgs[j] = __shfl_xor(gs[j], 32);
                float T = 0.f;
#pragma unroll
                for (int j = 7; j >= 0; --j) { const int kb = j >> 2, gq = j & 3;
                    float W = T + (hi == 0 ? pgs[j] : 0.f) + R;
#pragma unroll
                    for (int e = 3; e >= 0; --e) { const int r = 4 * gq + e; const float lb = kb ? s1[r] : s0[r];
                        const bool earlier = (kbase + 32 * kb + e + 8 * gq) < qpos;
                        const float w = earlier ? __builtin_amdgcn_exp2f((lb + W) * LOG2E) : 0.f;
                        W += kb ? L1[r] : L0[r];
                        if (kb) s1[r] = w; else s0[r] = w; }
                    T += gs[j] + pgs[j]; }
                R += T;
            }
            bf16x8 pb[4];
            { v4u w;
              w.x = pkbf(s0[0], s0[1]); w.y = pkbf(s0[2], s0[3]); w.z = pkbf(s0[4], s0[5]); w.w = pkbf(s0[6], s0[7]); pb[0] = __builtin_bit_cast(bf16x8, w);
              w.x = pkbf(s0[8], s0[9]); w.y = pkbf(s0[10], s0[11]); w.z = pkbf(s0[12], s0[13]); w.w = pkbf(s0[14], s0[15]); pb[1] = __builtin_bit_cast(bf16x8, w);
              w.x = pkbf(s1[0], s1[1]); w.y = pkbf(s1[2], s1[3]); w.z = pkbf(s1[4], s1[5]); w.w = pkbf(s1[6], s1[7]); pb[2] = __builtin_bit_cast(bf16x8, w);
              w.x = pkbf(s1[8], s1[9]); w.y = pkbf(s1[10], s1[11]); w.z = pkbf(s1[12], s1[13]); w.w = pkbf(s1[14], s1[15]); pb[3] = __builtin_bit_cast(bf16x8, w); }
            ATT_SB0;
            if (SB) { ATT_RDV(0, 0); ATT_RDV(1, 1); ATT_SB0; } else { ATT_RDV(1, 1); ATT_SB0; }
            ATT_MMV(0, 0); ATT_RDV(0, 2); ATT_SB0;
            ATT_MMV(1, 1); ATT_RDV(1, 3); ATT_SB0;
            ATT_MMV(0, 2); ATT_SB0;
            ATT_MMV(1, 3);
#undef ATT_SB0
#undef ATT_RDK
#undef ATT_MMK
#undef ATT_RDV
#undef ATT_MMV
        }
        if (SB) { const bool done = !active || __all(R < SB_EXIT); if (lane == 0) *(volatile LAS unsigned*)(lds + ATT_FLAGS + (i & 1) * 32 + wid * 4) = done ? 1u : 0u; }
        asm volatile("s_waitcnt lgkmcnt(0)" ::: "memory"); __builtin_amdgcn_s_barrier(); asm volatile("" ::: "memory");
        if (SB) { const volatile LAS unsigned* fl = (const volatile LAS unsigned*)(lds + ATT_FLAGS + (i & 1) * 32);
            unsigned all = fl[0] & fl[1] & fl[2] & fl[3] & fl[4] & fl[5] & fl[6] & fl[7];
            if (__builtin_amdgcn_readfirstlane(all)) break; }
    }
    asm volatile("s_waitcnt vmcnt(0)" ::: "memory");
    if (active) {
        float inv = 1.f; bf16* op = J.out + (size_t)(r0 + r32) * J.opitch + 4 * hi;
        if (!SB) { const float lt = l_run + __shfl_xor(l_run, 32); inv = 1.0f / lt;
            if (J.po) { inv = 1.0f; op = J.po + (size_t)(r0 + r32) * 128 + 4 * hi; if (hi == 0) { float* ml = J.pml + (size_t)(r0 + r32) * 2; ml[0] = m_run; ml[1] = lt; } } }
#pragma unroll
        for (int db = 0; db < 4; ++db)
#pragma unroll
            for (int gq = 0; gq < 4; ++gq) { u32x2v w; w.x = pkbf(o[db][4 * gq] * inv, o[db][4 * gq + 1] * inv); w.y = pkbf(o[db][4 * gq + 2] * inv, o[db][4 * gq + 3] * inv);
                *(u32x2v*)(op + 32 * db + 8 * gq) = w; }
    }
    __builtin_amdgcn_s_barrier();
}

__device__ __forceinline__ void attn_unit_pp(LAS unsigned char* lds, const AttnJob& J, const float* ctab, const float* stab, int wid, int lane) {
    constexpr int NQ = 12, PPK = 24576, PPV0 = 49152, PPV = 16384;
    const int r32 = lane & 31, hi = lane >> 5, r0 = wid * 32;
    const bool late = wid >= 4;
    const int nt = J.ntiles;
#define PP_ISSUE(t, kb, vb) do { const unsigned char* ka_ = J.kA + (size_t)(t) * J.kA_ts + wid * 2048 + lane * 16; \
        ATT_GLDS(ka_, (kb) * PPK + wid * 2048); ATT_GLDS(ka_ + 1024, (kb) * PPK + wid * 2048 + 1024); \
        const unsigned char* kr_ = J.kB + (size_t)(t) * J.kB_ts + wid * 1024 + lane * 16; ATT_GLDS(kr_, (kb) * PPK + 16384 + wid * 1024); \
        const unsigned char* vp_ = J.vt + (size_t)(t) * J.vt_ts + wid * 2048 + lane * 16; \
        ATT_GLDS(vp_, PPV0 + (vb) * PPV + wid * 2048); ATT_GLDS(vp_ + 1024, PPV0 + (vb) * PPV + wid * 2048 + 1024); } while (0)
    PP_ISSUE(0, 0, 0);
    if (wid == 0 && lane == 0) { volatile LAS unsigned long long* st = (volatile LAS unsigned long long*)(lds + ATT_FLAGS + 256); st[0] = (unsigned long long)J.out; st[1] = (unsigned long long)J.po; st[2] = (unsigned long long)J.pml; }
    const int opitch_ = J.opitch;
    bf16x8 qf[NQ];
    const int qpos = J.pos0 + r0 + r32;
    { const bf16* qp = J.q + (size_t)(r0 + r32) * J.qpitch + 8 * hi;
#pragma unroll
      for (int d0 = 0; d0 < NQ; ++d0) qf[d0] = *(const bf16x8*)(qp + 16 * d0);
#pragma unroll
      for (int fi = 0; fi < 2; ++fi) {
          float x1[8], x2[8], c[8], sn[8]; unpack8(__builtin_bit_cast(v4u, qf[8 + fi]), x1); unpack8(__builtin_bit_cast(v4u, qf[10 + fi]), x2);
          ld8f(ctab + qpos * 32 + 16 * fi + 8 * hi, c); ld8f(stab + qpos * 32 + 16 * fi + 8 * hi, sn);
          float o1[8], o2[8];
#pragma unroll
          for (int j = 0; j < 8; ++j) { o1[j] = x1[j] * c[j] - x2[j] * sn[j]; o2[j] = x2[j] * c[j] + x1[j] * sn[j]; }
          qf[8 + fi] = __builtin_bit_cast(bf16x8, pack8(o1)); qf[10 + fi] = __builtin_bit_cast(bf16x8, pack8(o2)); } }
    f32x16 o[4];
#pragma unroll
    for (int db = 0; db < 4; ++db)
#pragma unroll
        for (int r = 0; r < 16; ++r) o[db][r] = 0.f;
    float m_run = -INFINITY, l_run = 0.f;
    const int wave_lim = (J.pos0 + r0) >> 6;
    bf16x8 pb[4]; bool pend = false;
    int vb = 0;
#define PP_SB0 __builtin_amdgcn_sched_barrier(0)
#define PP_RDK(buf, d0_) do { kq[buf][0] = *(const LAS bf16x8*)(kbuf + (d0_) * 2048); kq[buf][1] = *(const LAS bf16x8*)(kbuf + (d0_) * 2048 + 512); } while (0)
#define PP_MMK(buf, d0_) do { s0 = ATT_MFMA(kq[buf][0], qf[d0_], s0); s1 = ATT_MFMA(kq[buf][1], qf[d0_], s1); } while (0)
#define PP_RDV(buf, g, vbuf_) do { _Pragma("unroll") for (int db_ = 0; db_ < 4; ++db_) ka[buf][db_] = *(const LAS bf16x8*)((vbuf_) + (g) * 4096 + db_ * 512); } while (0)
#define PP_MMV(buf, g) do { _Pragma("unroll") for (int db_ = 0; db_ < 4; ++db_) o[db_] = ATT_MFMA(ka[buf][db_], pb[g], o[db_]); } while (0)
#define PP_PV(vbuf_) do { bf16x8 ka[2][4]; PP_SB0; PP_RDV(0, 0, vbuf_); PP_RDV(1, 1, vbuf_); PP_SB0; PP_MMV(0, 0); PP_RDV(0, 2, vbuf_); PP_SB0; PP_MMV(1, 1); PP_RDV(1, 3, vbuf_); PP_SB0; PP_MMV(0, 2); PP_SB0; PP_MMV(1, 3); PP_SB0; } while (0)
    for (int i = 0; i < nt; ++i) {
        asm volatile("s_waitcnt vmcnt(0) lgkmcnt(0)" ::: "memory"); __builtin_amdgcn_s_barrier(); asm volatile("" ::: "memory");
        const int vn = (vb == 2) ? 0 : vb + 1, vp = (vb == 0) ? 2 : vb - 1;
        if (i + 1 < nt) PP_ISSUE(i + 1, (i + 1) & 1, vn);
        LAS unsigned char* kbuf = lds + (i & 1) * PPK + hi * 1024 + r32 * 16;
        LAS unsigned char* vcur = lds + PPV0 + vb * PPV + hi * 2048 + r32 * 16;
        LAS unsigned char* vprv = lds + PPV0 + vp * PPV + hi * 2048 + r32 * 16;
        if (pend) { PP_PV(vprv); pend = false; }
        if (i + J.t0 <= wave_lim) {
            f32x16 s0, s1;
#pragma unroll
            for (int r = 0; r < 16; ++r) { s0[r] = 0.f; s1[r] = 0.f; }
            bf16x8 kq[2][2];
            PP_RDK(0, 0); PP_SB0;
#pragma unroll
            for (int d0 = 0; d0 < NQ; ++d0) { if (d0 + 1 < NQ) PP_RDK((d0 + 1) & 1, d0 + 1); PP_MMK(d0 & 1, d0); PP_SB0; }
            float mx = s0[0];
#pragma unroll
            for (int r = 1; r < 16; ++r) mx = fmaxf(mx, s0[r]);
#pragma unroll
            for (int r = 0; r < 16; ++r) mx = fmaxf(mx, s1[r]);
            mx = fmaxf(mx, __shfl_xor(mx, 32));
            const float mn = fmaxf(m_run, mx), alpha = __builtin_amdgcn_exp2f(m_run - mn); m_run = mn;
            float ls = 0.f;
#pragma unroll
            for (int r = 0; r < 16; ++r) { s0[r] = __builtin_amdgcn_exp2f(s0[r] - mn); s1[r] = __builtin_amdgcn_exp2f(s1[r] - mn); ls += s0[r] + s1[r]; }
            l_run = l_run * alpha + ls;
#pragma unroll
            for (int db = 0; db < 4; ++db)
#pragma unroll
                for (int r = 0; r < 16; ++r) o[db][r] *= alpha;
            { v4u w;
              w.x = pkbf(s0[0], s0[1]); w.y = pkbf(s0[2], s0[3]); w.z = pkbf(s0[4], s0[5]); w.w = pkbf(s0[6], s0[7]); pb[0] = __builtin_bit_cast(bf16x8, w);
              w.x = pkbf(s0[8], s0[9]); w.y = pkbf(s0[10], s0[11]); w.z = pkbf(s0[12], s0[13]); w.w = pkbf(s0[14], s0[15]); pb[1] = __builtin_bit_cast(bf16x8, w);
              w.x = pkbf(s1[0], s1[1]); w.y = pkbf(s1[2], s1[3]); w.z = pkbf(s1[4], s1[5]); w.w = pkbf(s1[6], s1[7]); pb[2] = __builtin_bit_cast(bf16x8, w);
              w.x = pkbf(s1[8], s1[9]); w.y = pkbf(s1[10], s1[11]); w.z = pkbf(s1[12], s1[13]); w.w = pkbf(s1[14], s1[15]); pb[3] = __builtin_bit_cast(bf16x8, w); }
            if (late) pend = true; else { PP_PV(vcur); }
        }
        vb = vn;
    }
    if (pend) { const int vl = (vb == 0) ? 2 : vb - 1; LAS unsigned char* vlast = lds + PPV0 + vl * PPV + hi * 2048 + r32 * 16; PP_PV(vlast); }
    asm volatile("s_waitcnt vmcnt(0) lgkmcnt(0)" ::: "memory");
    { const int r32e = r32, hie = hi;
      const volatile LAS unsigned long long* st = (const volatile LAS unsigned long long*)(lds + ATT_FLAGS + 256);
      bf16* out_ = (bf16*)st[0]; bf16* po_ = (bf16*)st[1]; float* pml_ = (float*)st[2];
      float inv = 1.f; bf16* op = out_ + (size_t)(r0 + r32e) * opitch_ + 4 * hie;
      const float lt = l_run + __shfl_xor(l_run, 32); inv = 1.0f / lt;
      if (po_) { inv = 1.0f; op = po_ + (size_t)(r0 + r32e) * 128 + 4 * hie; if (hie == 0) { float* ml = pml_ + (size_t)(r0 + r32e) * 2; ml[0] = m_run; ml[1] = lt; } }
#pragma unroll
      for (int db = 0; db < 4; ++db)
#pragma unroll
          for (int gq = 0; gq < 4; ++gq) { u32x2v w; w.x = pkbf(o[db][4 * gq] * inv, o[db][4 * gq + 1] * inv); w.y = pkbf(o[db][4 * gq + 2] * inv, o[db][4 * gq + 3] * inv);
              *(u32x2v*)(op + 32 * db + 8 * gq) = w; } }
    __builtin_amdgcn_s_barrier();
#undef PP_ISSUE
#undef PP_SB0
#undef PP_RDK
#undef PP_MMK
#undef PP_RDV
#undef PP_MMV
#undef PP_PV
}

__device__ __forceinline__ void attn_unit_s4(LAS unsigned char* lds, const bf16* qrow0, const unsigned char* kn, const unsigned char* kr, const unsigned char* vt, int nt, float* po, float* pml,
                                             const float* ctab, const float* stab, int wid, int lane) {
    const int r32 = lane & 31, hi = lane >> 5, hs = wid >> 1, r0 = (wid & 1) * 32;
#define S4_ISSUE_K(t) do { const unsigned char* g_ = kn + (size_t)(t) * (8 * 16384) + wid * 8192 + lane * 16; \
        _Pragma("unroll") for (int p_ = 0; p_ < 8; ++p_) ATT_GLDS(g_ + p_ * 1024, wid * 8192 + p_ * 1024); \
        ATT_GLDS(kr + (size_t)(t) * 8192 + wid * 1024 + lane * 16, S4_KR + wid * 1024); } while (0)
#define S4_ISSUE_V(t) do { const unsigned char* g_ = vt + (size_t)(t) * (8 * 16384) + wid * 8192 + lane * 16; \
        _Pragma("unroll") for (int p_ = 0; p_ < 8; ++p_) ATT_GLDS(g_ + p_ * 1024, S4_V + wid * 8192 + p_ * 1024); } while (0)
    S4_ISSUE_K(0);
    bf16x8 qf[12];
    const int qpos = 2048 + r0 + r32;
    { const bf16* qp = qrow0 + (size_t)(r0 + r32) * QW + hs * 192 + 8 * hi;
#pragma unroll
      for (int d0 = 0; d0 < 12; ++d0) qf[d0] = *(const bf16x8*)(qp + 16 * d0);
#pragma unroll
      for (int fi = 0; fi < 2; ++fi) {
          float x1[8], x2[8], c[8], sn[8]; unpack8(__builtin_bit_cast(v4u, qf[8 + fi]), x1); unpack8(__builtin_bit_cast(v4u, qf[10 + fi]), x2);
          ld8f(ctab + qpos * 32 + 16 * fi + 8 * hi, c); ld8f(stab + qpos * 32 + 16 * fi + 8 * hi, sn);
          float o1[8], o2[8];
#pragma unroll
          for (int j = 0; j < 8; ++j) { o1[j] = x1[j] * c[j] - x2[j] * sn[j]; o2[j] = x2[j] * c[j] + x1[j] * sn[j]; }
          qf[8 + fi] = __builtin_bit_cast(bf16x8, pack8(o1)); qf[10 + fi] = __builtin_bit_cast(bf16x8, pack8(o2)); } }
    f32x16 o[4];
#pragma unroll
    for (int db = 0; db < 4; ++db)
#pragma unroll
        for (int r = 0; r < 16; ++r) o[db][r] = 0.f;
    float m_run = -INFINITY, l_run = 0.f;
    LAS unsigned char* kbuf = lds + hs * 16384 + hi * 1024 + r32 * 16;
    LAS unsigned char* krbuf = lds + S4_KR + hi * 1024 + r32 * 16;
    LAS unsigned char* vbuf = lds + S4_V + hs * 16384 + hi * 2048 + r32 * 16;
    for (int i = 0; i < nt; ++i) {
        asm volatile("s_waitcnt vmcnt(0) lgkmcnt(0)" ::: "memory"); __builtin_amdgcn_s_barrier(); asm volatile("" ::: "memory");
        S4_ISSUE_V(i);
        f32x16 s0, s1;
#pragma unroll
        for (int r = 0; r < 16; ++r) { s0[r] = 0.f; s1[r] = 0.f; }
        bf16x8 ka[2][4];
#define S4_RDK(buf, dbase) do { _Pragma("unroll") for (int j_ = 0; j_ < 2; ++j_) { LAS unsigned char* kb_ = ((dbase) + j_) < 8 ? kbuf + ((dbase) + j_) * 2048 : krbuf + ((dbase) + j_ - 8) * 2048; \
            ka[buf][2 * j_] = *(const LAS bf16x8*)(kb_); ka[buf][2 * j_ + 1] = *(const LAS bf16x8*)(kb_ + 512); } } while (0)
#define S4_MMK(buf, dbase) do { _Pragma("unroll") for (int j_ = 0; j_ < 2; ++j_) { s0 = ATT_MFMA(ka[buf][2 * j_], qf[(dbase) + j_], s0); s1 = ATT_MFMA(ka[buf][2 * j_ + 1], qf[(dbase) + j_], s1); } } while (0)
#define S4_RDV(buf, g) do { _Pragma("unroll") for (int db_ = 0; db_ < 4; ++db_) ka[buf][db_] = *(const LAS bf16x8*)(vbuf + (g) * 4096 + db_ * 512); } while (0)
#define S4_MMV(buf, g) do { _Pragma("unroll") for (int db_ = 0; db_ < 4; ++db_) o[db_] = ATT_MFMA(ka[buf][db_], pb[g], o[db_]); } while (0)
#define S4_SB0 __builtin_amdgcn_sched_barrier(0)
        S4_RDK(0, 0); S4_SB0;
        S4_RDK(1, 2); S4_MMK(0, 0); S4_SB0;
        S4_RDK(0, 4); S4_MMK(1, 2); S4_SB0;
        S4_RDK(1, 6); S4_MMK(0, 4); S4_SB0;
        S4_RDK(0, 8); S4_MMK(1, 6); S4_SB0;
        S4_RDK(1, 10); S4_MMK(0, 8); S4_SB0;
        S4_MMK(1, 10); S4_SB0;
        float mx = s0[0];
#pragma unroll
        for (int r = 1; r < 16; ++r) mx = fmaxf(mx, s0[r]);
#pragma unroll
        for (int r = 0; r < 16; ++r) mx = fmaxf(mx, s1[r]);
        mx = fmaxf(mx, __shfl_xor(mx, 32));
        const float mn = fmaxf(m_run, mx), alpha = __builtin_amdgcn_exp2f(m_run - mn); m_run = mn;
        float ls = 0.f;
#pragma unroll
        for (int r = 0; r < 16; ++r) { s0[r] = __builtin_amdgcn_exp2f(s0[r] - mn); s1[r] = __builtin_amdgcn_exp2f(s1[r] - mn); ls += s0[r] + s1[r]; }
        l_run = l_run * alpha + ls;
#pragma unroll
        for (int db = 0; db < 4; ++db)
#pragma unroll
            for (int r = 0; r < 16; ++r) o[db][r] *= alpha;
        bf16x8 pb[4];
        { v4u w;
          w.x = pkbf(s0[0], s0[1]); w.y = pkbf(s0[2], s0[3]); w.z = pkbf(s0[4], s0[5]); w.w = pkbf(s0[6], s0[7]); pb[0] = __builtin_bit_cast(bf16x8, w);
          w.x = pkbf(s0[8], s0[9]); w.y = pkbf(s0[10], s0[11]); w.z = pkbf(s0[12], s0[13]); w.w = pkbf(s0[14], s0[15]); pb[1] = __builtin_bit_cast(bf16x8, w);
          w.x = pkbf(s1[0], s1[1]); w.y = pkbf(s1[2], s1[3]); w.z = pkbf(s1[4], s1[5]); w.w = pkbf(s1[6], s1[7]); pb[2] = __builtin_bit_cast(bf16x8, w);
          w.x = pkbf(s1[8], s1[9]); w.y = pkbf(s1[10], s1[11]); w.z = pkbf(s1[12], s1[13]); w.w = pkbf(s1[14], s1[15]); pb[3] = __builtin_bit_cast(bf16x8, w); }
        asm volatile("s_waitcnt vmcnt(0) lgkmcnt(0)" ::: "memory"); __builtin_amdgcn_s_barrier(); asm volatile("" ::: "memory");
        if (i + 1 < nt) S4_ISSUE_K(i + 1);
        S4_SB0;
        S4_RDV(0, 0); S4_RDV(1, 1); S4_SB0;
        S4_MMV(0, 0); S4_RDV(0, 2); S4_SB0;
        S4_MMV(1, 1); S4_RDV(1, 3); S4_SB0;
        S4_MMV(0, 2); S4_SB0;
        S4_MMV(1, 3);
#undef S4_RDK
#undef S4_MMK
#undef S4_RDV
#undef S4_MMV
#undef S4_SB0
    }
    asm volatile("s_waitcnt vmcnt(0) lgkmcnt(0)" ::: "memory");
    { const float lt = l_run + __shfl_xor(l_run, 32);
      float* pp = po + ((size_t)hs * 3 * 64 + (r0 + r32)) * 128 + 4 * hi;
#pragma unroll
      for (int db = 0; db < 4; ++db)
#pragma unroll
          for (int gq = 0; gq < 4; ++gq) *(f32x4*)(pp + 32 * db + 8 * gq) = (f32x4){o[db][4 * gq], o[db][4 * gq + 1], o[db][4 * gq + 2], o[db][4 * gq + 3]};
      if (hi == 0) { float* ml = pml + ((size_t)hs * 3 * 64 + (r0 + r32)) * 2; ml[0] = m_run; ml[1] = lt; } }
    __builtin_amdgcn_s_barrier();
#undef S4_ISSUE_K
#undef S4_ISSUE_V
}

__device__ __forceinline__ int queue_next(Frame& F, gu32* head) {
    volatile LAS unsigned* w = (volatile LAS unsigned*)(F.lds + ATT_QWORD);
    if (F.tid == 0) *w = __hip_atomic_fetch_add(head, 1u, RLX_AGENT);
    LDS_WAIT(); __syncthreads();
    const int v = (int)*w;
    LDS_WAIT(); __syncthreads();
    return v;
}

constexpr int MLA_NITEMS = 416;
__constant__ unsigned mla_items[MLA_NITEMS][2] = {
{0x6002c0u, 0xffffu}, {0x6002c2u, 0xffffu}, {0x6002c4u, 0xffffu}, {0x6002c6u, 0xffffu}, {0x6002c8u, 0xffffu}, {0x6002cau, 0xffffu}, {0x6002ccu, 0xffffu}, {0x6002ceu, 0xffffu},
{0x6002d0u, 0xffffu}, {0x6002d2u, 0xffffu}, {0x6002d4u, 0xffffu}, {0x6002d6u, 0xffffu}, {0x6002d8u, 0xffffu}, {0x6002dau, 0xffffu}, {0x6002dcu, 0xffffu}, {0x6002deu, 0xffffu},
{0x580280u, 0xffffu}, {0x580282u, 0xffffu}, {0x580284u, 0xffffu}, {0x580286u, 0xffffu}, {0x580288u, 0xffffu}, {0x58028au, 0xffffu}, {0x58028cu, 0xffffu}, {0x58028eu, 0xffffu},
{0x580290u, 0xffffu}, {0x580292u, 0xffffu}, {0x580294u, 0xffffu}, {0x580296u, 0xffffu}, {0x580298u, 0xffffu}, {0x58029au, 0xffffu}, {0x58029cu, 0xffffu}, {0x58029eu, 0xffffu},
{0x500240u, 0xffffu}, {0x500242u, 0xffffu}, {0x500244u, 0xffffu}, {0x500246u, 0xffffu}, {0x500248u, 0xffffu}, {0x50024au, 0xffffu}, {0x50024cu, 0xffffu}, {0x50024eu, 0xffffu},
{0x500250u, 0xffffu}, {0x500252u, 0xffffu}, {0x500254u, 0xffffu}, {0x500256u, 0xffffu}, {0x500258u, 0xffffu}, {0x50025au, 0xffffu}, {0x50025cu, 0xffffu}, {0x50025eu, 0xffffu},
{0x480200u, 0xffffu}, {0x480202u, 0xffffu}, {0x480204u, 0xffffu}, {0x480206u, 0xffffu}, {0x480208u, 0xffffu}, {0x48020au, 0xffffu}, {0x48020cu, 0xffffu}, {0x48020eu, 0xffffu},
{0x480210u, 0xffffu}, {0x480212u, 0xffffu}, {0x480214u, 0xffffu}, {0x480216u, 0xffffu}, {0x480218u, 0xffffu}, {0x48021au, 0xffffu}, {0x48021cu, 0xffffu}, {0x48021eu, 0xffffu},
{0x4001c0u, 0xffffu}, {0x4001c2u, 0xffffu}, {0x4001c4u, 0xffffu}, {0x4001c6u, 0xffffu}, {0x4001c8u, 0xffffu}, {0x4001cau, 0xffffu}, {0x4001ccu, 0xffffu}, {0x4001ceu, 0xffffu},
{0x4001d0u, 0xffffu}, {0x4001d2u, 0xffffu}, {0x4001d4u, 0xffffu}, {0x4001d6u, 0xffffu}, {0x4001d8u, 0xffffu}, {0x4001dau, 0xffffu}, {0x4001dcu, 0xffffu}, {0x4001deu, 0xffffu},
{0x4003c0u, 0x6u}, {0x4083c0u, 0x7u}, {0x4003c2u, 0xeu}, {0x4083c2u, 0xfu}, {0x4003c4u, 0x16u}, {0x4083c4u, 0x17u}, {0x4003c6u, 0x1eu}, {0x4083c6u, 0x1fu},
{0x4003c8u, 0x26u}, {0x4083c8u, 0x27u}, {0x4003cau, 0x2eu}, {0x4083cau, 0x2fu}, {0x4003ccu, 0x36u}, {0x4083ccu, 0x37u}, {0x4003ceu, 0x3eu}, {0x4083ceu, 0x3fu},
{0x4003d0u, 0x46u}, {0x4083d0u, 0x47u}, {0x4003d2u, 0x4eu}, {0x4083d2u, 0x4fu}, {0x4003d4u, 0x56u}, {0x4083d4u, 0x57u}, {0x4003d6u, 0x5eu}, {0x4083d6u, 0x5fu},
{0x4003d8u, 0x66u}, {0x4083d8u, 0x67u}, {0x4003dau, 0x6eu}, {0x4083dau, 0x6fu}, {0x4003dcu, 0x76u}, {0x4083dcu, 0x77u}, {0x4003deu, 0x7eu}, {0x4083deu, 0x7fu},
{0x3c0380u, 0x4u}, {0x3c7b80u, 0x5u}, {0x3c0382u, 0xcu}, {0x3c7b82u, 0xdu}, {0x3c0384u, 0x14u}, {0x3c7b84u, 0x15u}, {0x3c0386u, 0x1cu}, {0x3c7b86u, 0x1du},
{0x3c0388u, 0x24u}, {0x3c7b88u, 0x25u}, {0x3c038au, 0x2cu}, {0x3c7b8au, 0x2du}, {0x3c038cu, 0x34u}, {0x3c7b8cu, 0x35u}, {0x3c038eu, 0x3cu}, {0x3c7b8eu, 0x3du},
{0x3c0390u, 0x44u}, {0x3c7b90u, 0x45u}, {0x3c0392u, 0x4cu}, {0x3c7b92u, 0x4du}, {0x3c0394u, 0x54u}, {0x3c7b94u, 0x55u}, {0x3c0396u, 0x5cu}, {0x3c7b96u, 0x5du},
{0x3c0398u, 0x64u}, {0x3c7b98u, 0x65u}, {0x3c039au, 0x6cu}, {0x3c7b9au, 0x6du}, {0x3c039cu, 0x74u}, {0x3c7b9cu, 0x75u}, {0x3c039eu, 0x7cu}, {0x3c7b9eu, 0x7du},
{0x380180u, 0xffffu}, {0x380182u, 0xffffu}, {0x380184u, 0xffffu}, {0x380186u, 0xffffu}, {0x380188u, 0xffffu}, {0x38018au, 0xffffu}, {0x38018cu, 0xffffu}, {0x38018eu, 0xffffu},
{0x380190u, 0xffffu}, {0x380192u, 0xffffu}, {0x380194u, 0xffffu}, {0x380196u, 0xffffu}, {0x380198u, 0xffffu}, {0x38019au, 0xffffu}, {0x38019cu, 0xffffu}, {0x38019eu, 0xffffu},
{0x380340u, 0x2u}, {0x387340u, 0x3u}, {0x380342u, 0xau}, {0x387342u, 0xbu}, {0x380344u, 0x12u}, {0x387344u, 0x13u}, {0x380346u, 0x1au}, {0x387346u, 0x1bu},
{0x380348u, 0x22u}, {0x387348u, 0x23u}, {0x38034au, 0x2au}, {0x38734au, 0x2bu}, {0x38034cu, 0x32u}, {0x38734cu, 0x33u}, {0x38034eu, 0x3au}, {0x38734eu, 0x3bu},
{0x380350u, 0x42u}, {0x387350u, 0x43u}, {0x380352u, 0x4au}, {0x387352u, 0x4bu}, {0x380354u, 0x52u}, {0x387354u, 0x53u}, {0x380356u, 0x5au}, {0x387356u, 0x5bu},
{0x380358u, 0x62u}, {0x387358u, 0x63u}, {0x38035au, 0x6au}, {0x38735au, 0x6bu}, {0x38035cu, 0x72u}, {0x38735cu, 0x73u}, {0x38035eu, 0x7au}, {0x38735eu, 0x7bu},
{0x340300u, 0x0u}, {0x346b00u, 0x1u}, {0x340302u, 0x8u}, {0x346b02u, 0x9u}, {0x340304u, 0x10u}, {0x346b04u, 0x11u}, {0x340306u, 0x18u}, {0x346b06u, 0x19u},
{0x340308u, 0x20u}, {0x346b08u, 0x21u}, {0x34030au, 0x28u}, {0x346b0au, 0x29u}, {0x34030cu, 0x30u}, {0x346b0cu, 0x31u}, {0x34030eu, 0x38u}, {0x346b0eu, 0x39u},
{0x340310u, 0x40u}, {0x346b10u, 0x41u}, {0x340312u, 0x48u}, {0x346b12u, 0x49u}, {0x340314u, 0x50u}, {0x346b14u, 0x51u}, {0x340316u, 0x58u}, {0x346b16u, 0x59u},
{0x340318u, 0x60u}, {0x346b18u, 0x61u}, {0x34031au, 0x68u}, {0x346b1au, 0x69u}, {0x34031cu, 0x70u}, {0x346b1cu, 0x71u}, {0x34031eu, 0x78u}, {0x346b1eu, 0x79u},
{0x300140u, 0xffffu}, {0x300142u, 0xffffu}, {0x300144u, 0xffffu}, {0x300146u, 0xffffu}, {0x300148u, 0xffffu}, {0x30014au, 0xffffu}, {0x30014cu, 0xffffu}, {0x30014eu, 0xffffu},
{0x300150u, 0xffffu}, {0x300152u, 0xffffu}, {0x300154u, 0xffffu}, {0x300156u, 0xffffu}, {0x300158u, 0xffffu}, {0x30015au, 0xffffu}, {0x30015cu, 0xffffu}, {0x30015eu, 0xffffu},
{0x280100u, 0xffffu}, {0x280102u, 0xffffu}, {0x280104u, 0xffffu}, {0x280106u, 0xffffu}, {0x280108u, 0xffffu}, {0x28010au, 0xffffu}, {0x28010cu, 0xffffu}, {0x28010eu, 0xffffu},
{0x280110u, 0xffffu}, {0x280112u, 0xffffu}, {0x280114u, 0xffffu}, {0x280116u, 0xffffu}, {0x280118u, 0xffffu}, {0x28011au, 0xffffu}, {0x28011cu, 0xffffu}, {0x28011eu, 0xffffu},
{0x2000c0u, 0xffffu}, {0x2000c2u, 0xffffu}, {0x2000c4u, 0xffffu}, {0x2000c6u, 0xffffu}, {0x2000c8u, 0xffffu}, {0x2000cau, 0xffffu}, {0x2000ccu, 0xffffu}, {0x2000ceu, 0xffffu},
{0x2000d0u, 0xffffu}, {0x2000d2u, 0xffffu}, {0x2000d4u, 0xffffu}, {0x2000d6u, 0xffffu}, {0x2000d8u, 0xffffu}, {0x2000dau, 0xffffu}, {0x2000dcu, 0xffffu}, {0x2000deu, 0xffffu},
{0x180080u, 0xffffu}, {0x180082u, 0xffffu}, {0x180084u, 0xffffu}, {0x180086u, 0xffffu}, {0x180088u, 0xffffu}, {0x18008au, 0xffffu}, {0x18008cu, 0xffffu}, {0x18008eu, 0xffffu},
{0x180090u, 0xffffu}, {0x180092u, 0xffffu}, {0x180094u, 0xffffu}, {0x180096u, 0xffffu}, {0x180098u, 0xffffu}, {0x18009au, 0xffffu}, {0x18009cu, 0xffffu}, {0x18009eu, 0xffffu},
{0x160001u, 0x0u}, {0x160041u, 0x0u}, {0x160081u, 0x0u}, {0x160003u, 0x0u}, {0x160043u, 0x0u}, {0x160083u, 0x0u}, {0x160005u, 0x0u}, {0x160045u, 0x0u},
{0x160085u, 0x0u}, {0x160007u, 0x0u}, {0x160047u, 0x0u}, {0x160087u, 0x0u}, {0x160009u, 0x0u}, {0x160049u, 0x0u}, {0x160089u, 0x0u}, {0x16000bu, 0x0u},
{0x16004bu, 0x0u}, {0x16008bu, 0x0u}, {0x16000du, 0x0u}, {0x16004du, 0x0u}, {0x16008du, 0x0u}, {0x16000fu, 0x0u}, {0x16004fu, 0x0u}, {0x16008fu, 0x0u},
{0x160011u, 0x0u}, {0x160051u, 0x0u}, {0x160091u, 0x0u}, {0x160013u, 0x0u}, {0x160053u, 0x0u}, {0x160093u, 0x0u}, {0x160015u, 0x0u}, {0x160055u, 0x0u},
{0x160095u, 0x0u}, {0x160017u, 0x0u}, {0x160057u, 0x0u}, {0x160097u, 0x0u}, {0x160019u, 0x0u}, {0x160059u, 0x0u}, {0x160099u, 0x0u}, {0x16001bu, 0x0u},
{0x16005bu, 0x0u}, {0x16009bu, 0x0u}, {0x16001du, 0x0u}, {0x16005du, 0x0u}, {0x16009du, 0x0u}, {0x16001fu, 0x0u}, {0x16005fu, 0x0u}, {0x16009fu, 0x0u},
{0x160021u, 0x0u}, {0x160061u, 0x0u}, {0x1600a1u, 0x0u}, {0x160023u, 0x0u}, {0x160063u, 0x0u}, {0x1600a3u, 0x0u}, {0x160025u, 0x0u}, {0x160065u, 0x0u},
{0x1600a5u, 0x0u}, {0x160027u, 0x0u}, {0x160067u, 0x0u}, {0x1600a7u, 0x0u}, {0x160029u, 0x0u}, {0x160069u, 0x0u}, {0x1600a9u, 0x0u}, {0x16002bu, 0x0u},
{0x16006bu, 0x0u}, {0x1600abu, 0x0u}, {0x16002du, 0x0u}, {0x16006du, 0x0u}, {0x1600adu, 0x0u}, {0x16002fu, 0x0u}, {0x16006fu, 0x0u}, {0x1600afu, 0x0u},
{0x160031u, 0x0u}, {0x160071u, 0x0u}, {0x1600b1u, 0x0u}, {0x160033u, 0x0u}, {0x160073u, 0x0u}, {0x1600b3u, 0x0u}, {0x160035u, 0x0u}, {0x160075u, 0x0u},
{0x1600b5u, 0x0u}, {0x160037u, 0x0u}, {0x160077u, 0x0u}, {0x1600b7u, 0x0u}, {0x160039u, 0x0u}, {0x160079u, 0x0u}, {0x1600b9u, 0x0u}, {0x16003bu, 0x0u},
{0x16007bu, 0x0u}, {0x1600bbu, 0x0u}, {0x16003du, 0x0u}, {0x16007du, 0x0u}, {0x1600bdu, 0x0u}, {0x16003fu, 0x0u}, {0x16007fu, 0x0u}, {0x1600bfu, 0x0u},
{0x100040u, 0xffffu}, {0x100042u, 0xffffu}, {0x100044u, 0xffffu}, {0x100046u, 0xffffu}, {0x100048u, 0xffffu}, {0x10004au, 0xffffu}, {0x10004cu, 0xffffu}, {0x10004eu, 0xffffu},
{0x100050u, 0xffffu}, {0x100052u, 0xffffu}, {0x100054u, 0xffffu}, {0x100056u, 0xffffu}, {0x100058u, 0xffffu}, {0x10005au, 0xffffu}, {0x10005cu, 0xffffu}, {0x10005eu, 0xffffu},
{0x80000u, 0xffffu}, {0x80002u, 0xffffu}, {0x80004u, 0xffffu}, {0x80006u, 0xffffu}, {0x80008u, 0xffffu}, {0x8000au, 0xffffu}, {0x8000cu, 0xffffu}, {0x8000eu, 0xffffu},
{0x80010u, 0xffffu}, {0x80012u, 0xffffu}, {0x80014u, 0xffffu}, {0x80016u, 0xffffu}, {0x80018u, 0xffffu}, {0x8001au, 0xffffu}, {0x8001cu, 0xffffu}, {0x8001eu, 0xffffu} };
__device__ __forceinline__ void attention_phase(Frame& F, int l, int rep) {
    unsigned char* ws = PWS(); unsigned char* cl = ws + WS_C + (size_t)l * C_LAYER;
    const float* ctab = (const float*)(ws + WS_ROPE); const float* stab = ctab + 4096 * 32;
    const bf16* Q = (const bf16*)(ws + WS_Q); const bf16* Z = (const bf16*)(ws + WS_Z); bf16* Y = (bf16*)(ws + WS_YATT);
    const unsigned char* KN = ws + WS_KN; const unsigned char* VT = ws + WS_VT; const unsigned char* KR = cl + C_KR; const unsigned char* KSB = cl + C_KSB; const unsigned char* VTSB = cl + C_VTSB;
    if (rep == 0 || ((DUPM >> 14) & 1u))
    { gu32* head = F.ctl + CW_QUEUE + 64 * (2 * l + 4 * rep);
      float* PO = (float*)(ws + WS_PO); float* PML = (float*)(ws + WS_PML);
      bf16* PO16 = (bf16*)(ws + WS_PO16); float* PML16 = (float*)(ws + WS_PML16);
      for (;;) { const int id = queue_next(F, head); if (id >= MLA_NITEMS) break;
          const unsigned w0 = mla_items[id][0], w1 = mla_items[id][1];
          if ((w0 & 1u) == 0u) { AttnJob J; J.kc = nullptr; J.vc = nullptr; J.ncache = 0;
              const int bh = (w0 >> 1) & 31, qb = (w0 >> 6) & 15, t0 = (w0 >> 10) & 127, ntl = (w0 >> 17) & 127, b = bh >> 3, h = bh & 7, row0 = b * 4096 + 256 * qb, tile0 = b * 64 + t0;
              J.nrows = 256; J.pos0 = 256 * qb; J.ntiles = ntl; J.t0 = t0; J.po = nullptr; J.pml = nullptr;
              if (w1 != 0xffffu) { J.po = PO16 + (size_t)w1 * 256 * 128; J.pml = PML16 + (size_t)w1 * 256 * 2; }
              J.q = Q + (size_t)row0 * QW + h * 192; J.qpitch = QW;
              J.kA = KN + ((size_t)tile0 * 8 + h) * 16384; J.kA_ts = 8 * 16384; J.kB = KR + (size_t)tile0 * 8192; J.kB_ts = 8192; J.vt = VT + ((size_t)tile0 * 8 + h) * 16384; J.vt_ts = 8 * 16384;
              J.out = Y + (size_t)row0 * YW + h * 128; J.opitch = YW;
              int ln_ = F.lane; asm volatile("" : "+v"(ln_));
              attn_unit_pp(F.lds, J, ctab, stab, F.wave, ln_); }
          else { const int sg = (w0 >> 1) & 31, part = (w0 >> 6) & 15, sI = sg >> 1, hg = sg & 1, tile0 = 128 + 33 * sI + 11 * part;
              const size_t pu = (size_t)((sI * 8 + 4 * hg) * 3 + part);
              int ln_ = F.lane; asm volatile("" : "+v"(ln_));
              attn_unit_s4(F.lds, Q + (size_t)(TP + 64 * sI) * QW + 4 * hg * 192, KN + ((size_t)tile0 * 8 + 4 * hg) * 16384, KR + (size_t)tile0 * 8192, VT + ((size_t)tile0 * 8 + 4 * hg) * 16384, 11,
                           PO + pu * 64 * 128, PML + pu * 64 * 2, ctab, stab, F.wave, ln_); } } }
    if (rep == 0 || ((DUPM >> 15) & 1u))
    { gu32* head = F.ctl + CW_QUEUE + 64 * (2 * l + 1 + 4 * rep);
      for (;;) { const int id = queue_next(F, head); if (id >= 192) break;
          AttnJob J; int row0, tile0, h; J.kc = nullptr; J.vc = nullptr; J.ncache = 0; J.t0 = 0; J.po = nullptr; J.pml = nullptr;
          if (id < 128) { const int qb = 15 - (id >> 3), b = (id >> 2) & 1; h = id & 3; row0 = b * 4096 + 256 * qb; tile0 = b * 64; J.nrows = 256; J.pos0 = 256 * qb; J.ntiles = 4 * qb + 4; }
          else { const int u = id - 128, s = u >> 2; h = u & 3; row0 = TP + 64 * s; tile0 = 128 + 33 * s; J.nrows = 64; J.pos0 = 2048; J.ntiles = 33;
              J.kc = PIN(4) + ((size_t)(l * 16 + s) * 2048) * 512 + h * 128; J.vc = PIN(5) + ((size_t)(l * 16 + s) * 2048) * 512 + h * 128; J.ncache = 32; }
          J.q = Z + (size_t)row0 * DINP + ZC_QSB + h * 128; J.qpitch = DINP;
          J.kA = KSB + ((size_t)tile0 * 4 + h) * 16384; J.kA_ts = 4 * 16384; J.kB = nullptr; J.kB_ts = 0; J.vt = VTSB + ((size_t)tile0 * 4 + h) * 16384; J.vt_ts = 4 * 16384;
          J.out = Y + (size_t)row0 * YW + 1024 + h * 128; J.opitch = YW;
          int ln_ = F.lane; asm volatile("" : "+v"(ln_));
          attn_unit<true>(F.lds, J, ctab, stab, F.wave, ln_); } }
}

#ifndef MK_SPLIT
#define MK_SPLIT 0
#endif
constexpr int NPH = 1 + 13 * DEPTH;
using EVtSb = pg8::EpiVtBlk<true, 4>; using EVtMla = pg8::EpiVtBlk<false, 8>; using EKnMla = pg8::EpiKBlk<8>;
__global__ void __launch_bounds__(NWAVES * 64, 2) fwd_kernel(Args args) {
    extern __shared__ __attribute__((aligned(16))) unsigned char lds_raw[];
    Frame F;
    F.lds = (LAS unsigned char*)lds_raw;
    F.MISC = (volatile LAS unsigned*)(F.lds + MISC_OFF);
    F.tid = threadIdx.x; F.lane = F.tid & 63; F.wave = __builtin_amdgcn_readfirstlane(F.tid >> 6);
    const int G = gridDim.x; const int vcu = (G % 8 == 0) ? ((int)blockIdx.x % 8) * (G / 8) + (int)blockIdx.x / 8 : (int)blockIdx.x;
    F.gw = vcu * NWAVES + F.wave; F.ngw = G * NWAVES;
    F.ctl = (gu32*)(args.ws + WS_CTL);
    { LAS unsigned long long* pp = (LAS unsigned long long*)(F.lds + PARAM_OFF);
      if (F.tid == 0) {
#pragma unroll
          for (int k = 0; k < 30; ++k) pp[k] = (unsigned long long)args.in[k];
          pp[30] = (unsigned long long)args.out; pp[31] = (unsigned long long)args.ws; } }
    for (int u = F.tid; u < 64; u += NWAVES * 64) ((LAS unsigned*)(F.lds + MISC_OFF))[u] = 0u;
    __syncthreads();
    XcdBarrier bar; bar.bar = (unsigned*)(F.ctl + CW_BAR); bar.x = 0; bar.st = nullptr;
    if (!MK_SPLIT) bar = xcd_barrier_post((unsigned*)(F.ctl + CW_BAR), F.MISC + 8);
    const int lo = args.ph_lo, hi = args.ph_hi;
#ifndef PHM
#define PHM 0xFFFFFFFFu
#endif
#define EN(j) ((PHM >> (j)) & 1u)
#define NREP(j) (((DUPM >> (j)) & 1u) ? 3 : 1)
#define IN(k) (lo <= (k) && (k) < hi)
#define SEAM(k) do { if (IN((k) + 1)) xcd_barrier(bar); } while (0)
#define LAUNDER() asm volatile("" : "+v"(F.tid), "+v"(F.lane), "+s"(F.wave), "+s"(F.gw))
#define WL() (PWS() + WS_W + (size_t)l * W_LAYER)
#define CL() (PWS() + WS_C + (size_t)l * C_LAYER)
#define GEMM_CALL(EPI, AP, BP, MM, NN, KK, EOBJ) do { int bid_ = (int)blockIdx.x; asm volatile("" : "+s"(bid_)); pg8::Gemm g{(const bf16*)(AP), (const bf16*)(BP), (MM), (NN), (KK)}; pg8::StaticOrder S; S.init((MM), (NN), (KK), (int)gridDim.x, bid_); \
        pg8::gemm_phase<EPI, pg8::StaticOrder, true, true>(F.lds, g, S, (EOBJ)); } while (0)
#define GEMM_CALL_I8(EPI, AP, BP, MM, NN, KK, EOBJ) do { int bid_ = (int)blockIdx.x; asm volatile("" : "+s"(bid_)); pg8::Gemm g{(const bf16*)(AP), (const bf16*)(BP), (MM), (NN), (KK)}; pg8::StaticOrder S; S.init((MM), (NN), (KK), (int)gridDim.x, bid_); \
        pg8::gemm_phase<EPI, pg8::StaticOrder, true, true, true>(F.lds, g, S, (EOBJ)); } while (0)
#define GEMM_CALL_SUB(EPI, AP, BP, MM, NN, KK, EOBJ, C0, CIDX, I0, I1) do { int bid_ = (int)blockIdx.x; asm volatile("" : "+s"(bid_)); pg8::Gemm g{(const bf16*)(AP), (const bf16*)(BP), (MM), (NN), (KK)}; pg8::SubsetOrder S; \
        S.init((MM), (NN), (KK), (int)gridDim.x, (CIDX), (C0), (I0), (I1)); pg8::gemm_phase<EPI, pg8::SubsetOrder, true, true>(F.lds, g, S, (EOBJ)); } while (0)
#define GEMM_CALL_NEW(EPI, ROWS, AP, BP, MM, NN, KK, EOBJ, ROT) do { int bid_ = (int)blockIdx.x; asm volatile("" : "+s"(bid_)); bid_ = (bid_ + (int)gridDim.x - (ROT)) % (int)gridDim.x; pg8::Gemm g{(const bf16*)(AP), (const bf16*)(BP), (MM), (NN), (KK)}; pg8::NewKeyOrder<ROWS> S; S.init((MM), (NN), (KK), (int)gridDim.x, bid_); \
        pg8::gemm_phase<EPI, pg8::NewKeyOrder<ROWS>, true, true>(F.lds, g, S, (EOBJ)); } while (0)
#define GEMM_CALL_SK(EPI, AP, BP, MM, NN, KK, EOBJ) do { pg8::Gemm g{(const bf16*)(AP), (const bf16*)(BP), (MM), (NN), (KK)}; int bid_ = (int)blockIdx.x; asm volatile("" : "+s"(bid_)); pg8::TailSplitOrder S; S.init((MM), (NN), (KK), (int)gridDim.x, bid_); \
        pg8::gemm_phase<EPI, pg8::TailSplitOrder, true, true>(F.lds, g, S, (EOBJ)); } while (0)
    if (EN(13) && IN(0)) for (int rep = 0; rep < NREP(13); ++rep) { LAUNDER(); p0_prologue(F); LAUNDER(); __syncthreads(); quant_strips(F); SEAM(0); }
    for (int l = 0; l < DEPTH; ++l) {
        const int pb = 1 + 13 * l;
        if (EN(0) && IN(pb + 0)) for (int rep = 0; rep < NREP(0); ++rep) { LAUNDER();
            { unsigned char* ws = PWS(); pg8::EpiSwiGLUi8 E{(bf16*)(ws + WS_HID), DFF, (const float*)(ws + WS_RS), (const float*)(ws + WS_CS) + (size_t)(l * 2) * 2 * DFF};
              GEMM_CALL_I8(pg8::EpiSwiGLUi8, ws + WS_HB8, WL() + W_GU1, MT, 2 * DFF, DM / 2, E); }
            { unsigned char* ws = PWS(); EKnMla E{ws + WS_KN, 32}; int bid_ = (int)blockIdx.x; asm volatile("" : "+s"(bid_));
              pg8::Gemm g{(const bf16*)(CL() + C_CKV + (size_t)8192 * 512 * 2), (const bf16*)(WL() + W_UKV), NKEY - 8192, 1024, 512};
              pg8::PastPanelOrder<true> S; S.init(116 * 256, 1024, 512, (int)gridDim.x, bid_, 48, 0, 2); pg8::gemm_phase<EKnMla, pg8::PastPanelOrder<true>, true, true>(F.lds, g, S, E); }
            SEAM(pb + 0); }
        if (EN(1) && IN(pb + 1)) for (int rep = 0; rep < NREP(1); ++rep) { LAUNDER(); unsigned char* ws = PWS(); pg8::EpiFmix E{(bf16*)(ws + WS_F), (bf16*)(ws + WS_F1), DM, DFF / 64}; GEMM_CALL_SK(pg8::EpiFmix, ws + WS_HID, WL() + W_D1, MT, DM, DFF, E); SEAM(pb + 1); }
        if (EN(2) && IN(pb + 2)) { LAUNDER(); unsigned char* ws = PWS(); bf16* HB = (bf16*)(ws + WS_HB);
            if (l == 0) norm_phase<true, false>(F, (const bf16*)(ws + WS_F), (const bf16*)(ws + WS_F1), PIN(0), PIN(1), 0.5f, PIN(11) + l * DM, (float*)(ws + WS_RS), HB);
            else norm_phase<false, false>(F, (const bf16*)(ws + WS_F), (const bf16*)(ws + WS_F1), HB, nullptr, 0.5f, PIN(11) + l * DM, (float*)(ws + WS_RS), HB);
            SEAM(pb + 2); }
        if (EN(3) && IN(pb + 3)) for (int rep = 0; rep < NREP(3); ++rep) { LAUNDER();
            { unsigned char* ws = PWS(); pg8::EpiBf16 E{(bf16*)(ws + WS_Z), DINP, (const float*)(ws + WS_RS)}; GEMM_CALL(pg8::EpiBf16, ws + WS_HB, WL() + W_IN, MT, DINP, DM, E); }
            { unsigned char* ws = PWS(); EVtMla E{ws + WS_VT, 32}; int bid_ = (int)blockIdx.x; asm volatile("" : "+s"(bid_));
              pg8::Gemm g{(const bf16*)(WL() + W_UKV + (size_t)1024 * 512 * 2), (const bf16*)(CL() + C_CKV + (size_t)8192 * 512 * 2), 1024, NKEY - 8192, 512};
              pg8::PastPanelOrder<false> S; S.init(1024, 116 * 256, 512, (int)gridDim.x, bid_, 100); pg8::gemm_phase<EVtMla, pg8::PastPanelOrder<false>, true, true>(F.lds, g, S, E); }
            SEAM(pb + 3); }
        if (EN(4) && IN(pb + 4)) for (int rep = 0; rep < NREP(4); ++rep) { LAUNDER(); postz_phase(F, l); SEAM(pb + 4); }
        if (EN(5) && IN(pb + 5)) for (int rep = 0; rep < NREP(5); ++rep) { LAUNDER();
            { unsigned char* ws = PWS(); pg8::EpiBf16 E{(bf16*)(ws + WS_Q), QW, nullptr}; GEMM_CALL(pg8::EpiBf16, ws + WS_CQN, WL() + W_UQ, MT, QW, 512, E); }
            { unsigned char* ws = PWS(); EKnMla E{ws + WS_KN, 0}; GEMM_CALL_NEW(EKnMla, true, CL() + C_CKV, WL() + W_UKV, 48 * 256, 1024, 512, E, 64); }
            { unsigned char* ws = PWS(); EVtMla E{ws + WS_VT, 0}; GEMM_CALL_NEW(EVtMla, false, WL() + W_UKV + (size_t)1024 * 512 * 2, CL() + C_CKV, 1024, 48 * 256, 512, E, 128); }
            { unsigned char* ws = PWS(); EKnMla E{ws + WS_KN, 32}; int bid_ = (int)blockIdx.x; asm volatile("" : "+s"(bid_));
              pg8::Gemm g{(const bf16*)(CL() + C_CKV + (size_t)8192 * 512 * 2), (const bf16*)(WL() + W_UKV), NKEY - 8192, 1024, 512};
              pg8::PastPanelOrder<true> S; S.init(116 * 256, 1024, 512, (int)gridDim.x, bid_ + 48, 48, 2, 3); pg8::gemm_phase<EKnMla, pg8::PastPanelOrder<true>, true, true>(F.lds, g, S, E); }
            SEAM(pb + 5); }
        if (EN(6) && IN(pb + 6)) for (int rep = 0; rep < NREP(6); ++rep) { LAUNDER(); attention_phase(F, l, rep); SEAM(pb + 6); }
        if (EN(7) && IN(pb + 7)) for (int rep = 0; rep < NREP(7); ++rep) { LAUNDER(); postattn_phase(F, l); SEAM(pb + 7); }
        if (EN(8) && IN(pb + 8)) for (int rep = 0; rep < NREP(8); ++rep) { LAUNDER(); unsigned char* ws = PWS(); pg8::EpiFmix E{(bf16*)(ws + WS_F), (bf16*)(ws + WS_F1), DM, DM / 64}; GEMM_CALL_SK(pg8::EpiFmix, ws + WS_XN, WL() + W_O, MT, DM, DM, E); SEAM(pb + 8); }
        if (EN(9) && IN(pb + 9)) { LAUNDER(); unsigned char* ws = PWS(); bf16* HB = (bf16*)(ws + WS_HB);
            norm_phase<false, false>(F, (const bf16*)(ws + WS_F), (const bf16*)(ws + WS_F1), HB, nullptr, 1.0f, PIN(24) + l * DM, (float*)(ws + WS_RS), HB, ws + WS_HB8); SEAM(pb + 9); }
        if (EN(10) && IN(pb + 10)) for (int rep = 0; rep < NREP(10); ++rep) { LAUNDER(); unsigned char* ws = PWS();
            pg8::EpiSwiGLUi8 E{(bf16*)(ws + WS_HID), DFF, (const float*)(ws + WS_RS), (const float*)(ws + WS_CS) + (size_t)(l * 2 + 1) * 2 * DFF};
            GEMM_CALL_I8(pg8::EpiSwiGLUi8, ws + WS_HB8, WL() + W_GU2, MT, 2 * DFF, DM / 2, E);
            if (l == 0 && DEPTH == 2) { LAUNDER(); __syncthreads(); deferred_down_weights(F); }
            SEAM(pb + 10); }
        if (EN(11) && IN(pb + 11)) for (int rep = 0; rep < NREP(11); ++rep) { LAUNDER(); unsigned char* ws = PWS(); pg8::EpiFmix E{(bf16*)(ws + WS_F), (bf16*)(ws + WS_F1), DM, DFF / 64}; GEMM_CALL_SK(pg8::EpiFmix, ws + WS_HID, WL() + W_D2, MT, DM, DFF, E); SEAM(pb + 11); }
        if (EN(12) && IN(pb + 12)) { LAUNDER(); unsigned char* ws = PWS(); bf16* HB = (bf16*)(ws + WS_HB);
            if (l + 1 < DEPTH) norm_phase<false, false>(F, (const bf16*)(ws + WS_F), (const bf16*)(ws + WS_F1), HB, nullptr, 0.5f, PIN(29) + l * DM, (float*)(ws + WS_RS), HB, ws + WS_HB8);
            else norm_phase<false, true>(F, (const bf16*)(ws + WS_F), (const bf16*)(ws + WS_F1), HB, nullptr, 0.5f, PIN(29) + l * DM, nullptr, POUT());
            SEAM(pb + 12); }
    }
#undef IN
#undef SEAM
}

extern "C" void kernel_launch(void* const* d_in, const int* in_sizes, int n_in, void* d_out, int out_size, void* d_ws, size_t ws_size, hipStream_t stream) {
    static int grid = 0;
    if (grid == 0) {
        if (n_in != 30 || out_size != (int)O_END || ws_size < WS_END) { fprintf(stderr, "kernel_launch: unexpected shapes: n_in %d out %d ws %zu (need %zu)\n", n_in, out_size, ws_size, (size_t)WS_END); grid = -1; return; }
        int dev = 0, cus = 0, per_cu = 0;
        if (hipGetDevice(&dev) != hipSuccess || hipDeviceGetAttribute(&cus, hipDeviceAttributeMultiprocessorCount, dev) != hipSuccess) { grid = -1; return; }
        if (hipFuncSetAttribute((const void*)fwd_kernel, hipFuncAttributeMaxDynamicSharedMemorySize, LDS_BYTES) != hipSuccess) { fprintf(stderr, "kernel_launch: hipFuncSetAttribute failed\n"); grid = -1; return; }
        if (hipOccupancyMaxActiveBlocksPerMultiprocessor(&per_cu, (const void*)fwd_kernel, NWAVES * 64, LDS_BYTES) != hipSuccess || per_cu < 1) { fprintf(stderr, "kernel_launch: occupancy query says %d\n", per_cu); (void)hipGetLastError(); grid = -1; return; }
        grid = cus;
    }
    if (grid < 0) return;
    (void)hipMemsetAsync((char*)d_ws + WS_CTL, 0, CTL_ZERO_BYTES, stream);
    Args a{};
    for (int i = 0; i < 30; ++i) a.in[i] = (const float*)d_in[i];
    a.out = (float*)d_out; a.ws = (unsigned char*)d_ws;
#if MK_SPLIT
    for (int p = 0; p < NPH; ++p) { a.ph_lo = p; a.ph_hi = p + 1; hipLaunchKernelGGL(fwd_kernel, dim3(grid), dim3(NWAVES * 64), LDS_BYTES, stream, a); }
#else
    a.ph_lo = 0; a.ph_hi = NPH;
    hipLaunchKernelGGL(fwd_kernel, dim3(grid), dim3(NWAVES * 64), LDS_BYTES, stream, a);
#endif
}
```
